# Optimizing an MI355X kernel written in HIP

```python
import math
import jax, jax.numpy as jnp
from jax import lax
import numpy as np

D_MODEL = 1024
BATCH = 8
SEQ = 2048
DEPTH = 2
DEC_BATCH = 128
DEC_SEQ = 4
PAST_LEN = 16384
PAGE_SIZE = 128

MLSTM_WIDTH = D_MODEL // 2
MLSTM_HEADS = 4
MLSTM_DH = MLSTM_WIDTH // MLSTM_HEADS
MLSTM_CHUNK = 64
SGU_WIDTH = D_MODEL // 4
SGU_HEADS = 4
SGU_DH = SGU_WIDTH // SGU_HEADS
SGU_CHUNK = 128
POOL_WIDTH = D_MODEL - MLSTM_WIDTH - SGU_WIDTH
POOL_WINDOWS = (2, 4, 8, 16)
POOL_GROUPS = len(POOL_WINDOWS)
POOL_DG = POOL_WIDTH // POOL_GROUPS
POOL_BUF = max(POOL_WINDOWS) - 1
PEER_HEADS = 8
PEER_NKEYS = 128
PEER_EXPERTS = PEER_NKEYS ** 2
PEER_TOPK = 16
PEER_DQ = 256
PEER_DK = PEER_DQ // 2
PEER_BLOCK = 128
ALPHA = (2 * DEPTH) ** 0.25
BETA = (8 * DEPTH) ** -0.25
LN_EPS = 1e-5
IN_COLS = 4 * MLSTM_WIDTH + 2 * MLSTM_HEADS + 2 * SGU_WIDTH + POOL_WIDTH
IN_SPLITS = [int(s) for s in np.cumsum([MLSTM_WIDTH] * 4 + [2 * MLSTM_HEADS] + [SGU_WIDTH] * 2 + [POOL_WIDTH])[:-1]]

kernel_name = 'hymba_mlstm_sgu_pool_peer_deepnorm_step'


def layer_norm(x, g, b, eps=LN_EPS):
    xf = x.astype(jnp.float32)
    mu = xf.mean(-1, keepdims=True)
    var = jnp.mean(jnp.square(xf - mu), -1, keepdims=True)
    return ((xf - mu) * lax.rsqrt(var + eps) * g + b).astype(x.dtype)


def mlstm_chunk(state, q, k, v, ig, lf):
    C, n, m = state
    L = q.shape[1]
    b = jnp.cumsum(lf, axis=1)
    causal = jnp.tril(jnp.ones((L, L), bool))
    dlog = b[:, :, None, :] - b[:, None, :, :] + ig[:, None, :, :]
    dlog = jnp.where(causal[None, :, :, None], dlog, -jnp.inf)
    inter = b + m[:, None, :]
    m_t = jnp.maximum(inter, dlog.max(axis=2))
    w_intra = jnp.exp(dlog - m_t[:, :, None, :])
    w_inter = jnp.exp(inter - m_t)
    a = w_intra * jnp.einsum('bthd,bshd->btsh', q, k)
    num = jnp.einsum('btsh,bshd->bthd', a, v) + w_inter[..., None] * jnp.einsum('bhvk,bthk->bthv', C, q)
    den = a.sum(2) + w_inter * jnp.einsum('bhk,bthk->bth', n, q)
    h = num / jnp.maximum(jnp.abs(den), jnp.exp(-m_t))[..., None]
    b_end = b[:, -1]
    dend = b_end[:, None, :] - b + ig
    m_new = jnp.maximum(b_end + m, dend.max(1))
    wc = jnp.exp(dend - m_new[:, None, :])
    dec = jnp.exp(b_end + m - m_new)
    C_new = dec[..., None, None] * C + jnp.einsum('bsh,bshv,bshk->bhvk', wc, v, k)
    n_new = dec[..., None] * n + jnp.einsum('bsh,bshk->bhk', wc, k)
    return (C_new, n_new, m_new), h


def mlstm_scan(state, q, k, v, ig, lf):
    B, T, H, Dh = q.shape
    lc = MLSTM_CHUNK if T % MLSTM_CHUNK == 0 else T
    nc = T // lc

    def to_chunks(a):
        return jnp.moveaxis(a.reshape((B, nc, lc) + a.shape[2:]), 1, 0)

    def step(carry, xs):
        return mlstm_chunk(carry, *xs)

    state, h = lax.scan(step, state, tuple(to_chunks(a) for a in (q, k, v, ig, lf)))
    return state, jnp.moveaxis(h, 0, 1).reshape(B, T, H, Dh)


def pool_mix(p_in, buf, pos0, w_pool, pool_scale):
    B, T, C = p_in.shape
    P = buf.shape[1]
    wmax = max(POOL_WINDOWS)
    xcat = jnp.concatenate([buf.astype(p_in.dtype), p_in], axis=1)
    xpad = jnp.concatenate([jnp.zeros((B, wmax, C), jnp.float32), xcat.astype(jnp.float32)], axis=1)
    cs = jnp.cumsum(xpad, axis=1)
    pos = pos0 + jnp.arange(T)
    start = wmax + P
    outs = []
    for gi, w in enumerate(POOL_WINDOWS):
        sl = slice(gi * POOL_DG, (gi + 1) * POOL_DG)
        wsum = cs[:, start:start + T, sl] - cs[:, start - w:start - w + T, sl]
        cnt = jnp.minimum(pos + 1, w).astype(jnp.float32)[None, :, None]
        outs.append(wsum / cnt - xpad[:, start:start + T, sl])
    pooled = jnp.stack(outs, axis=2)
    y = jnp.einsum('btgd,gde->btge', pooled, w_pool.astype(jnp.float32)).reshape(B, T, C) * pool_scale
    return y.astype(p_in.dtype), xcat[:, -POOL_BUF:]


def token_mixers(xm, mstate, pool_buf, pos0, w_in, b_gate, mh_g, sgu_g, sgu_b, w_s, b_s, w_pool, pool_scale, w_o):
    B, T, _ = xm.shape
    f32 = jnp.float32
    proj = jnp.einsum('btd,de->bte', xm, w_in)
    q, k, v, o, gates, u_s, v_s, p_in = jnp.split(proj, IN_SPLITS, axis=-1)
    hd = lambda a: a.reshape(B, T, MLSTM_HEADS, MLSTM_DH).astype(f32)
    gates = gates.astype(f32) + b_gate
    ig = gates[..., :MLSTM_HEADS]
    lf = jax.nn.log_sigmoid(gates[..., MLSTM_HEADS:])
    mstate, h = mlstm_scan(mstate, hd(q) * MLSTM_DH ** -0.5, hd(k), hd(v), ig, lf)
    h = layer_norm(h, mh_g.reshape(MLSTM_HEADS, MLSTM_DH), 0.0).reshape(B, T, MLSTM_WIDTH)
    y_a = (jax.nn.sigmoid(o.astype(f32)) * h).astype(xm.dtype)
    lc = min(T, SGU_CHUNK)
    vn = layer_norm(v_s.reshape(B, T, SGU_HEADS, SGU_DH), sgu_g.reshape(SGU_HEADS, SGU_DH), sgu_b.reshape(SGU_HEADS, SGU_DH))
    ws = jnp.where(jnp.tril(jnp.ones((lc, lc), bool)), w_s[:, :lc, :lc], 0.0)
    vc = vn.reshape(B, T // lc, lc, SGU_HEADS, SGU_DH)
    mix = jnp.einsum('gts,bcsgd->bctgd', ws, vc) + jnp.swapaxes(b_s[:, :lc], 0, 1)[:, :, None]
    y_b = u_s * mix.reshape(B, T, SGU_WIDTH).astype(xm.dtype)
    y_c, pool_buf = pool_mix(p_in, pool_buf, pos0, w_pool, pool_scale)
    y = jnp.einsum('bte,ed->btd', jnp.concatenate([y_a, y_b, y_c], axis=-1), w_o)
    return y, mstate, pool_buf, vn.reshape(B, T, SGU_WIDTH)


def peer(xm, w_pq, peer_keys, peer_u, peer_v):
    B, T, D = xm.shape
    n = B * T
    x2 = xm.reshape(n, D)
    q = jnp.einsum('nd,de->ne', x2, w_pq).reshape(n, PEER_HEADS, 2, PEER_DK)
    s = jnp.einsum('nhpd,hpkd->nhpk', q, peer_keys).astype(jnp.float32)
    s1, i1 = lax.top_k(s[:, :, 0], PEER_TOPK)
    s2, i2 = lax.top_k(s[:, :, 1], PEER_TOPK)
    cand = (s1[..., :, None] + s2[..., None, :]).reshape(n, PEER_HEADS, PEER_TOPK ** 2)
    cidx = (i1[..., :, None] * PEER_NKEYS + i2[..., None, :]).reshape(n, PEER_HEADS, PEER_TOPK ** 2)
    top_s, top_pos = lax.top_k(cand, PEER_TOPK)
    idx = jnp.take_along_axis(cidx, top_pos, axis=-1)
    g = jax.nn.softmax(top_s, axis=-1)
    pad = (-n) % PEER_BLOCK
    nb = (n + pad) // PEER_BLOCK
    xb = jnp.pad(x2, ((0, pad), (0, 0))).reshape(nb, PEER_BLOCK, D)
    ib = jnp.pad(idx, ((0, pad), (0, 0), (0, 0))).reshape(nb, PEER_BLOCK, PEER_HEADS, PEER_TOPK)
    gb = jnp.pad(g, ((0, pad), (0, 0), (0, 0))).reshape(nb, PEER_BLOCK, PEER_HEADS, PEER_TOPK)

    def expert_block(args):
        xk, ik, gk = args
        act = jax.nn.gelu(jnp.einsum('nd,nhkd->nhk', xk, peer_u[ik]).astype(jnp.float32), approximate=False)
        coef = (gk * act).astype(xk.dtype)
        return jnp.einsum('nhk,nhkd->nd', coef, peer_v[ik])

    out = lax.map(expert_block, (xb, ib, gb)).reshape(nb * PEER_BLOCK, D)[:n]
    return out.reshape(B, T, D)


def trunk_layer(x, c, mstate, pool_buf, pos0, w_ada, b_ada, w_in, b_gate, mh_g, sgu_g, sgu_b, w_s, b_s,
                w_pool, pool_scale, w_o, ln1_g, ln1_b, w_pq, peer_keys, peer_u, peer_v, ln2_g, ln2_b):
    ada = jnp.einsum('bd,de->be', jax.nn.silu(c), w_ada) + b_ada
    sh1, sc1, g1, sh2, sc2, g2 = jnp.split(ada[:, None, :], 6, axis=-1)
    y, mstate, pool_buf, v_rows = token_mixers(x * (1 + sc1) + sh1, mstate, pool_buf, pos0, w_in, b_gate, mh_g,
                                               sgu_g, sgu_b, w_s, b_s, w_pool, pool_scale, w_o)
    x = layer_norm(ALPHA * x + g1 * y, ln1_g, ln1_b)
    y = peer(x * (1 + sc2) + sh2, w_pq, peer_keys, peer_u, peer_v)
    x = layer_norm(ALPHA * x + g2 * y, ln2_g, ln2_b)
    return x, mstate, pool_buf, v_rows


def setup_inputs(seed: int = 0) -> dict:
    key = jax.random.key(seed)
    ks = iter(jax.random.split(key, 32))
    f32 = jnp.float32
    nrm = lambda shape, s: jax.random.normal(next(ks), shape, f32) * s
    D = D_MODEL
    H = MLSTM_HEADS
    fbias = jnp.broadcast_to(jnp.linspace(3.0, 6.0, H), (DEPTH, H))
    b_gate = jnp.concatenate([jnp.zeros((DEPTH, H), f32), fbias], axis=-1)
    return {
        'x_prompt': nrm((BATCH, SEQ, D), 1.0),
        'x_sample': nrm((DEC_BATCH, DEC_SEQ, D), 1.0),
        'state_mlstm_C': nrm((DEPTH, DEC_BATCH, H, MLSTM_DH, MLSTM_DH), 0.1),
        'state_mlstm_n': nrm((DEPTH, DEC_BATCH, H, MLSTM_DH), 0.5),
        'state_mlstm_m': nrm((DEPTH, DEC_BATCH, H), 0.5),
        'state_pool': nrm((DEPTH, DEC_BATCH, POOL_BUF, POOL_WIDTH), 1.0),
        'c_prompt': nrm((BATCH, D), 1.0),
        'c_sample': nrm((DEC_BATCH, D), 1.0),
        'w_ada': nrm((DEPTH, D, 6 * D), 0.5 * D ** -0.5),
        'b_ada': nrm((DEPTH, 6 * D), 0.01),
        'w_in': nrm((DEPTH, D, IN_COLS), D ** -0.5),
        'b_gate': b_gate + nrm((DEPTH, 2 * H), 0.1),
        'mh_g': 1.0 + nrm((DEPTH, MLSTM_WIDTH), 0.01),
        'sgu_g': 1.0 + nrm((DEPTH, SGU_WIDTH), 0.01),
        'sgu_b': nrm((DEPTH, SGU_WIDTH), 0.01),
        'w_s': nrm((DEPTH, SGU_HEADS, SGU_CHUNK, SGU_CHUNK), SGU_CHUNK ** -0.5),
        'b_s': 1.0 + nrm((DEPTH, SGU_HEADS, SGU_CHUNK), 0.01),
        'w_pool': nrm((DEPTH, POOL_GROUPS, POOL_DG, POOL_DG), POOL_DG ** -0.5),
        'pool_scale': 1.0 + nrm((DEPTH, POOL_WIDTH), 0.01),
        'w_o': nrm((DEPTH, D, D), BETA * D ** -0.5),
        'ln1_g': 1.0 + nrm((DEPTH, D), 0.01),
        'ln1_b': nrm((DEPTH, D), 0.01),
        'w_pq': nrm((DEPTH, D, PEER_HEADS * PEER_DQ), D ** -0.5),
        'peer_keys': nrm((DEPTH, PEER_HEADS, 2, PEER_NKEYS, PEER_DK), PEER_DK ** -0.5),
        'peer_u': nrm((DEPTH, PEER_EXPERTS, D), D ** -0.5),
        'peer_v': nrm((DEPTH, PEER_EXPERTS, D), BETA * PEER_HEADS ** -0.5),
        'ln2_g': 1.0 + nrm((DEPTH, D), 0.01),
        'ln2_b': nrm((DEPTH, D), 0.01),
    }


def reference(x_prompt, x_sample, state_mlstm_C, state_mlstm_n, state_mlstm_m, state_pool, c_prompt, c_sample,
              w_ada, b_ada, w_in, b_gate, mh_g, sgu_g, sgu_b, w_s, b_s, w_pool, pool_scale, w_o, ln1_g, ln1_b,
              w_pq, peer_keys, peer_u, peer_v, ln2_g, ln2_b):
    f32 = jnp.float32
    Bp = x_prompt.shape[0]
    xp, xs = x_prompt, x_sample
    pC, pn, pm, pp, sC, sn, sm, sp, sv = ([] for _ in range(9))
    for l in range(DEPTH):
        lp = (w_ada[l], b_ada[l], w_in[l], b_gate[l], mh_g[l], sgu_g[l], sgu_b[l], w_s[l], b_s[l], w_pool[l],
              pool_scale[l], w_o[l], ln1_g[l], ln1_b[l], w_pq[l], peer_keys[l], peer_u[l], peer_v[l], ln2_g[l], ln2_b[l])
        st0 = (jnp.zeros((Bp, MLSTM_HEADS, MLSTM_DH, MLSTM_DH), f32),
               jnp.zeros((Bp, MLSTM_HEADS, MLSTM_DH), f32),
               jnp.zeros((Bp, MLSTM_HEADS), f32))
        buf0 = jnp.zeros((Bp, 0, POOL_WIDTH), x_prompt.dtype)
        xp, (C, n, m), buf, _ = trunk_layer(xp, c_prompt, st0, buf0, 0, *lp)
        pC.append(C); pn.append(n); pm.append(m); pp.append(buf)
        st = (state_mlstm_C[l].astype(f32), state_mlstm_n[l].astype(f32), state_mlstm_m[l].astype(f32))
        xs, (C, n, m), buf, v_rows = trunk_layer(xs, c_sample, st, state_pool[l], PAST_LEN, *lp)
        sC.append(C); sn.append(n); sm.append(m); sp.append(buf); sv.append(v_rows)
    return (xp, xs, jnp.stack(pC), jnp.stack(pn), jnp.stack(pm), jnp.stack(pp),
            jnp.stack(sC), jnp.stack(sn), jnp.stack(sm), jnp.stack(sp), jnp.stack(sv))
```

```cpp
#include <hip/hip_runtime.h>
#include <hip/hip_cooperative_groups.h>
#include <cstdio>
#include <cstdint>
namespace cg = cooperative_groups;

typedef unsigned short bf16_t;
typedef __attribute__((ext_vector_type(8))) short bf16x8;
typedef __attribute__((ext_vector_type(16))) float f32x16;
typedef __attribute__((ext_vector_type(2))) __bf16 bf2_t;
typedef __attribute__((ext_vector_type(2))) float f32x2;
#define DI __device__ __forceinline__
#define MFMA32(a, b, c) __builtin_amdgcn_mfma_f32_32x32x16_bf16((a), (b), (c), 0, 0, 0)

constexpr int NP = 16384, NS = 512, NT = 16896;
constexpr int NIN = 2944;
constexpr int FS = 776;
constexpr float ALPHA = 1.4142135623730951f;
constexpr float LN_EPS = 1e-5f;
constexpr int CHS = 129 * 128;

struct Params {
  const float *x_prompt, *x_sample, *stC, *stN, *stM, *stPool, *c_prompt, *c_sample;
  const float *w_ada, *b_ada, *w_in, *b_gate, *mh_g, *sgu_g, *sgu_b, *w_s, *b_s, *w_pool, *pool_scale, *w_o,
      *ln1_g, *ln1_b, *w_pq, *peer_keys, *peer_u, *peer_v, *ln2_g, *ln2_b;
  float* out;
  float* ada;
  bf16_t *WinT, *WoT, *WpqT, *keysb, *hbf, *qkvo, *KT, *VT;
  unsigned char *Uq, *Vq, *xq;
  float *uscale, *vscale, *xscale;
  float *F, *CH, *scal, *mstart, *XZ, *pgate;
  int* pidx;
  unsigned* bar;
};

constexpr size_t O_YP = 0;
constexpr size_t O_YS = 16777216;
constexpr size_t O_CP = O_YS + 524288;
constexpr size_t O_NP = O_CP + 1048576;
constexpr size_t O_MP = O_NP + 8192;
constexpr size_t O_PP = O_MP + 64;
constexpr size_t O_CS = O_PP + 61440;
constexpr size_t O_NS = O_CS + 16777216;
constexpr size_t O_MS = O_NS + 131072;
constexpr size_t O_PS = O_MS + 1024;
constexpr size_t O_SV = O_PS + 983040;

DI int tidx() { int t = threadIdx.x; asm volatile("" : "+v"(t)); return t; }
DI int bidx() { int b = blockIdx.x; asm volatile("" : "+s"(b)); return b; }
DI unsigned f2bf(float x) { unsigned u = __float_as_uint(x); u += 0x7fffu + ((u >> 16) & 1u); return u >> 16; }
DI unsigned pack2(float a, float b) { return f2bf(a) | (f2bf(b) << 16); }
DI float bflo(unsigned u) { return __uint_as_float(u << 16); }
DI float bfhi(unsigned u) { return __uint_as_float(u & 0xffff0000u); }
DI float bf2f(bf16_t h) { return __uint_as_float(((unsigned)h) << 16); }
DI uint4 pack8(const float* v) { return make_uint4(pack2(v[0], v[1]), pack2(v[2], v[3]), pack2(v[4], v[5]), pack2(v[6], v[7])); }
DI void unpack8(uint4 u, float* v) {
  v[0] = bflo(u.x); v[1] = bfhi(u.x); v[2] = bflo(u.y); v[3] = bfhi(u.y);
  v[4] = bflo(u.z); v[5] = bfhi(u.z); v[6] = bflo(u.w); v[7] = bfhi(u.w);
}
DI int crow(int reg, int h) { return (reg & 3) + 8 * (reg >> 2) + 4 * h; }
DI int cond_row(int tok) { return tok < NP ? (tok >> 11) : 8 + ((tok - NP) >> 2); }
DI int dpp_xor1(int x) { return __builtin_amdgcn_update_dpp(0, x, 0xB1, 0xF, 0xF, true); }
DI int dpp_xor2(int x) { return __builtin_amdgcn_update_dpp(0, x, 0x4E, 0xF, 0xF, true); }
DI int dpp_xor4(int x) { return __builtin_amdgcn_update_dpp(0, __builtin_amdgcn_update_dpp(0, x, 0x141, 0xF, 0xF, true), 0x1B, 0xF, 0xF, true); }
DI int dpp_xor8(int x) { return __builtin_amdgcn_update_dpp(0, x, 0x128, 0xF, 0xF, true); }
DI float dpp_xor8f(float x) { return __builtin_bit_cast(float, dpp_xor8(__builtin_bit_cast(int, x))); }
DI float wsum(float v) { for (int o = 32; o > 0; o >>= 1) v += __shfl_xor(v, o); return v; }
DI float wmax(float v) { for (int o = 32; o > 0; o >>= 1) v = fmaxf(v, __shfl_xor(v, o)); return v; }
DI float sigmoidf_(float x) { return 1.f / (1.f + __expf(-x)); }
DI float logsigmoidf_(float x) { return fminf(x, 0.f) - log1pf(__expf(-fabsf(x))); }
DI float dot2bf(unsigned a, unsigned b, float c) {
  return __builtin_amdgcn_fdot2_f32_bf16(__builtin_bit_cast(bf2_t, a), __builtin_bit_cast(bf2_t, b), c, false);
}
DI bf16x8 ld8(const bf16_t* p) { return __builtin_bit_cast(bf16x8, *(const uint4*)p); }
DI void ld8f(const float* p, float* v) {
  float4 a = ((const float4*)p)[0], b = ((const float4*)p)[1];
  v[0] = a.x; v[1] = a.y; v[2] = a.z; v[3] = a.w; v[4] = b.x; v[5] = b.y; v[6] = b.z; v[7] = b.w;
}
DI void st8f(float* p, const float* v) {
  ((float4*)p)[0] = make_float4(v[0], v[1], v[2], v[3]); ((float4*)p)[1] = make_float4(v[4], v[5], v[6], v[7]);
}

template <class Epi>
DI void gemm128(const bf16_t* __restrict__ A, const bf16_t* __restrict__ Bt, int m0, int n0, char* smem, const Epi& epi) {
  const int tid = tidx(), lane = tid & 63, w = tid >> 6, wm = w >> 1, wn = w & 1, r = lane & 31, h = lane >> 5;
  bf16_t* As = (bf16_t*)smem;
  bf16_t* Bs = As + 128 * 72;
  f32x16 acc[2][2];
#pragma unroll
  for (int i = 0; i < 2; ++i)
#pragma unroll
    for (int j = 0; j < 2; ++j)
#pragma unroll
      for (int e = 0; e < 16; ++e) acc[i][j][e] = 0.f;
  typedef __attribute__((ext_vector_type(4))) unsigned u32x4;
  u32x4 ra0, ra1, ra2, ra3, rb0, rb1, rb2, rb3;
  u32x4 sa0, sa1, sa2, sa3, sb0, sb1, sb2, sb3;
  const int prow = tid >> 3, pc = (tid & 7) * 8;
  const bf16_t* ap = A + (size_t)(m0 + prow) * 1024 + pc;
  const bf16_t* bp = Bt + (size_t)(n0 + prow) * 1024 + pc;
#define GLD(P, k0_)                                                                                          \
  P##a0 = *(const u32x4*)(ap + (k0_)); P##a1 = *(const u32x4*)(ap + 32 * 1024 + (k0_));                      \
  P##a2 = *(const u32x4*)(ap + 64 * 1024 + (k0_)); P##a3 = *(const u32x4*)(ap + 96 * 1024 + (k0_));         \
  P##b0 = *(const u32x4*)(bp + (k0_)); P##b1 = *(const u32x4*)(bp + 32 * 1024 + (k0_));                      \
  P##b2 = *(const u32x4*)(bp + 64 * 1024 + (k0_)); P##b3 = *(const u32x4*)(bp + 96 * 1024 + (k0_));
#define LST(P)                                                                                               \
  *(u32x4*)(As + (prow) * 72 + pc) = P##a0; *(u32x4*)(As + (prow + 32) * 72 + pc) = P##a1;                   \
  *(u32x4*)(As + (prow + 64) * 72 + pc) = P##a2; *(u32x4*)(As + (prow + 96) * 72 + pc) = P##a3;              \
  *(u32x4*)(Bs + (prow) * 72 + pc) = P##b0; *(u32x4*)(Bs + (prow + 32) * 72 + pc) = P##b1;                   \
  *(u32x4*)(Bs + (prow + 64) * 72 + pc) = P##b2; *(u32x4*)(Bs + (prow + 96) * 72 + pc) = P##b3;
  GLD(r, 0)
  __builtin_amdgcn_sched_barrier(0);
  GLD(s, 64)
  __builtin_amdgcn_sched_barrier(0);
#define GEMM_COMPUTE()                                                                                       \
  _Pragma("unroll") for (int ks = 0; ks < 4; ++ks) {                                                         \
    bf16x8 a[2], b[2];                                                                                       \
    _Pragma("unroll") for (int i = 0; i < 2; ++i) a[i] = ld8(As + (wm * 64 + i * 32 + r) * 72 + ks * 16 + h * 8); \
    _Pragma("unroll") for (int j = 0; j < 2; ++j) b[j] = ld8(Bs + (wn * 64 + j * 32 + r) * 72 + ks * 16 + h * 8); \
    _Pragma("unroll") for (int i = 0; i < 2; ++i)                                                            \
      _Pragma("unroll") for (int j = 0; j < 2; ++j) acc[i][j] = MFMA32(a[i], b[j], acc[i][j]);               \
  }
#pragma unroll 1
  for (int kt = 0; kt < 16; kt += 2) {
    __syncthreads();
    LST(r)
    __syncthreads();
    { const int k0 = (kt + 2 < 16 ? kt + 2 : 14) * 64; GLD(r, k0) }
    __builtin_amdgcn_sched_barrier(0);
    GEMM_COMPUTE()
    __syncthreads();
    LST(s)
    __syncthreads();
    { const int k0 = (kt + 3 < 16 ? kt + 3 : 15) * 64; GLD(s, k0) }
    __builtin_amdgcn_sched_barrier(0);
    GEMM_COMPUTE()
  }
#pragma unroll
  for (int i = 0; i < 2; ++i)
#pragma unroll
    for (int j = 0; j < 2; ++j)
#pragma unroll
      for (int g = 0; g < 4; ++g)
        epi(m0 + wm * 64 + i * 32 + 8 * g + 4 * h, n0 + wn * 64 + j * 32 + r, acc[i][j][4 * g], acc[i][j][4 * g + 1],
            acc[i][j][4 * g + 2], acc[i][j][4 * g + 3]);
}

DI void phase0(const Params& p, char* smem) {
  const int tid = tidx(), G = gridDim.x;
  auto do_ada = [&]() __attribute__((always_inline)) {
    float* S = (float*)smem;
    const int lane = tid & 63, w = tid >> 6;
    for (int it0 = bidx(); it0 < 2 * 24 * 9; it0 += G) {
      int it = it0;
      if ((G & 7) == 0 && G >= 512) {
        const int x = it0 & 7, slot = it0 >> 3;
        if (slot >= 54) continue;
        it = ((slot / 9) * 8 + x) * 9 + slot % 9;
      }
      const int l = it / 216, rem = it % 216, cb = rem / 9, rg = rem % 9;
      float acc[64];
#pragma unroll
      for (int i = 0; i < 64; ++i) acc[i] = 0.f;
      for (int half = 0; half < 2; ++half) {
#pragma unroll
        for (int q = 0; q < 16; ++q) {
          const int row = rg * 16 + q, rowc = row < 136 ? row : 135;
          const float* cp = (rowc < 8 ? p.c_prompt + rowc * 1024 : p.c_sample + (rowc - 8) * 1024) + half * 512;
          const float m = row < 136 ? 1.f : 0.f;
#pragma unroll
          for (int j = 0; j < 2; ++j) { const float c = cp[tid + 256 * j]; S[(tid + 256 * j) * 16 + q] = m * c / (1.f + __expf(-c)); }
        }
        __syncthreads();
        const float* wp = p.w_ada + ((size_t)l * 1024 + half * 512 + w * 128) * 6144 + cb * 256 + lane * 4;
        const float* sp = S + w * 128 * 16;
#pragma unroll 8
        for (int kk = 0; kk < 128; ++kk) {
          const float4 wv = *(const float4*)(wp + (size_t)kk * 6144);
#pragma unroll
          for (int q4 = 0; q4 < 4; ++q4) {
            const float4 s4 = *(const float4*)(sp + kk * 16 + q4 * 4);
            acc[(q4 * 4 + 0) * 4 + 0] += s4.x * wv.x; acc[(q4 * 4 + 0) * 4 + 1] += s4.x * wv.y; acc[(q4 * 4 + 0) * 4 + 2] += s4.x * wv.z; acc[(q4 * 4 + 0) * 4 + 3] += s4.x * wv.w;
            acc[(q4 * 4 + 1) * 4 + 0] += s4.y * wv.x; acc[(q4 * 4 + 1) * 4 + 1] += s4.y * wv.y; acc[(q4 * 4 + 1) * 4 + 2] += s4.y * wv.z; acc[(q4 * 4 + 1) * 4 + 3] += s4.y * wv.w;
            acc[(q4 * 4 + 2) * 4 + 0] += s4.z * wv.x; acc[(q4 * 4 + 2) * 4 + 1] += s4.z * wv.y; acc[(q4 * 4 + 2) * 4 + 2] += s4.z * wv.z; acc[(q4 * 4 + 2) * 4 + 3] += s4.z * wv.w;
            acc[(q4 * 4 + 3) * 4 + 0] += s4.w * wv.x; acc[(q4 * 4 + 3) * 4 + 1] += s4.w * wv.y; acc[(q4 * 4 + 3) * 4 + 2] += s4.w * wv.z; acc[(q4 * 4 + 3) * 4 + 3] += s4.w * wv.w;
          }
        }
        __syncthreads();
      }
      const float4 bb = *(const float4*)(p.b_ada + l * 6144 + cb * 256 + lane * 4);
#pragma unroll
      for (int pass = 0; pass < 2; ++pass) {
#pragma unroll
        for (int j = 0; j < 32; ++j) S[(w * 32 + j) * 64 + lane] = acc[pass * 32 + j];
        __syncthreads();
#pragma unroll
        for (int rr = 0; rr < 2; ++rr) {
          const int r = 2 * w + rr, row = rg * 16 + pass * 8 + r;
          float o[4];
#pragma unroll
          for (int c = 0; c < 4; ++c) o[c] = S[(0 * 32 + r * 4 + c) * 64 + lane] + S[(1 * 32 + r * 4 + c) * 64 + lane] + S[(2 * 32 + r * 4 + c) * 64 + lane] + S[(3 * 32 + r * 4 + c) * 64 + lane];
          if (row < 136) *(float4*)(p.ada + ((size_t)l * 136 + row) * 6144 + cb * 256 + lane * 4) = make_float4(o[0] + bb.x, o[1] + bb.y, o[2] + bb.z, o[3] + bb.w);
        }
        __syncthreads();
      }
    }
  };
  auto do_transposes = [&]() __attribute__((always_inline)) {
    float* T = (float*)smem;
    for (int it = bidx(); it < 3008; it += G) {
      const int l = it / 1504; int j = it % 1504;
      const float* src; bf16_t* dst; int ldsrc, kind;
      if (j < 736) { kind = 0; src = p.w_in + (size_t)l * 1024 * 2824; ldsrc = 2824; dst = p.WinT + (size_t)l * NIN * 1024; }
      else if (j < 992) { j -= 736; kind = 1; src = p.w_o + (size_t)l * 1024 * 1024; ldsrc = 1024; dst = p.WoT + (size_t)l * 1024 * 1024; }
      else { j -= 992; kind = 2; src = p.w_pq + (size_t)l * 1024 * 2048; ldsrc = 2048; dst = p.WpqT + (size_t)l * 2048 * 1024; }
      const int nt = j >> 4, kt = j & 15;
      const int tn = tid & 63, tk0 = tid >> 6;
      const int n = nt * 64 + tn;
      int e = n;
      if (kind == 0) e = n < 2048 ? n : (n < 2816 ? n + 8 : (n < 2824 ? 2048 + (n - 2816) : -1));
#pragma unroll
      for (int i = 0; i < 16; ++i) { const int k = tk0 + 4 * i; T[k * 65 + tn] = e >= 0 ? src[(size_t)(kt * 64 + k) * ldsrc + e] : 0.f; }
      __syncthreads();
      const int nn = tid >> 2, kq = (tid & 3) * 16;
      unsigned pk[8];
#pragma unroll
      for (int q = 0; q < 8; ++q) pk[q] = pack2(T[(kq + 2 * q) * 65 + nn], T[(kq + 2 * q + 1) * 65 + nn]);
      uint4* d4 = (uint4*)(dst + (size_t)(nt * 64 + nn) * 1024 + kt * 64 + kq);
      d4[0] = make_uint4(pk[0], pk[1], pk[2], pk[3]);
      d4[1] = make_uint4(pk[4], pk[5], pk[6], pk[7]);
      __syncthreads();
    }
  };
  auto do_quant = [&]() __attribute__((always_inline)) {
    const size_t nk8 = 524288 / 8;
    for (size_t i = (size_t)bidx() * 256 + tid; i < nk8; i += (size_t)G * 256) {
      const float* s = p.peer_keys + i * 8;
      const float4 a = ((const float4*)s)[0], b = ((const float4*)s)[1];
      *(uint4*)(p.keysb + i * 8) = make_uint4(pack2(a.x, a.y), pack2(a.z, a.w), pack2(b.x, b.y), pack2(b.z, b.w));
    }
    const int lane = tid & 63, w = tid >> 6;
    for (int row0 = (bidx() * 4 + w) * 2; row0 < 65536; row0 += G * 8) {
      float v[2][16];
#pragma unroll
      for (int r = 0; r < 2; ++r) {
        const int row = row0 + r; const int tab = row >> 15, le = row & 32767;
        const float* src = (tab ? p.peer_v : p.peer_u) + (size_t)le * 1024 + lane * 16;
        ld8f(src, v[r]); ld8f(src + 8, v[r] + 8);
      }
#pragma unroll
      for (int r = 0; r < 2; ++r) {
        const int row = row0 + r; const int tab = row >> 15, le = row & 32767, l = le >> 14, e = le & 16383;
        float m = 0.f;
#pragma unroll
        for (int j = 0; j < 16; ++j) m = fmaxf(m, fabsf(v[r][j]));
        m = wmax(m);
        unsigned wd[4];
        if (tab == 0) {
          const float inv = m > 0.f ? 127.f / m : 0.f;
#pragma unroll
          for (int q = 0; q < 4; ++q) {
            const int q0 = (int)rintf(v[r][4 * q] * inv), q1 = (int)rintf(v[r][4 * q + 1] * inv), q2 = (int)rintf(v[r][4 * q + 2] * inv), q3 = (int)rintf(v[r][4 * q + 3] * inv);
            wd[q] = (unsigned)(q0 & 255) | ((unsigned)(q1 & 255) << 8) | ((unsigned)(q2 & 255) << 16) | ((unsigned)(q3 & 255) << 24);
          }
          if (lane == 0) p.uscale[le] = m * (1.f / 127.f);
        } else {
          const float inv = m > 0.f ? 400.f / m : 0.f;
#pragma unroll
          for (int q = 0; q < 4; ++q) {
            int pk = __builtin_amdgcn_cvt_pk_fp8_f32(v[r][4 * q] * inv, v[r][4 * q + 1] * inv, 0, false);
            pk = __builtin_amdgcn_cvt_pk_fp8_f32(v[r][4 * q + 2] * inv, v[r][4 * q + 3] * inv, pk, true);
            wd[q] = (unsigned)pk;
          }
          if (lane == 0) p.vscale[le] = m * (1.f / 400.f);
        }
        unsigned char* dst = (tab ? p.Vq : p.Uq) + (((size_t)(l * 8 + (lane >> 3)) * 16384 + e) << 7) + (lane & 7) * 16;
        *(uint4*)dst = make_uint4(wd[0], wd[1], wd[2], wd[3]);
      }
    }
  };
  if ((bidx() / (gridDim.x >> 1)) & 1) { do_quant(); do_transposes(); do_ada(); }
  else { do_ada(); do_transposes(); do_quant(); }
}

DI void mod_store(bf16_t* dst, const float* x, const float* sc, const float* sh) {
  float s[8], t[8], o[8];
  ld8f(sc, s); ld8f(sh, t);
#pragma unroll
  for (int j = 0; j < 8; ++j) o[j] = x[j] * (1.f + s[j]) + t[j];
  *(uint4*)dst = pack8(o);
}

DI void phase1(const Params& p) {
  const int tid = tidx(), lane = tid & 63, w = tid >> 6;
  for (int tok = bidx() * 4 + w; tok < NT; tok += gridDim.x * 4) {
    const float* xr = tok < NP ? p.x_prompt + (size_t)tok * 1024 : p.x_sample + (size_t)(tok - NP) * 1024;
    const float* ad = p.ada + (size_t)cond_row(tok) * 6144;
#pragma unroll
    for (int hf = 0; hf < 2; ++hf) {
      const int c = hf * 512 + lane * 8;
      float x[8]; ld8f(xr + c, x);
      mod_store(p.hbf + (size_t)tok * 1024 + c, x, ad + 1024 + c, ad + c);
    }
  }
}

DI void tile_decode(int u, int NTL, int& mt, int& nt) {
  const int per_mg = 8 * NTL;
  const int mg = u / per_mg; int v = u - mg * per_mg;
  const int rm = min(8, 132 - 8 * mg);
  int ng = 0;
  for (;;) { const int cn = min(8, NTL - 8 * ng); const int sz = rm * cn; if (v < sz) { mt = 8 * mg + v / cn; nt = 8 * ng + v % cn; return; } v -= sz; ++ng; }
}
template <class Epi>
DI void gemm_phase(const bf16_t* A, const bf16_t* Bt, int NTL, char* smem, const Epi& epi) {
  const int T = 132 * NTL, G = gridDim.x, bx = bidx();
  if ((G & 7) == 0) {
    const int x = bx & 7, slot = bx >> 3, per = G >> 3;
    const int lo = (int)(((long long)T * x) >> 3), hi = (int)(((long long)T * (x + 1)) >> 3);
    for (int u = lo + slot; u < hi; u += per) { int mt, nt; tile_decode(u, NTL, mt, nt); gemm128(A, Bt, mt * 128, nt * 128, smem, epi); }
  } else {
    for (int t = bx; t < T; t += G) { const int mt = t / NTL, nt = t % NTL; gemm128(A, Bt, mt * 128, nt * 128, smem, epi); }
  }
}

struct EpiA {
  const Params& p; const float* bg;
  DI void operator()(int row4, int col, float v0, float v1, float v2, float v3) const {
    if (col < 2048) {
      const float s = col < 512 ? 0.08838834764831845f : 1.f;
      bf16_t* q = p.qkvo + (size_t)row4 * 2048 + col;
      if (!(col >= 1024 && col < 1536 && row4 < NP)) {
        q[0] = (bf16_t)f2bf(v0 * s); q[2048] = (bf16_t)f2bf(v1 * s); q[4096] = (bf16_t)f2bf(v2 * s); q[6144] = (bf16_t)f2bf(v3 * s);
      }
      if (col >= 512 && col < 1536 && row4 < NP) {
        int cc = col - 512; bf16_t* T = cc < 512 ? p.KT : p.VT; cc &= 511;
        const int hh = cc >> 7, d = cc & 127, b = row4 >> 11, t = row4 & 2047;
        *(uint2*)(T + ((size_t)((b * 4 + hh) * 128 + d)) * 2048 + t) = make_uint2(pack2(v0, v1), pack2(v2, v3));
      }
    } else if (col < 2816) {
      float* f = p.F + (size_t)row4 * FS + (col - 2048);
      f[0] = v0; f[FS] = v1; f[2 * FS] = v2; f[3 * FS] = v3;
    } else if (col < 2824) {
      const int g = col - 2816; const float bb = bg[g];
      float* f = p.F + (size_t)row4 * FS + 768 + g;
      f[0] = v0 + bb; f[FS] = v1 + bb; f[2 * FS] = v2 + bb; f[3 * FS] = v3 + bb;
    }
  }
};
DI void phaseA(const Params& p, int l, char* smem) {
  const bf16_t* Bt = p.WinT + (size_t)l * NIN * 1024;
  EpiA epi{p, p.b_gate + l * 8};
  gemm_phase(p.hbf, Bt, 23, smem, epi);
}

struct EpiC {
  const Params& p; const float* adaL; int l;
  DI void operator()(int row4, int col, float v0, float v1, float v2, float v3) const {
    const float* xr = (l == 0) ? (row4 < NP ? p.x_prompt + (size_t)row4 * 1024 : p.x_sample + (size_t)(row4 - NP) * 1024)
                               : p.XZ + (size_t)row4 * 1024;
    const float g1 = adaL[(size_t)cond_row(row4) * 6144 + 2048 + col];
    const float x0 = xr[col], x1 = xr[1024 + col], x2 = xr[2048 + col], x3 = xr[3072 + col];
    float* z = p.XZ + (size_t)row4 * 1024 + col;
    z[0] = ALPHA * x0 + g1 * v0; z[1024] = ALPHA * x1 + g1 * v1; z[2048] = ALPHA * x2 + g1 * v2; z[3072] = ALPHA * x3 + g1 * v3;
  }
};
DI void phaseC(const Params& p, int l, char* smem) {
  const bf16_t* Bt = p.WoT + (size_t)l * 1024 * 1024;
  EpiC epi{p, p.ada + (size_t)l * 136 * 6144, l};
  gemm_phase(p.hbf, Bt, 8, smem, epi);
}

struct EpiE {
  const Params& p;
  DI void operator()(int row4, int col, float v0, float v1, float v2, float v3) const {
    bf16_t* q = p.qkvo + (size_t)row4 * 2048 + col;
    q[0] = (bf16_t)f2bf(v0); q[2048] = (bf16_t)f2bf(v1); q[4096] = (bf16_t)f2bf(v2); q[6144] = (bf16_t)f2bf(v3);
  }
};
DI void phaseE(const Params& p, int l, char* smem) {
  const bf16_t* Bt = p.WpqT + (size_t)l * 2048 * 1024;
  EpiE epi{p};
  gemm_phase(p.hbf, Bt, 16, smem, epi);
}

DI void phaseD(const Params& p, int l) {
  const int tid = tidx(), lane = tid & 63, w = tid >> 6;
  const float* adaL = p.ada + (size_t)l * 136 * 6144;
  const float* g = p.ln1_g + l * 1024; const float* bta = p.ln1_b + l * 1024;
  for (int tok = bidx() * 4 + w; tok < NT; tok += gridDim.x * 4) {
    float* zr = p.XZ + (size_t)tok * 1024;
    const int c0 = lane * 8, c1 = 512 + lane * 8;
    float z[16]; ld8f(zr + c0, z); ld8f(zr + c1, z + 8);
    float s = 0.f;
#pragma unroll
    for (int j = 0; j < 16; ++j) s += z[j];
    const float mu = wsum(s) * (1.f / 1024.f);
    float q = 0.f;
#pragma unroll
    for (int j = 0; j < 16; ++j) { const float d = z[j] - mu; q += d * d; }
    const float rstd = rsqrtf(wsum(q) * (1.f / 1024.f) + LN_EPS);
    float gg[16], bb[16];
    ld8f(g + c0, gg); ld8f(g + c1, gg + 8); ld8f(bta + c0, bb); ld8f(bta + c1, bb + 8);
#pragma unroll
    for (int j = 0; j < 16; ++j) z[j] = (z[j] - mu) * rstd * gg[j] + bb[j];
    st8f(zr + c0, z); st8f(zr + c1, z + 8);
    const float* ad = adaL + (size_t)cond_row(tok) * 6144;
    float sc[16], sh[16], hv[16];
    ld8f(ad + 4096 + c0, sc); ld8f(ad + 4096 + c1, sc + 8); ld8f(ad + 3072 + c0, sh); ld8f(ad + 3072 + c1, sh + 8);
    float hm = 0.f;
#pragma unroll
    for (int j = 0; j < 16; ++j) { hv[j] = z[j] * (1.f + sc[j]) + sh[j]; hm = fmaxf(hm, fabsf(hv[j])); }
    *(uint4*)(p.hbf + (size_t)tok * 1024 + c0) = pack8(hv);
    *(uint4*)(p.hbf + (size_t)tok * 1024 + c1) = pack8(hv + 8);
    hm = wmax(hm);
    const float hinv = hm > 0.f ? 127.f / hm : 0.f;
    unsigned qw[4];
#pragma unroll
    for (int q = 0; q < 4; ++q) {
      const int q0 = (int)rintf(hv[4 * q] * hinv), q1 = (int)rintf(hv[4 * q + 1] * hinv), q2 = (int)rintf(hv[4 * q + 2] * hinv), q3 = (int)rintf(hv[4 * q + 3] * hinv);
      qw[q] = (unsigned)(q0 & 255) | ((unsigned)(q1 & 255) << 8) | ((unsigned)(q2 & 255) << 16) | ((unsigned)(q3 & 255) << 24);
    }
    *(uint2*)(p.xq + (size_t)tok * 1024 + c0) = make_uint2(qw[0], qw[1]);
    *(uint2*)(p.xq + (size_t)tok * 1024 + c1) = make_uint2(qw[2], qw[3]);
    if (lane == 0) p.xscale[tok] = hm * (1.f / 127.f);
  }
}

DI void mlstm_i(const Params& p, int l, int item, char* smem) {
  const int tid = tidx(), lane = tid & 63, w = tid >> 6, r = lane & 31, h = lane >> 5;
  const int bh = item >> 5, c = item & 31, b = bh >> 2, hh = bh & 3;
  const int tok0 = b * 2048 + c * 64;
  float* wc = (float*)smem;
  bf16_t* Vs = (bf16_t*)(smem + 256);
  bf16_t* Ks = Vs + 128 * 72;
  {
#pragma unroll
    for (int i = 0; i < 4; ++i) {
      const int pc = tid + 256 * i, row = pc >> 3, cc = (pc & 7) * 8;
      *(uint4*)(Vs + row * 72 + cc) = *(const uint4*)(p.VT + ((size_t)(bh * 128 + row)) * 2048 + c * 64 + cc);
      *(uint4*)(Ks + row * 72 + cc) = *(const uint4*)(p.KT + ((size_t)(bh * 128 + row)) * 2048 + c * 64 + cc);
    }
  }
  if (w == 0) {
    const float* f = p.F + (size_t)(tok0 + lane) * FS + 768;
    const float gi = f[hh], gf = f[4 + hh];
    float x = logsigmoidf_(gf);
#pragma unroll
    for (int o = 1; o < 64; o <<= 1) { const float t = __shfl_up(x, o); if (lane >= o) x += t; }
    const float bend = __shfl(x, 63);
    const float dend = bend - x + gi;
    const float mloc = wmax(dend);
    wc[lane] = __expf(dend - mloc);
    if (lane == 0) { p.scal[(bh * 32 + c) * 2] = bend; p.scal[(bh * 32 + c) * 2 + 1] = mloc; }
  }
  __syncthreads();
  const int vi = w >> 1, ki = w & 1;
  f32x16 acc[2][2];
#pragma unroll
  for (int i = 0; i < 2; ++i)
#pragma unroll
    for (int j = 0; j < 2; ++j)
#pragma unroll
      for (int e = 0; e < 16; ++e) acc[i][j][e] = 0.f;
  const bf16_t* vt = Vs + (vi * 64 + r) * 72 + h * 8;
  const bf16_t* kt = Ks + (ki * 64 + r) * 72 + h * 8;
#pragma unroll
  for (int ks = 0; ks < 4; ++ks) {
    float wv[8];
#pragma unroll
    for (int j = 0; j < 8; ++j) wv[j] = wc[ks * 16 + h * 8 + j];
    bf16x8 a[2], bb[2];
#pragma unroll
    for (int i = 0; i < 2; ++i) {
      const uint4 u = *(const uint4*)(vt + i * 32 * 72 + ks * 16);
      float x[8]; unpack8(u, x);
#pragma unroll
      for (int j = 0; j < 8; ++j) x[j] *= wv[j];
      a[i] = __builtin_bit_cast(bf16x8, pack8(x));
    }
#pragma unroll
    for (int j = 0; j < 2; ++j) bb[j] = ld8(kt + j * 32 * 72 + ks * 16);
#pragma unroll
    for (int i = 0; i < 2; ++i)
#pragma unroll
      for (int j = 0; j < 2; ++j) acc[i][j] = MFMA32(a[i], bb[j], acc[i][j]);
  }
  float* ch = p.CH + (size_t)(bh * 32 + c) * CHS;
#pragma unroll
  for (int i = 0; i < 2; ++i)
#pragma unroll
    for (int j = 0; j < 2; ++j)
#pragma unroll
      for (int e = 0; e < 16; ++e) ch[(vi * 64 + i * 32 + crow(e, h)) * 128 + ki * 64 + j * 32 + r] = acc[i][j][e];
  if (tid < 128) {
    float s = 0.f;
#pragma unroll
    for (int q = 0; q < 8; ++q) {
      float x[8]; unpack8(*(const uint4*)(Ks + tid * 72 + q * 8), x);
#pragma unroll
      for (int j = 0; j < 8; ++j) s += wc[q * 8 + j] * x[j];
    }
    ch[128 * 128 + tid] = s;
  }
  __syncthreads();
}

DI void phaseB2(const Params& p, int l) {
  const int tid = tidx();
  for (int it = bidx(); it < 32 * 17; it += gridDim.x) {
    const int bh = it / 17, sl = it % 17;
    const int e4 = sl * 256 + tid;
    if (e4 >= 4128) continue;
    float m = 0.f;
    float4 C = make_float4(0.f, 0.f, 0.f, 0.f);
    float4* base = (float4*)(p.CH + (size_t)bh * 32 * CHS) + e4;
#pragma unroll 4
    for (int c = 0; c < 32; ++c) {
      const float bend = p.scal[(bh * 32 + c) * 2], mloc = p.scal[(bh * 32 + c) * 2 + 1];
      float4* q = base + (size_t)c * (CHS / 4);
      const float4 d = *q;
      *q = C;
      if (e4 == 0) p.mstart[bh * 32 + c] = m;
      const float mn = fmaxf(bend + m, mloc);
      const float dec = __expf(bend + m - mn), sc = __expf(mloc - mn);
      C.x = dec * C.x + sc * d.x; C.y = dec * C.y + sc * d.y; C.z = dec * C.z + sc * d.z; C.w = dec * C.w + sc * d.w;
      m = mn;
    }
    if (e4 < 4096) *((float4*)(p.out + O_CP + (size_t)(l * 32 + bh) * 16384) + e4) = C;
    else *((float4*)(p.out + O_NP + (size_t)(l * 32 + bh) * 128) + (e4 - 4096)) = C;
    if (e4 == 0) p.out[O_MP + l * 32 + bh] = m;
  }
}

DI void mlstm_iii(const Params& p, int l, int item, char* smem) {
  const int tid = tidx(), lane = tid & 63, w = tid >> 6, r = lane & 31, h = lane >> 5;
  const int bh = item >> 5, c = item & 31, b = bh >> 2, hh = bh & 3;
  const int tok0 = b * 2048 + c * 64;
  bf16_t* Qs = (bf16_t*)smem;
  bf16_t* As = (bf16_t*)(smem + 17408);
  float* Hs = (float*)(smem + 26624);
  float* sv = (float*)(smem + 60416);
  float *rowoff = sv, *gsrc = sv + 64, *winter = sv + 128, *enm = sv + 192, *scl = sv + 256, *nvec = sv + 320, *mus = sv + 448, *rss = sv + 512;
  const float* ch = p.CH + (size_t)(bh * 32 + c) * CHS;
#pragma unroll
  for (int i = 0; i < 4; ++i) {
    const int pc = tid + 256 * i, row = pc >> 4, cc = (pc & 15) * 8;
    *(uint4*)(Qs + row * 136 + cc) = *(const uint4*)(p.qkvo + (size_t)(tok0 + row) * 2048 + hh * 128 + cc);
  }
  if (tid < 128) nvec[tid] = ch[128 * 128 + tid];
  if (w == 0) {
    const float* f = p.F + (size_t)(tok0 + lane) * FS + 768;
    const float gi = f[hh], gf = f[4 + hh];
    float x = logsigmoidf_(gf);
#pragma unroll
    for (int o = 1; o < 64; o <<= 1) { const float t = __shfl_up(x, o); if (lane >= o) x += t; }
    const float u = gi - x;
    float pm = u;
#pragma unroll
    for (int o = 1; o < 64; o <<= 1) { const float t = __shfl_up(pm, o); if (lane >= o) pm = fmaxf(pm, t); }
    const float mc = p.mstart[bh * 32 + c];
    const float inter = x + mc;
    const float mt = fmaxf(inter, x + pm);
    rowoff[lane] = x - mt; gsrc[lane] = u; winter[lane] = __expf(inter - mt); enm[lane] = __expf(-mt);
  }
  __syncthreads();
  {
    const int ti = w >> 1, si = w & 1;
    f32x16 acc;
#pragma unroll
    for (int e = 0; e < 16; ++e) acc[e] = 0.f;
    if (si <= ti) {
      const bf16_t* kp = p.qkvo + (size_t)(tok0 + si * 32 + r) * 2048 + 512 + hh * 128 + h * 8;
#pragma unroll
      for (int ks = 0; ks < 8; ++ks) {
        const bf16x8 a = ld8(Qs + (ti * 32 + r) * 136 + ks * 16 + h * 8);
        const bf16x8 bb = ld8(kp + ks * 16);
        acc = MFMA32(a, bb, acc);
      }
    }
    const int s = si * 32 + r;
    const float gs = gsrc[s];
#pragma unroll
    for (int e = 0; e < 16; ++e) {
      const int t = ti * 32 + crow(e, h);
      const float v = (s <= t) ? __expf(rowoff[t] + gs) * acc[e] : 0.f;
      As[t * 72 + s] = (bf16_t)f2bf(v);
    }
  }
  __syncthreads();
  f32x16 acc1[2], acc2[2];
#pragma unroll
  for (int i = 0; i < 2; ++i)
#pragma unroll
    for (int e = 0; e < 16; ++e) { acc1[i][e] = 0.f; acc2[i][e] = 0.f; }
  {
    const bf16_t* vt = p.VT + ((size_t)(bh * 128 + w * 32 + r)) * 2048 + c * 64 + h * 8;
#pragma unroll 2
    for (int ks = 0; ks < 4; ++ks) {
      const bf16x8 bb = ld8(vt + ks * 16);
#pragma unroll
      for (int i = 0; i < 2; ++i) { const bf16x8 a = ld8(As + (i * 32 + r) * 72 + ks * 16 + h * 8); acc1[i] = MFMA32(a, bb, acc1[i]); }
    }
    const float* cp = ch + (size_t)(w * 32 + r) * 128 + h * 8;
#pragma unroll 4
    for (int ks = 0; ks < 8; ++ks) {
      float x[8]; ld8f(cp + ks * 16, x);
      const bf16x8 bb = __builtin_bit_cast(bf16x8, pack8(x));
#pragma unroll
      for (int i = 0; i < 2; ++i) { const bf16x8 a = ld8(Qs + (i * 32 + r) * 136 + ks * 16 + h * 8); acc2[i] = MFMA32(a, bb, acc2[i]); }
    }
  }
  if (tid < 64) {
    const int t = tid;
    float di = 0.f;
#pragma unroll
    for (int q = 0; q < 8; ++q) { float x[8]; unpack8(*(const uint4*)(As + t * 72 + q * 8), x);
#pragma unroll
      for (int j = 0; j < 8; ++j) di += x[j]; }
    float nq = 0.f;
#pragma unroll 2
    for (int q = 0; q < 16; ++q) { float x[8]; unpack8(*(const uint4*)(Qs + t * 136 + q * 8), x);
#pragma unroll
      for (int j = 0; j < 8; ++j) nq += x[j] * nvec[q * 8 + j]; }
    const float den = di + winter[t] * nq;
    scl[t] = 1.f / fmaxf(fabsf(den), enm[t]);
  }
  __syncthreads();
#pragma unroll
  for (int i = 0; i < 2; ++i)
#pragma unroll
    for (int e = 0; e < 16; ++e) {
      const int t = i * 32 + crow(e, h);
      Hs[t * 132 + w * 32 + r] = (acc1[i][e] + winter[t] * acc2[i][e]) * scl[t];
    }
  __syncthreads();
  {
    const int t = tid >> 2, part = tid & 3;
    float s = 0.f;
#pragma unroll
    for (int j = 0; j < 32; ++j) s += Hs[t * 132 + j * 4 + part];
    s += __shfl_xor(s, 1); s += __shfl_xor(s, 2);
    const float mu = s * (1.f / 128.f);
    float q = 0.f;
#pragma unroll
    for (int j = 0; j < 32; ++j) { const float d = Hs[t * 132 + j * 4 + part] - mu; q += d * d; }
    q += __shfl_xor(q, 1); q += __shfl_xor(q, 2);
    if (part == 0) { mus[t] = mu; rss[t] = rsqrtf(q * (1.f / 128.f) + LN_EPS); }
  }
  __syncthreads();
  const float* mg = p.mh_g + l * 512 + hh * 128;
#pragma unroll
  for (int i = 0; i < 4; ++i) {
    const int pc = tid + 256 * i, t = pc >> 4, v0 = (pc & 15) * 8;
    float o[8]; unpack8(*(const uint4*)(p.qkvo + (size_t)(tok0 + t) * 2048 + 1536 + hh * 128 + v0), o);
    float gg[8]; ld8f(mg + v0, gg);
    const float mu = mus[t], rs = rss[t];
    float y[8];
#pragma unroll
    for (int j = 0; j < 8; ++j) y[j] = sigmoidf_(o[j]) * ((Hs[t * 132 + v0 + j] - mu) * rs * gg[j]);
    *(uint4*)(p.hbf + (size_t)(tok0 + t) * 1024 + hh * 128 + v0) = pack8(y);
  }
  __syncthreads();
}

DI void mlstm_sample(const Params& p, int l, int item, char* smem) {
  const int tid = tidx(), lane = tid & 63, w = tid >> 6;
  const int b = item >> 2, hh = item & 3;
  const int tok0 = NP + b * 4;
  float* qs = (float*)smem;
  float* ks = qs + 512;
  float* vs = ks + 512;
  float* hs = vs + 512;
  float* ns = hs + 512;
  float* qk = ns + 128;
  float* nq = qk + 16;
  const size_t sidx = (size_t)(l * 128 + b) * 4 + hh;
  for (int i = tid; i < 1536; i += 256) {
    const int m = i >> 9, t = (i >> 7) & 3, d = i & 127;
    qs[i] = bf2f(p.qkvo[(size_t)(tok0 + t) * 2048 + m * 512 + hh * 128 + d]);
  }
  if (tid < 128) ns[tid] = p.stN[sidx * 128 + tid];
  __syncthreads();
  {
    const int dp = tid >> 3, part = tid & 7;
    if (dp < 20) {
      const float* x = qs + (dp < 16 ? (dp >> 2) : (dp - 16)) * 128 + part * 16;
      const float* y = (dp < 16 ? ks + (dp & 3) * 128 : ns) + part * 16;
      float a = 0.f;
#pragma unroll
      for (int d = 0; d < 16; ++d) a += x[d] * y[d];
      a += __shfl_xor(a, 1); a += __shfl_xor(a, 2); a += __shfl_xor(a, 4);
      if (part == 0) { if (dp < 16) qk[dp] = a; else nq[dp - 16] = a; }
    }
  }
  float ig[4], bc[4];
  {
    float run = 0.f;
#pragma unroll
    for (int t = 0; t < 4; ++t) { const float* f = p.F + (size_t)(tok0 + t) * FS + 768; ig[t] = f[hh]; run += logsigmoidf_(f[4 + hh]); bc[t] = run; }
  }
  const float mprev = p.stM[sidx];
  float mt[4], wint[4];
#pragma unroll
  for (int t = 0; t < 4; ++t) {
    float mm = bc[t] + mprev;
#pragma unroll
    for (int s = 0; s < 4; ++s) if (s <= t) mm = fmaxf(mm, bc[t] - bc[s] + ig[s]);
    mt[t] = mm; wint[t] = __expf(bc[t] + mprev - mm);
  }
  const float bend = bc[3];
  float mnew = bend + mprev;
#pragma unroll
  for (int s = 0; s < 4; ++s) mnew = fmaxf(mnew, bend - bc[s] + ig[s]);
  float wcs[4];
#pragma unroll
  for (int s = 0; s < 4; ++s) wcs[s] = __expf(bend - bc[s] + ig[s] - mnew);
  const float dec = __expf(bend + mprev - mnew);
  __syncthreads();
  float a[4][4], den[4];
#pragma unroll
  for (int t = 0; t < 4; ++t) {
    float ds = 0.f;
#pragma unroll
    for (int s = 0; s < 4; ++s) { a[t][s] = (s <= t) ? __expf(bc[t] - bc[s] + ig[s] - mt[t]) * qk[t * 4 + s] : 0.f; ds += a[t][s]; }
    den[t] = ds + wint[t] * nq[t];
  }
  {
    const int k4i = tid & 31, rgrp = tid >> 5, l5 = lane & 31;
    const bool bb4 = l5 & 16, bb3 = l5 & 8;
    float4 q4[4], k4[4];
#pragma unroll
    for (int t = 0; t < 4; ++t) { q4[t] = *(const float4*)(qs + t * 128 + k4i * 4); k4[t] = *(const float4*)(ks + t * 128 + k4i * 4); }
    const float wint_t = bb4 ? (bb3 ? wint[3] : wint[2]) : (bb3 ? wint[1] : wint[0]);
    const float den_t = bb4 ? (bb3 ? den[3] : den[2]) : (bb3 ? den[1] : den[0]);
    const float mt_t = bb4 ? (bb3 ? mt[3] : mt[2]) : (bb3 ? mt[1] : mt[0]);
    const float invd_t = 1.f / fmaxf(fabsf(den_t), __expf(-mt_t));
    float a_t[4];
#pragma unroll
    for (int s = 0; s < 4; ++s) a_t[s] = bb4 ? (bb3 ? a[3][s] : a[2][s]) : (bb3 ? a[1][s] : a[0][s]);
    const int tsel = (bb4 ? 2 : 0) + (bb3 ? 1 : 0);
    const float* cbase = p.stC + sidx * 16384 + k4i * 4;
    float* obase = p.out + O_CS + sidx * 16384 + k4i * 4;
#pragma unroll 4
    for (int j = 0; j < 16; ++j) {
      const int vrow = rgrp + 8 * j;
      const float4 cv = *(const float4*)(cbase + vrow * 128);
      const float v0 = vs[vrow], v1 = vs[128 + vrow], v2 = vs[256 + vrow], v3 = vs[384 + vrow];
      float pt[4];
#pragma unroll
      for (int t = 0; t < 4; ++t) pt[t] = cv.x * q4[t].x + cv.y * q4[t].y + cv.z * q4[t].z + cv.w * q4[t].w;
      const float w0 = wcs[0] * v0, w1 = wcs[1] * v1, w2 = wcs[2] * v2, w3 = wcs[3] * v3;
      float4 cn;
      cn.x = dec * cv.x + w0 * k4[0].x + w1 * k4[1].x + w2 * k4[2].x + w3 * k4[3].x;
      cn.y = dec * cv.y + w0 * k4[0].y + w1 * k4[1].y + w2 * k4[2].y + w3 * k4[3].y;
      cn.z = dec * cv.z + w0 * k4[0].z + w1 * k4[1].z + w2 * k4[2].z + w3 * k4[3].z;
      cn.w = dec * cv.w + w0 * k4[0].w + w1 * k4[1].w + w2 * k4[2].w + w3 * k4[3].w;
      *(float4*)(obase + vrow * 128) = cn;
      float r2[2];
#pragma unroll
      for (int jj = 0; jj < 2; ++jj) { const float x = pt[jj], y = pt[jj + 2]; r2[jj] = (bb4 ? y : x) + __shfl_xor(bb4 ? x : y, 16); }
      float r1 = (bb3 ? r2[1] : r2[0]) + __shfl_xor(bb3 ? r2[0] : r2[1], 8);
      r1 += __shfl_xor(r1, 4); r1 += __shfl_xor(r1, 2); r1 += __shfl_xor(r1, 1);
      if ((l5 & 7) == 0) hs[tsel * 128 + vrow] = (wint_t * r1 + a_t[0] * v0 + a_t[1] * v1 + a_t[2] * v2 + a_t[3] * v3) * invd_t;
    }
  }
  if (tid < 128) {
    float nn = dec * ns[tid];
#pragma unroll
    for (int s = 0; s < 4; ++s) nn += wcs[s] * ks[s * 128 + tid];
    p.out[O_NS + sidx * 128 + tid] = nn;
  }
  if (tid == 0) p.out[O_MS + sidx] = mnew;
  __syncthreads();
  {
    const int t = w;
    const float h0 = hs[t * 128 + lane], h1 = hs[t * 128 + 64 + lane];
    const float mu = wsum(h0 + h1) * (1.f / 128.f);
    const float d0 = h0 - mu, d1 = h1 - mu;
    const float rs = rsqrtf(wsum(d0 * d0 + d1 * d1) * (1.f / 128.f) + LN_EPS);
    const float* mg = p.mh_g + l * 512 + hh * 128;
    const bf16_t* op = p.qkvo + (size_t)(tok0 + t) * 2048 + 1536 + hh * 128;
    bf16_t* yp = p.hbf + (size_t)(tok0 + t) * 1024 + hh * 128;
    yp[lane] = (bf16_t)f2bf(sigmoidf_(bf2f(op[lane])) * d0 * rs * mg[lane]);
    yp[64 + lane] = (bf16_t)f2bf(sigmoidf_(bf2f(op[64 + lane])) * d1 * rs * mg[64 + lane]);
  }
  __syncthreads();
}

DI void sgu_prompt(const Params& p, int l, int item, char* smem) {
  const int tid = tidx(), lane = tid & 63, w = tid >> 6, r = lane & 31, h = lane >> 5;
  const int g = item & 3, bc = item >> 2;
  const int tok0 = bc * 128;
  bf16_t* Ws = (bf16_t*)smem;
  bf16_t* Vt = (bf16_t*)(smem + 34816);
  {
    const int s = tid >> 1, hf = tid & 1;
    const float* vp = p.F + (size_t)(tok0 + s) * FS + 256 + g * 64 + hf * 32;
    float x[32];
#pragma unroll
    for (int q = 0; q < 4; ++q) ld8f(vp + q * 8, x + q * 8);
    float sm = 0.f;
#pragma unroll
    for (int j = 0; j < 32; ++j) sm += x[j];
    sm += __shfl_xor(sm, 1);
    const float mu = sm * (1.f / 64.f);
    float q2 = 0.f;
#pragma unroll
    for (int j = 0; j < 32; ++j) { const float d = x[j] - mu; q2 += d * d; }
    q2 += __shfl_xor(q2, 1);
    const float rs = rsqrtf(q2 * (1.f / 64.f) + LN_EPS);
    const float* gp = p.sgu_g + l * 256 + g * 64 + hf * 32;
    const float* bp = p.sgu_b + l * 256 + g * 64 + hf * 32;
#pragma unroll
    for (int j = 0; j < 32; ++j) Vt[(hf * 32 + j) * 136 + s] = (bf16_t)f2bf((x[j] - mu) * rs * gp[j] + bp[j]);
  }
  {
    const float* wsp = p.w_s + (size_t)(l * 4 + g) * 16384;
#pragma unroll
    for (int i = 0; i < 16; ++i) {
      const int e4 = tid + 256 * i, t = e4 >> 5, s0 = (e4 & 31) * 4;
      const float4 v = *(const float4*)(wsp + t * 128 + s0);
      const float a0 = s0 <= t ? v.x : 0.f, a1 = s0 + 1 <= t ? v.y : 0.f, a2 = s0 + 2 <= t ? v.z : 0.f, a3 = s0 + 3 <= t ? v.w : 0.f;
      *(uint2*)(Ws + t * 136 + s0) = make_uint2(pack2(a0, a1), pack2(a2, a3));
    }
  }
  __syncthreads();
  f32x16 acc[2];
#pragma unroll
  for (int j = 0; j < 2; ++j)
#pragma unroll
    for (int e = 0; e < 16; ++e) acc[j][e] = 0.f;
#pragma unroll
  for (int ks = 0; ks < 8; ++ks) {
    const bf16x8 a = ld8(Ws + (w * 32 + r) * 136 + ks * 16 + h * 8);
#pragma unroll
    for (int j = 0; j < 2; ++j) { const bf16x8 bb = ld8(Vt + (j * 32 + r) * 136 + ks * 16 + h * 8); acc[j] = MFMA32(a, bb, acc[j]); }
  }
  const float* bsp = p.b_s + (l * 4 + g) * 128;
#pragma unroll
  for (int j = 0; j < 2; ++j)
#pragma unroll
    for (int e = 0; e < 16; ++e) {
      const int t = w * 32 + crow(e, h), d = j * 32 + r;
      const float u = p.F[(size_t)(tok0 + t) * FS + g * 64 + d];
      p.hbf[(size_t)(tok0 + t) * 1024 + 512 + g * 64 + d] = (bf16_t)f2bf(u * (acc[j][e] + bsp[t]));
    }
  __syncthreads();
}

DI void sgu_sample(const Params& p, int l, int b) {
  const int tid = tidx(), g = tid >> 6;
  const int tok0 = NP + b * 4;
  float vn[4];
  const float gg = p.sgu_g[l * 256 + tid], bb = p.sgu_b[l * 256 + tid];
#pragma unroll
  for (int t = 0; t < 4; ++t) {
    const float x = p.F[(size_t)(tok0 + t) * FS + 256 + tid];
    const float mu = wsum(x) * (1.f / 64.f);
    const float d = x - mu;
    const float rs = rsqrtf(wsum(d * d) * (1.f / 64.f) + LN_EPS);
    vn[t] = d * rs * gg + bb;
    p.out[O_SV + ((size_t)(l * 128 + b) * 4 + t) * 256 + tid] = vn[t];
  }
  const float* wsp = p.w_s + (size_t)(l * 4 + g) * 16384;
  const float* bsp = p.b_s + (l * 4 + g) * 128;
#pragma unroll
  for (int t = 0; t < 4; ++t) {
    float mix = bsp[t];
#pragma unroll
    for (int s = 0; s < 4; ++s) if (s <= t) mix += wsp[t * 128 + s] * vn[s];
    const float u = p.F[(size_t)(tok0 + t) * FS + tid];
    p.hbf[(size_t)(tok0 + t) * 1024 + 512 + tid] = (bf16_t)f2bf(u * mix);
  }
}

DI void pool_tail(const Params& p, int l, int tokbase, const float* P, int tid) {
  const int g = tid >> 6, e = tid & 63;
  float acc[16];
#pragma unroll
  for (int i = 0; i < 16; ++i) acc[i] = 0.f;
  const float* wp = p.w_pool + (size_t)(l * 4 + g) * 4096 + e;
#pragma unroll 4
  for (int d4 = 0; d4 < 16; ++d4) {
    const float w0 = wp[(d4 * 4) * 64], w1 = wp[(d4 * 4 + 1) * 64], w2 = wp[(d4 * 4 + 2) * 64], w3 = wp[(d4 * 4 + 3) * 64];
#pragma unroll
    for (int tt = 0; tt < 16; ++tt) {
      const float4 p4 = *(const float4*)(P + tt * 256 + g * 64 + d4 * 4);
      acc[tt] += p4.x * w0 + p4.y * w1 + p4.z * w2 + p4.w * w3;
    }
  }
  const float ps = p.pool_scale[l * 256 + tid];
#pragma unroll
  for (int tt = 0; tt < 16; ++tt) p.hbf[(size_t)(tokbase + tt) * 1024 + 768 + tid] = (bf16_t)f2bf(acc[tt] * ps);
}

DI void pool_prompt(const Params& p, int l, int item, char* smem) {
  const int tid = tidx();
  const int b = item >> 7, t0 = (item & 127) * 16;
  float* X = (float*)smem;
  float* P = X + 31 * 256;
#pragma unroll
  for (int i = 0; i < 31; ++i) { const int t = t0 - 15 + i; const int tc = t >= 0 ? t : 0; const float v = p.F[(size_t)(b * 2048 + tc) * FS + 512 + tid]; X[i * 256 + tid] = t >= 0 ? v : 0.f; }
  __syncthreads();
  const int g = tid >> 6, wsz = 2 << g;
  for (int tt = 0; tt < 16; ++tt) {
    float s = 0.f;
    for (int j = 0; j < wsz; ++j) s += X[(15 + tt - j) * 256 + tid];
    const int pos = t0 + tt;
    const float cnt = (float)(pos + 1 < wsz ? pos + 1 : wsz);
    P[tt * 256 + tid] = s / cnt - X[(15 + tt) * 256 + tid];
  }
  if (t0 == 2032)
    for (int tt = 1; tt < 16; ++tt) p.out[O_PP + ((size_t)(l * 8 + b) * 15 + (tt - 1)) * 256 + tid] = X[(15 + tt) * 256 + tid];
  __syncthreads();
  pool_tail(p, l, b * 2048 + t0, P, tid);
  __syncthreads();
}

DI void pool_sample(const Params& p, int l, int item, char* smem) {
  const int tid = tidx();
  const int b0 = item * 4;
  float* X = (float*)smem;
  float* P = X + 31 * 256;
  const int g = tid >> 6, wsz = 2 << g;
  for (int bi = 0; bi < 4; ++bi) {
    const int b = b0 + bi;
    for (int i = 0; i < 19; ++i)
      X[i * 256 + tid] = i < 15 ? p.stPool[((size_t)(l * 128 + b) * 15 + i) * 256 + tid] : p.F[(size_t)(NP + b * 4 + (i - 15)) * FS + 512 + tid];
    __syncthreads();
    for (int t = 0; t < 4; ++t) {
      float s = 0.f;
      for (int j = 0; j < wsz; ++j) s += X[(15 + t - j) * 256 + tid];
      P[(bi * 4 + t) * 256 + tid] = s / (float)wsz - X[(15 + t) * 256 + tid];
    }
    for (int i = 0; i < 15; ++i) p.out[O_PS + ((size_t)(l * 128 + b) * 15 + i) * 256 + tid] = X[(4 + i) * 256 + tid];
    __syncthreads();
  }
  pool_tail(p, l, NP + b0 * 4, P, tid);
  __syncthreads();
}

DI void phaseB1(const Params& p, int l, char* smem) {
  const int G = gridDim.x, bx = bidx();
  for (int it = bx; it < 512; it += G) mlstm_sample(p, l, it, smem);
  for (int it = (bx + 256) % G; it < 1024; it += G) mlstm_i(p, l, it, smem);
  for (int it = bx; it < 512; it += G) sgu_prompt(p, l, it, smem);
  for (int it = (bx + 128) % G; it < 128; it += G) sgu_sample(p, l, it);
  for (int it = bx; it < 1024; it += G) pool_prompt(p, l, it, smem);
  for (int it = (bx + 64) % G; it < 32; it += G) pool_sample(p, l, it, smem);
}

DI void phaseB3(const Params& p, int l, char* smem) {
  for (int it = bidx(); it < 1024; it += gridDim.x) mlstm_iii(p, l, it, smem);
}

__device__ const unsigned kCandWords[16] = {0x03020100u, 0x07060504u, 0x0b0a0908u, 0x0f0e0d0cu, 0x13121110u, 0x17161514u, 0x23222120u, 0x32313024u,
                                            0x42414033u, 0x61605150u, 0x90807170u, 0xd0c0b0a0u, 0xfffff0e0u, 0xffffffffu, 0xffffffffu, 0xffffffffu};

DI void ce_(int& a, int& b, bool desc) { const int hi = max(a, b), lo = min(a, b); a = desc ? hi : lo; b = desc ? lo : hi; }
DI void bitonic_sort16(int* v) {
#pragma unroll
  for (int k = 2; k <= 16; k <<= 1) {
#pragma unroll
    for (int j = k >> 1; j >= 1; j >>= 1) {
#pragma unroll
      for (int i = 0; i < 16; ++i) { const int l = i ^ j; if (l > i) ce_(v[i], v[l], (i & k) == 0); }
    }
  }
}
DI void bitonic_merge16(int* v) {
#pragma unroll
  for (int j = 8; j >= 1; j >>= 1) {
#pragma unroll
    for (int i = 0; i < 16; ++i) { const int l = i ^ j; if (l > i) ce_(v[i], v[l], true); }
  }
}

DI void phaseF(const Params& p, int l, char* smem) {
  const int tid = tidx(), lane = tid & 63, w = tid >> 6, r = lane & 31, h = lane >> 5;
  float* Sc = (float*)smem;
  float* ls = (float*)(smem + 33024);
  int* li = (int*)(smem + 41472);
  int* jp = (int*)(smem + 49920);
  for (int it = bidx(); it < 264 * 8; it += gridDim.x) {
    const int tile = it >> 3, hd = it & 7;
    const int tok0 = tile * 64;
    for (int pp = 0; pp < 2; ++pp) {
      f32x16 acc[2];
#pragma unroll
      for (int i = 0; i < 2; ++i)
#pragma unroll
        for (int e = 0; e < 16; ++e) acc[i][e] = 0.f;
      const bf16_t* qp = p.qkvo + (size_t)(tok0 + r) * 2048 + (hd * 2 + pp) * 128 + h * 8;
      const bf16_t* kp = p.keysb + ((size_t)((l * 8 + hd) * 2 + pp) * 128 + w * 32 + r) * 128 + h * 8;
#pragma unroll
      for (int ks = 0; ks < 8; ++ks) {
        const bf16x8 bb = ld8(kp + ks * 16);
#pragma unroll
        for (int i = 0; i < 2; ++i) { const bf16x8 a = ld8(qp + (size_t)i * 32 * 2048 + ks * 16); acc[i] = MFMA32(a, bb, acc[i]); }
      }
#pragma unroll
      for (int i = 0; i < 2; ++i)
#pragma unroll
        for (int e = 0; e < 16; ++e) Sc[(i * 32 + crow(e, h)) * 129 + w * 32 + r] = acc[i][e];
      __syncthreads();
      {
        const int row = tid >> 2, part = tid & 3;
        int va[16], vb[16];
#pragma unroll
        for (int j = 0; j < 16; ++j) {
          const int fa = __float_as_int(Sc[row * 129 + j * 4 + part]);
          const int ma = fa ^ ((fa >> 31) & 0x7fffffff);
          va[j] = (ma & ~127) | (127 - (j * 4 + part));
          const int fb = __float_as_int(Sc[row * 129 + (j + 16) * 4 + part]);
          const int mb = fb ^ ((fb >> 31) & 0x7fffffff);
          vb[j] = (mb & ~127) | (127 - ((j + 16) * 4 + part));
        }
        bitonic_sort16(va); bitonic_sort16(vb);
        int vc[16];
#pragma unroll
        for (int i = 0; i < 16; ++i) vc[i] = max(va[i], vb[15 - i]);
        bitonic_merge16(vc);
#pragma unroll
        for (int o = 1; o < 4; o <<= 1) {
          int vp[16];
#pragma unroll
          for (int i = 0; i < 16; ++i) vp[i] = (o == 1) ? dpp_xor1(vc[15 - i]) : dpp_xor2(vc[15 - i]);
#pragma unroll
          for (int i = 0; i < 16; ++i) vc[i] = max(vc[i], vp[i]);
          bitonic_merge16(vc);
        }
        if (part == 0) {
#pragma unroll
          for (int i = 0; i < 16; ++i) {
            const int mono = vc[i] & ~127;
            ls[row * 33 + pp * 16 + i] = __int_as_float(mono ^ ((mono >> 31) & 0x7fffffff));
            li[row * 33 + pp * 16 + i] = 127 - (vc[i] & 127);
          }
        }
      }
      __syncthreads();
    }
    {
      const int row = tid >> 2, part = tid & 3;
      int vc[16];
#pragma unroll
      for (int k = 0; k < 16; ++k) {
        const unsigned cw = kCandWords[k];
        const unsigned ij = (cw >> (8 * part)) & 0xffu;
        const int c = 4 * k + part;
        int key = (int)0x80000000;
        if (ij != 0xffu) {
          const float v = ls[row * 33 + (ij >> 4)] + ls[row * 33 + 16 + (ij & 15)];
          const int fb = __float_as_int(v);
          const int mono = fb ^ ((fb >> 31) & 0x7fffffff);
          key = (mono & ~63) | (63 - c);
        }
        vc[k] = key;
      }
      bitonic_sort16(vc);
#pragma unroll
      for (int o = 1; o < 4; o <<= 1) {
        int vp[16];
#pragma unroll
        for (int i = 0; i < 16; ++i) vp[i] = (o == 1) ? dpp_xor1(vc[15 - i]) : dpp_xor2(vc[15 - i]);
#pragma unroll
        for (int i = 0; i < 16; ++i) vc[i] = max(vc[i], vp[i]);
        bitonic_merge16(vc);
      }
      float sc[16];
      float sum = 0.f;
#pragma unroll
      for (int st = 0; st < 16; ++st) {
        const int mono = vc[st] & ~63;
        sc[st] = __int_as_float(mono ^ ((mono >> 31) & 0x7fffffff));
      }
      const float s0 = sc[0];
#pragma unroll
      for (int st = 0; st < 16; ++st) { sc[st] = __expf(sc[st] - s0); sum += sc[st]; }
      const float inv = 1.f / sum;
      int oid[4]; float og[4];
#pragma unroll
      for (int q = 0; q < 4; ++q) {
        const int kq = part == 0 ? vc[q] : (part == 1 ? vc[4 + q] : (part == 2 ? vc[8 + q] : vc[12 + q]));
        const float gq = part == 0 ? sc[q] : (part == 1 ? sc[4 + q] : (part == 2 ? sc[8 + q] : sc[12 + q]));
        const int c = 63 - (kq & 63);
        const unsigned ij = (kCandWords[c >> 2] >> (8 * (c & 3))) & 0xffu;
        oid[q] = li[row * 33 + (ij >> 4)] * 128 + li[row * 33 + 16 + (ij & 15)];
        og[q] = gq * inv;
      }
      *(int4*)(p.pidx + (size_t)(tok0 + row) * 128 + hd * 16 + part * 4) = make_int4(oid[0], oid[1], oid[2], oid[3]);
      *(float4*)(p.pgate + (size_t)(tok0 + row) * 128 + hd * 16 + part * 4) = make_float4(og[0], og[1], og[2], og[3]);
    }
    __syncthreads();
  }
}

constexpr int GT = 12;
DI void phaseG(const Params& p, int l, char* smem) {
  const int tid = tidx(), lane = tid & 63, w = tid >> 6, g = lane >> 3, sub = lane & 7;
  const int TW = gridDim.x * 4, wg = bidx() * 4 + w;
  const unsigned char* Uq = p.Uq + (size_t)l * 16384 * 1024;
  const unsigned char* Vq = p.Vq + (size_t)l * 16384 * 1024;
  const float* usc = p.uscale + l * 16384; const float* vsc = p.vscale + l * 16384;
  const float* adaL = p.ada + (size_t)l * 136 * 6144;
  const float* g2g = p.ln2_g + l * 1024; const float* g2b = p.ln2_b + l * 1024;
  float* dstbase = (l == 1) ? p.out : p.XZ;
  float* Y = p.F;
  int* spk0 = (int*)smem + w * (4 * GT * 64) + lane;
  int* spk1 = spk0 + GT * 64;
  const int* gpk0 = (const int*)smem + w * (4 * GT * 64) + 8 * g;
  const int* gpk1 = gpk0 + GT * 64;
  int* sa0 = spk0 + 2 * GT * 64;
  int* sa1 = spk0 + 3 * GT * 64;
  const unsigned sub16 = (unsigned)sub << 4;
  const bool b2 = sub & 4, b1 = sub & 2, b0 = sub & 1;
  const bool b5 = g & 4, b4 = g & 2, b3 = g & 1;
  for (int base = wg; base < NT; base += TW * GT) {
    const int nt = min(GT, (NT - base + TW - 1) / TW);
    for (int i = 0; i < nt; ++i) {
      const int tok = base + i * TW;
      spk0[i * 64] = p.pidx[(size_t)tok * 128 + 8 * sub + g];
      spk1[i * 64] = p.pidx[(size_t)tok * 128 + 64 + 8 * sub + g];
      sa0[i * 64] = 0; sa1[i * 64] = 0;
    }
    const int nsteps = 8 * nt;
#define G_NEXT(c_, i_, cn_, in_) { in_ = (i_) + 1; cn_ = (c_); if (in_ == nt) { in_ = 0; cn_ = (c_) + 1; } if (cn_ == 8) { cn_ = (c_); in_ = (i_); } }
#define U_GATHER(BUF, XS, c_, i_)                                                                            \
    { const unsigned char* tb_ = Uq + (size_t)(c_) * 16384 * 128;                                            \
      XS = *(const uint4*)(p.xq + (size_t)(base + (i_) * TW) * 1024 + (c_) * 128 + sub * 16);                \
      const int4 ka_ = *(const int4*)(gpk0 + (i_) * 64), kb_ = *(const int4*)(gpk0 + (i_) * 64 + 4);         \
      const int4 kc_ = *(const int4*)(gpk1 + (i_) * 64), kd_ = *(const int4*)(gpk1 + (i_) * 64 + 4);         \
      const int kk_[16] = {ka_.x, ka_.y, ka_.z, ka_.w, kb_.x, kb_.y, kb_.z, kb_.w, kc_.x, kc_.y, kc_.z, kc_.w, kd_.x, kd_.y, kd_.z, kd_.w}; \
      _Pragma("unroll") for (int ld = 0; ld < 16; ++ld) {                                                    \
        const unsigned e_ = (unsigned)kk_[ld] & 0xffffu;                                                     \
        BUF[ld] = *(const uint4*)(tb_ + ((e_ << 7) | sub16)); } }
#define U_COMPUTE(BUF, XS, i_)                                                                               \
    {                                                                                                        \
      int t[16];                                                                                             \
      _Pragma("unroll") for (int ld = 0; ld < 16; ++ld) {                                                    \
        int v = __builtin_amdgcn_sdot4((int)BUF[ld].x, (int)XS.x, 0, false);                                 \
        v = __builtin_amdgcn_sdot4((int)BUF[ld].y, (int)XS.y, v, false);                                     \
        v = __builtin_amdgcn_sdot4((int)BUF[ld].z, (int)XS.z, v, false);                                     \
        v = __builtin_amdgcn_sdot4((int)BUF[ld].w, (int)XS.w, v, false); t[ld] = v; }                        \
      int wsum2[2];                                                                                          \
      _Pragma("unroll") for (int k = 0; k < 2; ++k) {                                                        \
        int u4[4], v2[2];                                                                                    \
        _Pragma("unroll") for (int j = 0; j < 4; ++j) { const int x = t[8 * k + j], y = t[8 * k + j + 4]; u4[j] = (b2 ? y : x) + dpp_xor4(b2 ? x : y); } \
        _Pragma("unroll") for (int j = 0; j < 2; ++j) { const int x = u4[j], y = u4[j + 2]; v2[j] = (b1 ? y : x) + dpp_xor2(b1 ? x : y); } \
        { const int x = v2[0], y = v2[1]; wsum2[k] = (b0 ? y : x) + dpp_xor1(b0 ? x : y); } }               \
      sa0[(i_) * 64] += wsum2[0]; sa1[(i_) * 64] += wsum2[1];                                                \
    }
    {
      uint4 A[16]; uint4 xa;
      for (int c = 0; c < 8; ++c)
        for (int i = 0; i < nt; ++i) {
          U_GATHER(A, xa, c, i)
          U_COMPUTE(A, xa, i)
        }
    }
    for (int i = 0; i < nt; ++i) {
      const int tok = base + i * TW;
      const float xsc = p.xscale[tok];
      const float gv0 = p.pgate[(size_t)tok * 128 + 8 * sub + g], gv1 = p.pgate[(size_t)tok * 128 + 64 + 8 * sub + g];
      const int e0 = spk0[i * 64], e1 = spk1[i * 64];
      const float a0 = (float)sa0[i * 64] * usc[e0] * xsc, a1 = (float)sa1[i * 64] * usc[e1] * xsc;
      const float c0f = gv0 * 0.5f * a0 * (1.f + erff(a0 * 0.70710678118654752f)) * vsc[e0];
      const float c1f = gv1 * 0.5f * a1 * (1.f + erff(a1 * 0.70710678118654752f)) * vsc[e1];
      spk0[i * 64] = e0 | (int)(f2bf(c0f) << 16); spk1[i * 64] = e1 | (int)(f2bf(c1f) << 16);
    }
    {
      uint4 A[16]; unsigned ca[8];
#define V_GATHER(BUF, CF, c_, i_)                                                                            \
      { const unsigned char* tb_ = Vq + (size_t)(c_) * 16384 * 128;                                          \
        const int4 ka_ = *(const int4*)(gpk0 + (i_) * 64), kb_ = *(const int4*)(gpk0 + (i_) * 64 + 4);       \
        const int4 kc_ = *(const int4*)(gpk1 + (i_) * 64), kd_ = *(const int4*)(gpk1 + (i_) * 64 + 4);       \
        const int kk_[16] = {ka_.x, ka_.y, ka_.z, ka_.w, kb_.x, kb_.y, kb_.z, kb_.w, kc_.x, kc_.y, kc_.z, kc_.w, kd_.x, kd_.y, kd_.z, kd_.w}; \
        _Pragma("unroll") for (int ld = 0; ld < 16; ++ld) {                                                  \
          const unsigned pv_ = (unsigned)kk_[ld];                                                            \
          BUF[ld] = *(const uint4*)(tb_ + (((pv_ & 0xffffu) << 7) | sub16));                                 \
          if (ld & 1) CF[ld >> 1] |= pv_ & 0xffff0000u; else CF[ld >> 1] = pv_ >> 16; } }
#define FP8ACC(w_, o_) { const f32x2 lo = __builtin_amdgcn_cvt_pk_f32_fp8((int)(w_), false); const f32x2 hi = __builtin_amdgcn_cvt_pk_f32_fp8((int)(w_), true); \
        yv[(o_) / 2] = lo * cf2 + yv[(o_) / 2]; yv[(o_) / 2 + 1] = hi * cf2 + yv[(o_) / 2 + 1]; }
#define V_COMPUTE(BUF, CF, c_, i_)                                                                           \
      {                                                                                                      \
        f32x2 yv[8];                                                                                         \
        _Pragma("unroll") for (int j = 0; j < 8; ++j) { yv[j].x = 0.f; yv[j].y = 0.f; }                      \
        _Pragma("unroll") for (int ld = 0; ld < 16; ++ld) {                                                  \
          const float cf = (ld & 1) ? __uint_as_float(CF[ld >> 1] & 0xffff0000u) : __uint_as_float(CF[ld >> 1] << 16); \
          f32x2 cf2; cf2.x = cf; cf2.y = cf;                                                                 \
          unsigned w0_ = BUF[ld].x, w1_ = BUF[ld].y, w2_ = BUF[ld].z, w3_ = BUF[ld].w;                      \
          asm volatile("" : "+v"(w0_), "+v"(w1_), "+v"(w2_), "+v"(w3_));                                   \
          FP8ACC(w0_, 0) FP8ACC(w1_, 4) FP8ACC(w2_, 8) FP8ACC(w3_, 12)                                      \
          asm volatile("" : "+v"(yv[0]), "+v"(yv[1]), "+v"(yv[2]), "+v"(yv[3]), "+v"(yv[4]), "+v"(yv[5]), "+v"(yv[6]), "+v"(yv[7])); } \
        float y16[16];                                                                                       \
        _Pragma("unroll") for (int j = 0; j < 8; ++j) { y16[2 * j] = yv[j].x; y16[2 * j + 1] = yv[j].y; }    \
        float z8[8], z4[4], z2[2];                                                                           \
        _Pragma("unroll") for (int j = 0; j < 8; ++j) { const float x = y16[j], y = y16[j + 8]; z8[j] = (b5 ? y : x) + __shfl_xor(b5 ? x : y, 32); } \
        _Pragma("unroll") for (int j = 0; j < 4; ++j) { const float x = z8[j], y = z8[j + 4]; z4[j] = (b4 ? y : x) + __shfl_xor(b4 ? x : y, 16); } \
        _Pragma("unroll") for (int j = 0; j < 2; ++j) { const float x = z4[j], y = z4[j + 2]; z2[j] = (b3 ? y : x) + dpp_xor8f(b3 ? x : y); } \
        *(float2*)(Y + (size_t)(base + (i_) * TW) * 1024 + (c_) * 128 + sub * 16 + 2 * g) = make_float2(z2[0], z2[1]); \
      }
      for (int c = 0; c < 8; ++c)
        for (int i = 0; i < nt; ++i) {
          V_GATHER(A, ca, c, i)
          V_COMPUTE(A, ca, c, i)
        }
    }
    __threadfence();
    for (int i = 0; i < nt; ++i) {
      const int tok = base + i * TW;
      const int c0i = lane * 8, c1i = 512 + lane * 8;
      const float* ad = adaL + (size_t)cond_row(tok) * 6144;
      const float* xr = p.XZ + (size_t)tok * 1024;
      const float* yr = Y + (size_t)tok * 1024;
      float z[16], gg[16], y[16];
      ld8f(xr + c0i, z); ld8f(xr + c1i, z + 8);
      ld8f(yr + c0i, y); ld8f(yr + c1i, y + 8);
      ld8f(ad + 5120 + c0i, gg); ld8f(ad + 5120 + c1i, gg + 8);
      float sm = 0.f;
#pragma unroll
      for (int j = 0; j < 16; ++j) { z[j] = ALPHA * z[j] + gg[j] * y[j]; sm += z[j]; }
      const float mu = wsum(sm) * (1.f / 1024.f);
      float q = 0.f;
#pragma unroll
      for (int j = 0; j < 16; ++j) { const float d = z[j] - mu; q += d * d; }
      const float rstd = rsqrtf(wsum(q) * (1.f / 1024.f) + LN_EPS);
      float bb[16];
      ld8f(g2g + c0i, gg); ld8f(g2g + c1i, gg + 8); ld8f(g2b + c0i, bb); ld8f(g2b + c1i, bb + 8);
#pragma unroll
      for (int j = 0; j < 16; ++j) z[j] = (z[j] - mu) * rstd * gg[j] + bb[j];
      float* dr = dstbase + (size_t)tok * 1024;
      st8f(dr + c0i, z); st8f(dr + c1i, z + 8);
      if (l == 0) {
        const float* ad1 = p.ada + (size_t)(136 + cond_row(tok)) * 6144;
        mod_store(p.hbf + (size_t)tok * 1024 + c0i, z, ad1 + 1024 + c0i, ad1 + c0i);
        mod_store(p.hbf + (size_t)tok * 1024 + c1i, z + 8, ad1 + 1024 + c1i, ad1 + c1i);
      }
    }
  }
}

#define XB_TMO      128
#define XB_XCNT(j)  (256  + 64 * (j))
#define XB_XSUB(j)  (1280 + 64 * (j))
#define XB_XGEN(j)  (2304 + 64 * (j))
#define XB_TOP      3328
#define XB_TOPGEN   3392
#define XCD_BAR_WORDS 3456
#define XB_SPIN_CAP (1u << 18)
#define LAS __attribute__((address_space(3)))
DI unsigned xb_ld(unsigned* p) { return __hip_atomic_load(p, __ATOMIC_RELAXED, __HIP_MEMORY_SCOPE_AGENT); }
DI unsigned xb_add(unsigned* p, unsigned v) { return __hip_atomic_fetch_add(p, v, __ATOMIC_RELAXED, __HIP_MEMORY_SCOPE_AGENT); }
DI unsigned xb_xcc_id() { return (unsigned)__builtin_amdgcn_s_getreg((3 << 11) | 20) & 0xFu; }
#define XB_SPIN(cond, bar) do { unsigned _sp = 0; while (cond) { __builtin_amdgcn_s_sleep(1); \
    if ((++_sp & 255u) == 0u) { if (xb_ld(&(bar)[XB_TMO])) break; if (_sp > XB_SPIN_CAP) { atomicAdd(&(bar)[XB_TMO], 1u); break; } } } } while (0)
struct XcdBarrier { unsigned* bar; unsigned x; volatile LAS unsigned* st; };
DI XcdBarrier xcd_barrier_post(unsigned* bar, volatile LAS unsigned* st) {
  XcdBarrier b; b.bar = bar; b.x = xb_xcc_id(); b.st = st;
  if (threadIdx.x == 0) (void)xb_add(&bar[XB_XCNT(b.x)], 1u);
  return b;
}
DI void xcd_barrier_complete(unsigned* bar, unsigned x, unsigned& nloc, unsigned& nx) {
  const unsigned G = gridDim.x * gridDim.y * gridDim.z;
  unsigned sum, cnt, mine, sp = 0u;
  for (;;) {
    sum = 0u; cnt = 0u; mine = 0u;
#pragma unroll
    for (unsigned j = 0; j < 16; ++j) { const unsigned c = xb_ld(&bar[XB_XCNT(j)]); sum += c; cnt += (c > 0u) ? 1u : 0u; mine = (j == x) ? c : mine; }
    if (sum == G) break;
    __builtin_amdgcn_s_sleep(1);
    if ((++sp & 255u) == 0u) { if (xb_ld(&bar[XB_TMO])) break; if (sp > XB_SPIN_CAP) { atomicAdd(&bar[XB_TMO], 1u); break; } }
  }
  nloc = mine > 0u ? mine : 1u; nx = cnt > 0u ? cnt : 1u;
}
DI void xcd_barrier(const XcdBarrier& b) {
  asm volatile("s_waitcnt vmcnt(0)" ::: "memory");
  __syncthreads();
  if (threadIdx.x == 0) {
    unsigned* bar = b.bar;
    __builtin_amdgcn_s_waitcnt(0);
    unsigned nloc = b.st[0], nx = b.st[1];
    if (nloc == 0u) { xcd_barrier_complete(bar, b.x, nloc, nx); b.st[0] = nloc; b.st[1] = nx; }
    const unsigned old = xb_add(&bar[XB_XSUB(b.x)], 1u);
    const unsigned gen = old / nloc;
    if (old + 1u == (gen + 1u) * nloc) {
      __builtin_amdgcn_fence(__ATOMIC_RELEASE, "agent");
      asm volatile("s_waitcnt vmcnt(0)" ::: "memory");
      const unsigned og = xb_add(&bar[XB_TOP], 1u);
      const unsigned tg = og / nx;
      if (og + 1u == (tg + 1u) * nx) xb_add(&bar[XB_TOPGEN], 1u);
      else XB_SPIN(xb_ld(&bar[XB_TOPGEN]) == tg, bar);
      __builtin_amdgcn_fence(__ATOMIC_ACQUIRE, "agent");
      xb_add(&bar[XB_XGEN(b.x)], 1u);
      asm volatile("s_waitcnt vmcnt(0)" ::: "memory");
    } else {
      XB_SPIN(xb_ld(&bar[XB_XGEN(b.x)]) == gen, bar);
      __builtin_amdgcn_fence(__ATOMIC_ACQUIRE, "agent");
      asm volatile("s_waitcnt vmcnt(0)" ::: "memory");
    }
  }
  __syncthreads();
}

__global__ void __launch_bounds__(256, 2) fwd_megakernel(Params p, int ph_lo, int ph_hi) {
  __shared__ __attribute__((aligned(16))) char smem[63488];
  __shared__ uint4 xb_words;
  cg::grid_group grid = cg::this_grid();
  if (threadIdx.x == 0) xb_words = make_uint4(0u, 0u, 0u, 0u);
  __syncthreads();
  const XcdBarrier xb = xcd_barrier_post(p.bar, (volatile LAS unsigned*)&xb_words);
  for (int ph = ph_lo; ph < ph_hi; ++ph) {
    if (ph == 0) phase0(p, smem);
    else if (ph == 1) phase1(p);
    else {
      const int l = (ph - 2) / 9, s = (ph - 2) % 9;
      switch (s) {
        case 0: phaseA(p, l, smem); break;
        case 1: phaseB1(p, l, smem); break;
        case 2: phaseB2(p, l); break;
        case 3: phaseB3(p, l, smem); break;
        case 4: phaseC(p, l, smem); break;
        case 5: phaseD(p, l); break;
        case 6: phaseE(p, l, smem); break;
        case 7: phaseF(p, l, smem); break;
        default: phaseG(p, l, smem); break;
      }
    }
    if (ph + 1 < ph_hi) { if (ph_lo < 0) grid.sync(); xcd_barrier(xb); }
  }
}

#ifndef MULTI_LAUNCH
#define MULTI_LAUNCH 0
#endif

extern "C" void kernel_launch(void* const* d_in, const int* in_sizes, int n_in, void* d_out, int out_size, void* d_ws,
                              size_t ws_size, hipStream_t stream) {
  static int grid_blocks = 0;
  if (!grid_blocks) {
    int dev = 0, cus = 0, per_cu = 0;
    hipGetDevice(&dev);
    hipDeviceGetAttribute(&cus, hipDeviceAttributeMultiprocessorCount, dev);
    hipOccupancyMaxActiveBlocksPerMultiprocessor(&per_cu, fwd_megakernel, 256, 0);
    if (per_cu > 2) per_cu = 2;
    if (per_cu < 1) per_cu = 1;
    grid_blocks = cus * per_cu;
  }
  Params p{};
  const float* const* in = (const float* const*)d_in;
  p.x_prompt = in[0]; p.x_sample = in[1]; p.stC = in[2]; p.stN = in[3]; p.stM = in[4]; p.stPool = in[5];
  p.c_prompt = in[6]; p.c_sample = in[7]; p.w_ada = in[8]; p.b_ada = in[9]; p.w_in = in[10]; p.b_gate = in[11];
  p.mh_g = in[12]; p.sgu_g = in[13]; p.sgu_b = in[14]; p.w_s = in[15]; p.b_s = in[16]; p.w_pool = in[17];
  p.pool_scale = in[18]; p.w_o = in[19]; p.ln1_g = in[20]; p.ln1_b = in[21]; p.w_pq = in[22]; p.peer_keys = in[23];
  p.peer_u = in[24]; p.peer_v = in[25]; p.ln2_g = in[26]; p.ln2_b = in[27];
  p.out = (float*)d_out;
  char* ws = (char*)d_ws; size_t off = 0;
  auto take = [&](size_t bytes) { char* r = ws + off; off += (bytes + 255) & ~(size_t)255; return r; };
  p.ada = (float*)take((size_t)2 * 136 * 6144 * 4);
  p.WinT = (bf16_t*)take((size_t)2 * NIN * 1024 * 2);
  p.WoT = (bf16_t*)take((size_t)2 * 1024 * 1024 * 2);
  p.WpqT = (bf16_t*)take((size_t)2 * 2048 * 1024 * 2);
  p.keysb = (bf16_t*)take((size_t)524288 * 2);
  p.Uq = (unsigned char*)take((size_t)2 * 16384 * 1024);
  p.Vq = (unsigned char*)take((size_t)2 * 16384 * 1024);
  p.xq = (unsigned char*)take((size_t)NT * 1024);
  p.uscale = (float*)take((size_t)2 * 16384 * 4);
  p.vscale = (float*)take((size_t)2 * 16384 * 4);
  p.xscale = (float*)take((size_t)NT * 4);
  p.hbf = (bf16_t*)take((size_t)NT * 1024 * 2);
  p.qkvo = (bf16_t*)take((size_t)NT * 2048 * 2);
  p.KT = (bf16_t*)take((size_t)32 * 128 * 2048 * 2);
  p.VT = (bf16_t*)take((size_t)32 * 128 * 2048 * 2);
  p.F = (float*)take((size_t)NT * FS * 4);
  p.CH = (float*)take((size_t)1024 * CHS * 4);
  p.scal = (float*)take((size_t)2048 * 4);
  p.mstart = (float*)take((size_t)1024 * 4);
  p.XZ = (float*)take((size_t)NT * 1024 * 4);
  p.pgate = (float*)take((size_t)NT * 128 * 4);
  p.pidx = (int*)take((size_t)NT * 128 * 4);
  p.bar = (unsigned*)take((size_t)XCD_BAR_WORDS * 4);
  if (off > ws_size) fprintf(stderr, "workspace too small: need %zu have %zu\n", off, ws_size);
  (void)hipMemsetAsync(p.bar, 0, (size_t)XCD_BAR_WORDS * 4, stream);
#if MULTI_LAUNCH
  for (int ph = 0; ph < 20; ++ph) hipLaunchKernelGGL(fwd_megakernel, dim3(grid_blocks), dim3(256), 0, stream, p, ph, ph + 1);
#else
  int lo = 0, hi = 20;
  void* args[] = {&p, &lo, &hi};
  hipError_t e = hipLaunchCooperativeKernel((void*)fwd_megakernel, dim3(grid_blocks), dim3(256), args, 0, stream);
  if (e != hipSuccess) fprintf(stderr, "cooperative launch failed: %s (grid %d)\n", hipGetErrorString(e), grid_blocks);
#endif
}
```

```cpp
#include <hip/hip_runtime.h>
#include <hip/hip_cooperative_groups.h>
#include <cstdio>
#include <cstdint>
namespace cg = cooperative_groups;

typedef unsigned short bf16_t;
typedef __attribute__((ext_vector_type(8))) short bf16x8;
typedef __attribute__((ext_vector_type(16))) float f32x16;
typedef __attribute__((ext_vector_type(2))) __bf16 bf2_t;
typedef __attribute__((ext_vector_type(2))) float f32x2;
#define DI __device__ __forceinline__
#define MFMA32(a, b, c) __builtin_amdgcn_mfma_f32_32x32x16_bf16((a), (b), (c), 0, 0, 0)

constexpr int NP = 16384, NS = 512, NT = 16896;
constexpr int NIN = 2944;
constexpr int FS = 776;
constexpr float ALPHA = 1.4142135623730951f;
constexpr float LN_EPS = 1e-5f;
constexpr int CHS = 129 * 128;

struct Params {
  const float *x_prompt, *x_sample, *stC, *stN, *stM, *stPool, *c_prompt, *c_sample;
  const float *w_ada, *b_ada, *w_in, *b_gate, *mh_g, *sgu_g, *sgu_b, *w_s, *b_s, *w_pool, *pool_scale, *w_o,
      *ln1_g, *ln1_b, *w_pq, *peer_keys, *peer_u, *peer_v, *ln2_g, *ln2_b;
  float* out;
  float* ada;
  bf16_t *WinT, *WoT, *WpqT, *keysb, *hbf, *qkvo, *KT, *VT;
  unsigned char *Uq, *Vq, *xq;
  float *uscale, *vscale, *xscale;
  float *F, *CH, *scal, *mstart, *XZ, *pgate;
  int* pidx;
  unsigned* bar;
};

constexpr size_t O_YP = 0;
constexpr size_t O_YS = 16777216;
constexpr size_t O_CP = O_YS + 524288;
constexpr size_t O_NP = O_CP + 1048576;
constexpr size_t O_MP = O_NP + 8192;
constexpr size_t O_PP = O_MP + 64;
constexpr size_t O_CS = O_PP + 61440;
constexpr size_t O_NS = O_CS + 16777216;
constexpr size_t O_MS = O_NS + 131072;
constexpr size_t O_PS = O_MS + 1024;
constexpr size_t O_SV = O_PS + 983040;

DI int tidx() { int t = threadIdx.x; asm volatile("" : "+v"(t)); return t; }
DI int bidx() { int b = blockIdx.x; asm volatile("" : "+s"(b)); return b; }
DI unsigned f2bf(float x) { unsigned u = __float_as_uint(x); u += 0x7fffu + ((u >> 16) & 1u); return u >> 16; }
DI unsigned pack2(float a, float b) { return f2bf(a) | (f2bf(b) << 16); }
DI float bflo(unsigned u) { return __uint_as_float(u << 16); }
DI float bfhi(unsigned u) { return __uint_as_float(u & 0xffff0000u); }
DI float bf2f(bf16_t h) { return __uint_as_float(((unsigned)h) << 16); }
DI uint4 pack8(const float* v) { return make_uint4(pack2(v[0], v[1]), pack2(v[2], v[3]), pack2(v[4], v[5]), pack2(v[6], v[7])); }
DI void unpack8(uint4 u, float* v) {
  v[0] = bflo(u.x); v[1] = bfhi(u.x); v[2] = bflo(u.y); v[3] = bfhi(u.y);
  v[4] = bflo(u.z); v[5] = bfhi(u.z); v[6] = bflo(u.w); v[7] = bfhi(u.w);
}
DI int crow(int reg, int h) { return (reg & 3) + 8 * (reg >> 2) + 4 * h; }
DI int cond_row(int tok) { return tok < NP ? (tok >> 11) : 8 + ((tok - NP) >> 2); }
DI int dpp_xor1(int x) { return __builtin_amdgcn_update_dpp(0, x, 0xB1, 0xF, 0xF, true); }
DI int dpp_xor2(int x) { return __builtin_amdgcn_update_dpp(0, x, 0x4E, 0xF, 0xF, true); }
DI int dpp_xor4(int x) { return __builtin_amdgcn_update_dpp(0, __builtin_amdgcn_update_dpp(0, x, 0x141, 0xF, 0xF, true), 0x1B, 0xF, 0xF, true); }
DI int dpp_xor8(int x) { return __builtin_amdgcn_update_dpp(0, x, 0x128, 0xF, 0xF, true); }
DI float dpp_xor8f(float x) { return __builtin_bit_cast(float, dpp_xor8(__builtin_bit_cast(int, x))); }
DI float wsum(float v) { for (int o = 32; o > 0; o >>= 1) v += __shfl_xor(v, o); return v; }
DI float wmax(float v) { for (int o = 32; o > 0; o >>= 1) v = fmaxf(v, __shfl_xor(v, o)); return v; }
DI float sigmoidf_(float x) { return 1.f / (1.f + __expf(-x)); }
DI float logsigmoidf_(float x) { return fminf(x, 0.f) - log1pf(__expf(-fabsf(x))); }
DI float dot2bf(unsigned a, unsigned b, float c) {
  return __builtin_amdgcn_fdot2_f32_bf16(__builtin_bit_cast(bf2_t, a), __builtin_bit_cast(bf2_t, b), c, false);
}
DI bf16x8 ld8(const bf16_t* p) { return __builtin_bit_cast(bf16x8, *(const uint4*)p); }
DI void ld8f(const float* p, float* v) {
  float4 a = ((const float4*)p)[0], b = ((const float4*)p)[1];
  v[0] = a.x; v[1] = a.y; v[2] = a.z; v[3] = a.w; v[4] = b.x; v[5] = b.y; v[6] = b.z; v[7] = b.w;
}
DI void st8f(float* p, const float* v) {
  ((float4*)p)[0] = make_float4(v[0], v[1], v[2], v[3]); ((float4*)p)[1] = make_float4(v[4], v[5], v[6], v[7]);
}

template <class Epi>
DI void gemm128(const bf16_t* __restrict__ A, const bf16_t* __restrict__ Bt, int m0, int n0, char* smem, const Epi& epi) {
  const int tid = tidx(), lane = tid & 63, w = tid >> 6, wm = w >> 1, wn = w & 1, r = lane & 31, h = lane >> 5;
  bf16_t* As = (bf16_t*)smem;
  bf16_t* Bs = As + 128 * 72;
  f32x16 acc[2][2];
#pragma unroll
  for (int i = 0; i < 2; ++i)
#pragma unroll
    for (int j = 0; j < 2; ++j)
#pragma unroll
      for (int e = 0; e < 16; ++e) acc[i][j][e] = 0.f;
  typedef __attribute__((ext_vector_type(4))) unsigned u32x4;
  u32x4 ra0, ra1, ra2, ra3, rb0, rb1, rb2, rb3;
  u32x4 sa0, sa1, sa2, sa3, sb0, sb1, sb2, sb3;
  const int prow = tid >> 3, pc = (tid & 7) * 8;
  const bf16_t* ap = A + (size_t)(m0 + prow) * 1024 + pc;
  const bf16_t* bp = Bt + (size_t)(n0 + prow) * 1024 + pc;
#define GLD(P, k0_)                                                                                          \
  P##a0 = *(const u32x4*)(ap + (k0_)); P##a1 = *(const u32x4*)(ap + 32 * 1024 + (k0_));                      \
  P##a2 = *(const u32x4*)(ap + 64 * 1024 + (k0_)); P##a3 = *(const u32x4*)(ap + 96 * 1024 + (k0_));         \
  P##b0 = *(const u32x4*)(bp + (k0_)); P##b1 = *(const u32x4*)(bp + 32 * 1024 + (k0_));                      \
  P##b2 = *(const u32x4*)(bp + 64 * 1024 + (k0_)); P##b3 = *(const u32x4*)(bp + 96 * 1024 + (k0_));
#define LST(P)                                                                                               \
  *(u32x4*)(As + (prow) * 72 + pc) = P##a0; *(u32x4*)(As + (prow + 32) * 72 + pc) = P##a1;                   \
  *(u32x4*)(As + (prow + 64) * 72 + pc) = P##a2; *(u32x4*)(As + (prow + 96) * 72 + pc) = P##a3;              \
  *(u32x4*)(Bs + (prow) * 72 + pc) = P##b0; *(u32x4*)(Bs + (prow + 32) * 72 + pc) = P##b1;                   \
  *(u32x4*)(Bs + (prow + 64) * 72 + pc) = P##b2; *(u32x4*)(Bs + (prow + 96) * 72 + pc) = P##b3;
  GLD(r, 0)
  __builtin_amdgcn_sched_barrier(0);
  GLD(s, 64)
  __builtin_amdgcn_sched_barrier(0);
#define GEMM_COMPUTE()                                                                                       \
  _Pragma("unroll") for (int ks = 0; ks < 4; ++ks) {                                                         \
    bf16x8 a[2], b[2];                                                                                       \
    _Pragma("unroll") for (int i = 0; i < 2; ++i) a[i] = ld8(As + (wm * 64 + i * 32 + r) * 72 + ks * 16 + h * 8); \
    _Pragma("unroll") for (int j = 0; j < 2; ++j) b[j] = ld8(Bs + (wn * 64 + j * 32 + r) * 72 + ks * 16 + h * 8); \
    _Pragma("unroll") for (int i = 0; i < 2; ++i)                                                            \
      _Pragma("unroll") for (int j = 0; j < 2; ++j) acc[i][j] = MFMA32(a[i], b[j], acc[i][j]);               \
  }
#pragma unroll 1
  for (int kt = 0; kt < 16; kt += 2) {
    __syncthreads();
    LST(r)
    __syncthreads();
    { const int k0 = (kt + 2 < 16 ? kt + 2 : 14) * 64; GLD(r, k0) }
    __builtin_amdgcn_sched_barrier(0);
    GEMM_COMPUTE()
    __syncthreads();
    LST(s)
    __syncthreads();
    { const int k0 = (kt + 3 < 16 ? kt + 3 : 15) * 64; GLD(s, k0) }
    __builtin_amdgcn_sched_barrier(0);
    GEMM_COMPUTE()
  }
#pragma unroll
  for (int i = 0; i < 2; ++i)
#pragma unroll
    for (int j = 0; j < 2; ++j)
#pragma unroll
      for (int g = 0; g < 4; ++g)
        epi(m0 + wm * 64 + i * 32 + 8 * g + 4 * h, n0 + wn * 64 + j * 32 + r, acc[i][j][4 * g], acc[i][j][4 * g + 1],
            acc[i][j][4 * g + 2], acc[i][j][4 * g + 3]);
}

DI void phase0(const Params& p, char* smem) {
  const int tid = tidx(), G = gridDim.x;
  auto do_ada = [&]() __attribute__((always_inline)) {
    float* S = (float*)smem;
    const int lane = tid & 63, w = tid >> 6;
    for (int it0 = bidx(); it0 < 2 * 24 * 9; it0 += G) {
      int it = it0;
      if ((G & 7) == 0 && G >= 512) {
        const int x = it0 & 7, slot = it0 >> 3;
        if (slot >= 54) continue;
        it = ((slot / 9) * 8 + x) * 9 + slot % 9;
      }
      const int l = it / 216, rem = it % 216, cb = rem / 9, rg = rem % 9;
      float acc[64];
#pragma unroll
      for (int i = 0; i < 64; ++i) acc[i] = 0.f;
      for (int half = 0; half < 2; ++half) {
#pragma unroll
        for (int q = 0; q < 16; ++q) {
          const int row = rg * 16 + q, rowc = row < 136 ? row : 135;
          const float* cp = (rowc < 8 ? p.c_prompt + rowc * 1024 : p.c_sample + (rowc - 8) * 1024) + half * 512;
          const float m = row < 136 ? 1.f : 0.f;
#pragma unroll
          for (int j = 0; j < 2; ++j) { const float c = cp[tid + 256 * j]; S[(tid + 256 * j) * 16 + q] = m * c / (1.f + __expf(-c)); }
        }
        __syncthreads();
        const float* wp = p.w_ada + ((size_t)l * 1024 + half * 512 + w * 128) * 6144 + cb * 256 + lane * 4;
        const float* sp = S + w * 128 * 16;
#pragma unroll 8
        for (int kk = 0; kk < 128; ++kk) {
          const float4 wv = *(const float4*)(wp + (size_t)kk * 6144);
#pragma unroll
          for (int q4 = 0; q4 < 4; ++q4) {
            const float4 s4 = *(const float4*)(sp + kk * 16 + q4 * 4);
            acc[(q4 * 4 + 0) * 4 + 0] += s4.x * wv.x; acc[(q4 * 4 + 0) * 4 + 1] += s4.x * wv.y; acc[(q4 * 4 + 0) * 4 + 2] += s4.x * wv.z; acc[(q4 * 4 + 0) * 4 + 3] += s4.x * wv.w;
            acc[(q4 * 4 + 1) * 4 + 0] += s4.y * wv.x; acc[(q4 * 4 + 1) * 4 + 1] += s4.y * wv.y; acc[(q4 * 4 + 1) * 4 + 2] += s4.y * wv.z; acc[(q4 * 4 + 1) * 4 + 3] += s4.y * wv.w;
            acc[(q4 * 4 + 2) * 4 + 0] += s4.z * wv.x; acc[(q4 * 4 + 2) * 4 + 1] += s4.z * wv.y; acc[(q4 * 4 + 2) * 4 + 2] += s4.z * wv.z; acc[(q4 * 4 + 2) * 4 + 3] += s4.z * wv.w;
            acc[(q4 * 4 + 3) * 4 + 0] += s4.w * wv.x; acc[(q4 * 4 + 3) * 4 + 1] += s4.w * wv.y; acc[(q4 * 4 + 3) * 4 + 2] += s4.w * wv.z; acc[(q4 * 4 + 3) * 4 + 3] += s4.w * wv.w;
          }
        }
        __syncthreads();
      }
      const float4 bb = *(const float4*)(p.b_ada + l * 6144 + cb * 256 + lane * 4);
#pragma unroll
      for (int pass = 0; pass < 2; ++pass) {
#pragma unroll
        for (int j = 0; j < 32; ++j) S[(w * 32 + j) * 64 + lane] = acc[pass * 32 + j];
        __syncthreads();
#pragma unroll
        for (int rr = 0; rr < 2; ++rr) {
          const int r = 2 * w + rr, row = rg * 16 + pass * 8 + r;
          float o[4];
#pragma unroll
          for (int c = 0; c < 4; ++c) o[c] = S[(0 * 32 + r * 4 + c) * 64 + lane] + S[(1 * 32 + r * 4 + c) * 64 + lane] + S[(2 * 32 + r * 4 + c) * 64 + lane] + S[(3 * 32 + r * 4 + c) * 64 + lane];
          if (row < 136) *(float4*)(p.ada + ((size_t)l * 136 + row) * 6144 + cb * 256 + lane * 4) = make_float4(o[0] + bb.x, o[1] + bb.y, o[2] + bb.z, o[3] + bb.w);
        }
        __syncthreads();
      }
    }
  };
  auto do_transposes = [&]() __attribute__((always_inline)) {
    float* T = (float*)smem;
    for (int it = bidx(); it < 3008; it += G) {
      const int l = it / 1504; int j = it % 1504;
      const float* src; bf16_t* dst; int ldsrc, kind;
      if (j < 736) { kind = 0; src = p.w_in + (size_t)l * 1024 * 2824; ldsrc = 2824; dst = p.WinT + (size_t)l * NIN * 1024; }
      else if (j < 992) { j -= 736; kind = 1; src = p.w_o + (size_t)l * 1024 * 1024; ldsrc = 1024; dst = p.WoT + (size_t)l * 1024 * 1024; }
      else { j -= 992; kind = 2; src = p.w_pq + (size_t)l * 1024 * 2048; ldsrc = 2048; dst = p.WpqT + (size_t)l * 2048 * 1024; }
      const int nt = j >> 4, kt = j & 15;
      const int tn = tid & 63, tk0 = tid >> 6;
      const int n = nt * 64 + tn;
      int e = n;
      if (kind == 0) e = n < 2048 ? n : (n < 2816 ? n + 8 : (n < 2824 ? 2048 + (n - 2816) : -1));
#pragma unroll
      for (int i = 0; i < 16; ++i) { const int k = tk0 + 4 * i; T[k * 65 + tn] = e >= 0 ? src[(size_t)(kt * 64 + k) * ldsrc + e] : 0.f; }
      __syncthreads();
      const int nn = tid >> 2, kq = (tid & 3) * 16;
      unsigned pk[8];
#pragma unroll
      for (int q = 0; q < 8; ++q) pk[q] = pack2(T[(kq + 2 * q) * 65 + nn], T[(kq + 2 * q + 1) * 65 + nn]);
      uint4* d4 = (uint4*)(dst + (size_t)(nt * 64 + nn) * 1024 + kt * 64 + kq);
      d4[0] = make_uint4(pk[0], pk[1], pk[2], pk[3]);
      d4[1] = make_uint4(pk[4], pk[5], pk[6], pk[7]);
      __syncthreads();
    }
  };
  auto do_quant = [&]() __attribute__((always_inline)) {
    const size_t nk8 = 524288 / 8;
    for (size_t i = (size_t)bidx() * 256 + tid; i < nk8; i += (size_t)G * 256) {
      const float* s = p.peer_keys + i * 8;
      const float4 a = ((const float4*)s)[0], b = ((const float4*)s)[1];
      *(uint4*)(p.keysb + i * 8) = make_uint4(pack2(a.x, a.y), pack2(a.z, a.w), pack2(b.x, b.y), pack2(b.z, b.w));
    }
    const int lane = tid & 63, w = tid >> 6;
    for (int row0 = (bidx() * 4 + w) * 2; row0 < 65536; row0 += G * 8) {
      float v[2][16];
#pragma unroll
      for (int r = 0; r < 2; ++r) {
        const int row = row0 + r; const int tab = row >> 15, le = row & 32767;
        const float* src = (tab ? p.peer_v : p.peer_u) + (size_t)le * 1024 + lane * 16;
        ld8f(src, v[r]); ld8f(src + 8, v[r] + 8);
      }
#pragma unroll
      for (int r = 0; r < 2; ++r) {
        const int row = row0 + r; const int tab = row >> 15, le = row & 32767, l = le >> 14, e = le & 16383;
        float m = 0.f;
#pragma unroll
        for (int j = 0; j < 16; ++j) m = fmaxf(m, fabsf(v[r][j]));
        m = wmax(m);
        unsigned wd[4];
        if (tab == 0) {
          const float inv = m > 0.f ? 127.f / m : 0.f;
#pragma unroll
          for (int q = 0; q < 4; ++q) {
            const int q0 = (int)rintf(v[r][4 * q] * inv), q1 = (int)rintf(v[r][4 * q + 1] * inv), q2 = (int)rintf(v[r][4 * q + 2] * inv), q3 = (int)rintf(v[r][4 * q + 3] * inv);
            wd[q] = (unsigned)(q0 & 255) | ((unsigned)(q1 & 255) << 8) | ((unsigned)(q2 & 255) << 16) | ((unsigned)(q3 & 255) << 24);
          }
          if (lane == 0) p.uscale[le] = m * (1.f / 127.f);
        } else {
          const float inv = m > 0.f ? 400.f / m : 0.f;
#pragma unroll
          for (int q = 0; q < 4; ++q) {
            int pk = __builtin_amdgcn_cvt_pk_fp8_f32(v[r][4 * q] * inv, v[r][4 * q + 1] * inv, 0, false);
            pk = __builtin_amdgcn_cvt_pk_fp8_f32(v[r][4 * q + 2] * inv, v[r][4 * q + 3] * inv, pk, true);
            wd[q] = (unsigned)pk;
          }
          if (lane == 0) p.vscale[le] = m * (1.f / 400.f);
        }
        unsigned char* dst = (tab ? p.Vq : p.Uq) + (((size_t)(l * 8 + (lane >> 3)) * 16384 + e) << 7) + (lane & 7) * 16;
        *(uint4*)dst = make_uint4(wd[0], wd[1], wd[2], wd[3]);
      }
    }
  };
  if ((bidx() / (gridDim.x >> 1)) & 1) { do_quant(); do_transposes(); do_ada(); }
  else { do_ada(); do_transposes(); do_quant(); }
}

DI void mod_store(bf16_t* dst, const float* x, const float* sc, const float* sh) {
  float s[8], t[8], o[8];
  ld8f(sc, s); ld8f(sh, t);
#pragma unroll
  for (int j = 0; j < 8; ++j) o[j] = x[j] * (1.f + s[j]) + t[j];
  *(uint4*)dst = pack8(o);
}

DI void phase1(const Params& p) {
  const int tid = tidx(), lane = tid & 63, w = tid >> 6;
  for (int tok = bidx() * 4 + w; tok < NT; tok += gridDim.x * 4) {
    const float* xr = tok < NP ? p.x_prompt + (size_t)tok * 1024 : p.x_sample + (size_t)(tok - NP) * 1024;
    const float* ad = p.ada + (size_t)cond_row(tok) * 6144;
#pragma unroll
    for (int hf = 0; hf < 2; ++hf) {
      const int c = hf * 512 + lane * 8;
      float x[8]; ld8f(xr + c, x);
      mod_store(p.hbf + (size_t)tok * 1024 + c, x, ad + 1024 + c, ad + c);
    }
  }
}

DI void tile_decode(int u, int NTL, int MTL, int& mt, int& nt) {
  const int per_mg = 8 * NTL;
  const int mg = u / per_mg; int v = u - mg * per_mg;
  const int rm = min(8, MTL - 8 * mg);
  int ng = 0;
  for (;;) { const int cn = min(8, NTL - 8 * ng); const int sz = rm * cn; if (v < sz) { mt = 8 * mg + v / cn; nt = 8 * ng + v % cn; return; } v -= sz; ++ng; }
}
template <class Epi>
DI void gemm_micro32(const bf16_t* __restrict__ A, const bf16_t* __restrict__ Bt, int m0, int n0, char* smem, const Epi& epi) {
  const int tid = tidx(), lane = tid & 63, w = tid >> 6, r = lane & 31, h = lane >> 5;
  float* red = (float*)smem;
  f32x16 acc;
#pragma unroll
  for (int e = 0; e < 16; ++e) acc[e] = 0.f;
  const bf16_t* ap = A + (size_t)(m0 + r) * 1024 + w * 256 + h * 8;
  const bf16_t* bp = Bt + (size_t)(n0 + r) * 1024 + w * 256 + h * 8;
#pragma unroll
  for (int ks = 0; ks < 16; ++ks) { const bf16x8 a = ld8(ap + ks * 16); const bf16x8 b = ld8(bp + ks * 16); acc = MFMA32(a, b, acc); }
  __syncthreads();
#pragma unroll
  for (int e = 0; e < 16; ++e) red[(w * 16 + e) * 64 + lane] = acc[e];
  __syncthreads();
  if (w == 0) {
#pragma unroll
    for (int e = 0; e < 16; ++e) acc[e] = red[e * 64 + lane] + red[(16 + e) * 64 + lane] + red[(32 + e) * 64 + lane] + red[(48 + e) * 64 + lane];
#pragma unroll
    for (int g = 0; g < 4; ++g) epi(m0 + 8 * g + 4 * h, n0 + r, acc[4 * g], acc[4 * g + 1], acc[4 * g + 2], acc[4 * g + 3]);
  }
}

template <class Epi>
DI void gemm_phase(const bf16_t* A, const bf16_t* Bt, int NTL, char* smem, const Epi& epi, bool micro_sample) {
  const int MTL = micro_sample ? 128 : 132;
  const int T = MTL * NTL, G = gridDim.x, bx = bidx();
  if ((G & 7) == 0) {
    const int x = bx & 7, slot = bx >> 3, per = G >> 3;
    const int lo = (int)(((long long)T * x) >> 3), hi = (int)(((long long)T * (x + 1)) >> 3);
    for (int u = lo + slot; u < hi; u += per) { int mt, nt; tile_decode(u, NTL, MTL, mt, nt); gemm128(A, Bt, mt * 128, nt * 128, smem, epi); }
  } else {
    for (int t = bx; t < T; t += G) { const int mt = t / NTL, nt = t % NTL; gemm128(A, Bt, mt * 128, nt * 128, smem, epi); }
  }
  if (micro_sample) {
    const int NB = NTL * 4;
    for (int t = bx; t < 16 * NB; t += G) { const int mb = t & 15, nb = t >> 4; gemm_micro32(A, Bt, NP + mb * 32, nb * 32, smem, epi); }
  }
}

struct EpiA {
  const Params& p; const float* bg;
  DI void operator()(int row4, int col, float v0, float v1, float v2, float v3) const {
    if (col < 2048) {
      const float s = col < 512 ? 0.08838834764831845f : 1.f;
      bf16_t* q = p.qkvo + (size_t)row4 * 2048 + col;
      if (!(col >= 1024 && col < 1536 && row4 < NP)) {
        q[0] = (bf16_t)f2bf(v0 * s); q[2048] = (bf16_t)f2bf(v1 * s); q[4096] = (bf16_t)f2bf(v2 * s); q[6144] = (bf16_t)f2bf(v3 * s);
      }
      if (col >= 512 && col < 1536 && row4 < NP) {
        int cc = col - 512; bf16_t* T = cc < 512 ? p.KT : p.VT; cc &= 511;
        const int hh = cc >> 7, d = cc & 127, b = row4 >> 11, t = row4 & 2047;
        *(uint2*)(T + ((size_t)((b * 4 + hh) * 128 + d)) * 2048 + t) = make_uint2(pack2(v0, v1), pack2(v2, v3));
      }
    } else if (col < 2816) {
      float* f = p.F + (size_t)row4 * FS + (col - 2048);
      f[0] = v0; f[FS] = v1; f[2 * FS] = v2; f[3 * FS] = v3;
    } else if (col < 2824) {
      const int g = col - 2816; const float bb = bg[g];
      float* f = p.F + (size_t)row4 * FS + 768 + g;
      f[0] = v0 + bb; f[FS] = v1 + bb; f[2 * FS] = v2 + bb; f[3 * FS] = v3 + bb;
    }
  }
};
DI void phaseA(const Params& p, int l, char* smem) {
  const bf16_t* Bt = p.WinT + (size_t)l * NIN * 1024;
  EpiA epi{p, p.b_gate + l * 8};
  gemm_phase(p.hbf, Bt, 23, smem, epi, false);
}

struct EpiC {
  const Params& p; const float* adaL; int l;
  DI void operator()(int row4, int col, float v0, float v1, float v2, float v3) const {
    const float* xr = (l == 0) ? (row4 < NP ? p.x_prompt + (size_t)row4 * 1024 : p.x_sample + (size_t)(row4 - NP) * 1024)
                               : p.XZ + (size_t)row4 * 1024;
    const float g1 = adaL[(size_t)cond_row(row4) * 6144 + 2048 + col];
    const float x0 = xr[col], x1 = xr[1024 + col], x2 = xr[2048 + col], x3 = xr[3072 + col];
    float* z = p.XZ + (size_t)row4 * 1024 + col;
    z[0] = ALPHA * x0 + g1 * v0; z[1024] = ALPHA * x1 + g1 * v1; z[2048] = ALPHA * x2 + g1 * v2; z[3072] = ALPHA * x3 + g1 * v3;
  }
};
DI void phaseC(const Params& p, int l, char* smem) {
  const bf16_t* Bt = p.WoT + (size_t)l * 1024 * 1024;
  EpiC epi{p, p.ada + (size_t)l * 136 * 6144, l};
  gemm_phase(p.hbf, Bt, 8, smem, epi, true);
}

struct EpiE {
  const Params& p;
  DI void operator()(int row4, int col, float v0, float v1, float v2, float v3) const {
    bf16_t* q = p.qkvo + (size_t)row4 * 2048 + col;
    q[0] = (bf16_t)f2bf(v0); q[2048] = (bf16_t)f2bf(v1); q[4096] = (bf16_t)f2bf(v2); q[6144] = (bf16_t)f2bf(v3);
  }
};
DI void phaseE(const Params& p, int l, char* smem) {
  const bf16_t* Bt = p.WpqT + (size_t)l * 2048 * 1024;
  EpiE epi{p};
  gemm_phase(p.hbf, Bt, 16, smem, epi, true);
}

DI void phaseD(const Params& p, int l) {
  const int tid = tidx(), lane = tid & 63, w = tid >> 6;
  const float* adaL = p.ada + (size_t)l * 136 * 6144;
  const float* g = p.ln1_g + l * 1024; const float* bta = p.ln1_b + l * 1024;
  for (int tok = bidx() * 4 + w; tok < NT; tok += gridDim.x * 4) {
    float* zr = p.XZ + (size_t)tok * 1024;
    const int c0 = lane * 8, c1 = 512 + lane * 8;
    float z[16]; ld8f(zr + c0, z); ld8f(zr + c1, z + 8);
    float s = 0.f;
#pragma unroll
    for (int j = 0; j < 16; ++j) s += z[j];
    const float mu = wsum(s) * (1.f / 1024.f);
    float q = 0.f;
#pragma unroll
    for (int j = 0; j < 16; ++j) { const float d = z[j] - mu; q += d * d; }
    const float rstd = rsqrtf(wsum(q) * (1.f / 1024.f) + LN_EPS);
    float gg[16], bb[16];
    ld8f(g + c0, gg); ld8f(g + c1, gg + 8); ld8f(bta + c0, bb); ld8f(bta + c1, bb + 8);
#pragma unroll
    for (int j = 0; j < 16; ++j) z[j] = (z[j] - mu) * rstd * gg[j] + bb[j];
    st8f(zr + c0, z); st8f(zr + c1, z + 8);
    const float* ad = adaL + (size_t)cond_row(tok) * 6144;
    float sc[16], sh[16], hv[16];
    ld8f(ad + 4096 + c0, sc); ld8f(ad + 4096 + c1, sc + 8); ld8f(ad + 3072 + c0, sh); ld8f(ad + 3072 + c1, sh + 8);
    float hm = 0.f;
#pragma unroll
    for (int j = 0; j < 16; ++j) { hv[j] = z[j] * (1.f + sc[j]) + sh[j]; hm = fmaxf(hm, fabsf(hv[j])); }
    *(uint4*)(p.hbf + (size_t)tok * 1024 + c0) = pack8(hv);
    *(uint4*)(p.hbf + (size_t)tok * 1024 + c1) = pack8(hv + 8);
    hm = wmax(hm);
    const float hinv = hm > 0.f ? 127.f / hm : 0.f;
    unsigned qw[4];
#pragma unroll
    for (int q = 0; q < 4; ++q) {
      const int q0 = (int)rintf(hv[4 * q] * hinv), q1 = (int)rintf(hv[4 * q + 1] * hinv), q2 = (int)rintf(hv[4 * q + 2] * hinv), q3 = (int)rintf(hv[4 * q + 3] * hinv);
      qw[q] = (unsigned)(q0 & 255) | ((unsigned)(q1 & 255) << 8) | ((unsigned)(q2 & 255) << 16) | ((unsigned)(q3 & 255) << 24);
    }
    *(uint2*)(p.xq + (size_t)tok * 1024 + c0) = make_uint2(qw[0], qw[1]);
    *(uint2*)(p.xq + (size_t)tok * 1024 + c1) = make_uint2(qw[2], qw[3]);
    if (lane == 0) p.xscale[tok] = hm * (1.f / 127.f);
  }
}

DI void mlstm_i(const Params& p, int l, int item, char* smem) {
  const int tid = tidx(), lane = tid & 63, w = tid >> 6, r = lane & 31, h = lane >> 5;
  const int bh = item >> 5, c = item & 31, b = bh >> 2, hh = bh & 3;
  const int tok0 = b * 2048 + c * 64;
  float* wc = (float*)smem;
  bf16_t* Vs = (bf16_t*)(smem + 256);
  bf16_t* Ks = Vs + 128 * 72;
  {
#pragma unroll
    for (int i = 0; i < 4; ++i) {
      const int pc = tid + 256 * i, row = pc >> 3, cc = (pc & 7) * 8;
      *(uint4*)(Vs + row * 72 + cc) = *(const uint4*)(p.VT + ((size_t)(bh * 128 + row)) * 2048 + c * 64 + cc);
      *(uint4*)(Ks + row * 72 + cc) = *(const uint4*)(p.KT + ((size_t)(bh * 128 + row)) * 2048 + c * 64 + cc);
    }
  }
  if (w == 0) {
    const float* f = p.F + (size_t)(tok0 + lane) * FS + 768;
    const float gi = f[hh], gf = f[4 + hh];
    float x = logsigmoidf_(gf);
#pragma unroll
    for (int o = 1; o < 64; o <<= 1) { const float t = __shfl_up(x, o); if (lane >= o) x += t; }
    const float bend = __shfl(x, 63);
    const float dend = bend - x + gi;
    const float mloc = wmax(dend);
    wc[lane] = __expf(dend - mloc);
    if (lane == 0) { p.scal[(bh * 32 + c) * 2] = bend; p.scal[(bh * 32 + c) * 2 + 1] = mloc; }
  }
  __syncthreads();
  const int vi = w >> 1, ki = w & 1;
  f32x16 acc[2][2];
#pragma unroll
  for (int i = 0; i < 2; ++i)
#pragma unroll
    for (int j = 0; j < 2; ++j)
#pragma unroll
      for (int e = 0; e < 16; ++e) acc[i][j][e] = 0.f;
  const bf16_t* vt = Vs + (vi * 64 + r) * 72 + h * 8;
  const bf16_t* kt = Ks + (ki * 64 + r) * 72 + h * 8;
#pragma unroll
  for (int ks = 0; ks < 4; ++ks) {
    float wv[8];
#pragma unroll
    for (int j = 0; j < 8; ++j) wv[j] = wc[ks * 16 + h * 8 + j];
    bf16x8 a[2], bb[2];
#pragma unroll
    for (int i = 0; i < 2; ++i) {
      const uint4 u = *(const uint4*)(vt + i * 32 * 72 + ks * 16);
      float x[8]; unpack8(u, x);
#pragma unroll
      for (int j = 0; j < 8; ++j) x[j] *= wv[j];
      a[i] = __builtin_bit_cast(bf16x8, pack8(x));
    }
#pragma unroll
    for (int j = 0; j < 2; ++j) bb[j] = ld8(kt + j * 32 * 72 + ks * 16);
#pragma unroll
    for (int i = 0; i < 2; ++i)
#pragma unroll
      for (int j = 0; j < 2; ++j) acc[i][j] = MFMA32(a[i], bb[j], acc[i][j]);
  }
  float* ch = p.CH + (size_t)(bh * 32 + c) * CHS;
#pragma unroll
  for (int i = 0; i < 2; ++i)
#pragma unroll
    for (int j = 0; j < 2; ++j)
#pragma unroll
      for (int e = 0; e < 16; ++e) ch[(vi * 64 + i * 32 + crow(e, h)) * 128 + ki * 64 + j * 32 + r] = acc[i][j][e];
  if (tid < 128) {
    float s = 0.f;
#pragma unroll
    for (int q = 0; q < 8; ++q) {
      float x[8]; unpack8(*(const uint4*)(Ks + tid * 72 + q * 8), x);
#pragma unroll
      for (int j = 0; j < 8; ++j) s += wc[q * 8 + j] * x[j];
    }
    ch[128 * 128 + tid] = s;
  }
  __syncthreads();
}

DI void phaseB2(const Params& p, int l) {
  const int tid = tidx();
  for (int it = bidx(); it < 32 * 17; it += gridDim.x) {
    const int bh = it / 17, sl = it % 17;
    const int e4 = sl * 256 + tid;
    if (e4 >= 4128) continue;
    float m = 0.f;
    float4 C = make_float4(0.f, 0.f, 0.f, 0.f);
    float4* base = (float4*)(p.CH + (size_t)bh * 32 * CHS) + e4;
#pragma unroll 4
    for (int c = 0; c < 32; ++c) {
      const float bend = p.scal[(bh * 32 + c) * 2], mloc = p.scal[(bh * 32 + c) * 2 + 1];
      float4* q = base + (size_t)c * (CHS / 4);
      const float4 d = *q;
      *q = C;
      if (e4 == 0) p.mstart[bh * 32 + c] = m;
      const float mn = fmaxf(bend + m, mloc);
      const float dec = __expf(bend + m - mn), sc = __expf(mloc - mn);
      C.x = dec * C.x + sc * d.x; C.y = dec * C.y + sc * d.y; C.z = dec * C.z + sc * d.z; C.w = dec * C.w + sc * d.w;
      m = mn;
    }
    if (e4 < 4096) *((float4*)(p.out + O_CP + (size_t)(l * 32 + bh) * 16384) + e4) = C;
    else *((float4*)(p.out + O_NP + (size_t)(l * 32 + bh) * 128) + (e4 - 4096)) = C;
    if (e4 == 0) p.out[O_MP + l * 32 + bh] = m;
  }
}

DI void mlstm_iii(const Params& p, int l, int item, char* smem) {
  const int tid = tidx(), lane = tid & 63, w = tid >> 6, r = lane & 31, h = lane >> 5;
  const int bh = item >> 5, c = item & 31, b = bh >> 2, hh = bh & 3;
  const int tok0 = b * 2048 + c * 64;
  bf16_t* Qs = (bf16_t*)smem;
  bf16_t* As = (bf16_t*)(smem + 17408);
  float* Hs = (float*)(smem + 26624);
  float* sv = (float*)(smem + 60416);
  float *rowoff = sv, *gsrc = sv + 64, *winter = sv + 128, *enm = sv + 192, *scl = sv + 256, *nvec = sv + 320, *mus = sv + 448, *rss = sv + 512;
  const float* ch = p.CH + (size_t)(bh * 32 + c) * CHS;
#pragma unroll
  for (int i = 0; i < 4; ++i) {
    const int pc = tid + 256 * i, row = pc >> 4, cc = (pc & 15) * 8;
    *(uint4*)(Qs + row * 136 + cc) = *(const uint4*)(p.qkvo + (size_t)(tok0 + row) * 2048 + hh * 128 + cc);
  }
  if (tid < 128) nvec[tid] = ch[128 * 128 + tid];
  if (w == 0) {
    const float* f = p.F + (size_t)(tok0 + lane) * FS + 768;
    const float gi = f[hh], gf = f[4 + hh];
    float x = logsigmoidf_(gf);
#pragma unroll
    for (int o = 1; o < 64; o <<= 1) { const float t = __shfl_up(x, o); if (lane >= o) x += t; }
    const float u = gi - x;
    float pm = u;
#pragma unroll
    for (int o = 1; o < 64; o <<= 1) { const float t = __shfl_up(pm, o); if (lane >= o) pm = fmaxf(pm, t); }
    const float mc = p.mstart[bh * 32 + c];
    const float inter = x + mc;
    const float mt = fmaxf(inter, x + pm);
    rowoff[lane] = x - mt; gsrc[lane] = u; winter[lane] = __expf(inter - mt); enm[lane] = __expf(-mt);
  }
  __syncthreads();
  {
    const int ti = w >> 1, si = w & 1;
    f32x16 acc;
#pragma unroll
    for (int e = 0; e < 16; ++e) acc[e] = 0.f;
    if (si <= ti) {
      const bf16_t* kp = p.qkvo + (size_t)(tok0 + si * 32 + r) * 2048 + 512 + hh * 128 + h * 8;
#pragma unroll
      for (int ks = 0; ks < 8; ++ks) {
        const bf16x8 a = ld8(Qs + (ti * 32 + r) * 136 + ks * 16 + h * 8);
        const bf16x8 bb = ld8(kp + ks * 16);
        acc = MFMA32(a, bb, acc);
      }
    }
    const int s = si * 32 + r;
    const float gs = gsrc[s];
#pragma unroll
    for (int e = 0; e < 16; ++e) {
      const int t = ti * 32 + crow(e, h);
      const float v = (s <= t) ? __expf(rowoff[t] + gs) * acc[e] : 0.f;
      As[t * 72 + s] = (bf16_t)f2bf(v);
    }
  }
  __syncthreads();
  f32x16 acc1[2], acc2[2];
#pragma unroll
  for (int i = 0; i < 2; ++i)
#pragma unroll
    for (int e = 0; e < 16; ++e) { acc1[i][e] = 0.f; acc2[i][e] = 0.f; }
  {
    const bf16_t* vt = p.VT + ((size_t)(bh * 128 + w * 32 + r)) * 2048 + c * 64 + h * 8;
#pragma unroll 2
    for (int ks = 0; ks < 4; ++ks) {
      const bf16x8 bb = ld8(vt + ks * 16);
#pragma unroll
      for (int i = 0; i < 2; ++i) { const bf16x8 a = ld8(As + (i * 32 + r) * 72 + ks * 16 + h * 8); acc1[i] = MFMA32(a, bb, acc1[i]); }
    }
    const float* cp = ch + (size_t)(w * 32 + r) * 128 + h * 8;
#pragma unroll 4
    for (int ks = 0; ks < 8; ++ks) {
      float x[8]; ld8f(cp + ks * 16, x);
      const bf16x8 bb = __builtin_bit_cast(bf16x8, pack8(x));
#pragma unroll
      for (int i = 0; i < 2; ++i) { const bf16x8 a = ld8(Qs + (i * 32 + r) * 136 + ks * 16 + h * 8); acc2[i] = MFMA32(a, bb, acc2[i]); }
    }
  }
  if (tid < 64) {
    const int t = tid;
    float di = 0.f;
#pragma unroll
    for (int q = 0; q < 8; ++q) { float x[8]; unpack8(*(const uint4*)(As + t * 72 + q * 8), x);
#pragma unroll
      for (int j = 0; j < 8; ++j) di += x[j]; }
    float nq = 0.f;
#pragma unroll 2
    for (int q = 0; q < 16; ++q) { float x[8]; unpack8(*(const uint4*)(Qs + t * 136 + q * 8), x);
#pragma unroll
      for (int j = 0; j < 8; ++j) nq += x[j] * nvec[q * 8 + j]; }
    const float den = di + winter[t] * nq;
    scl[t] = 1.f / fmaxf(fabsf(den), enm[t]);
  }
  __syncthreads();
#pragma unroll
  for (int i = 0; i < 2; ++i)
#pragma unroll
    for (int e = 0; e < 16; ++e) {
      const int t = i * 32 + crow(e, h);
      Hs[t * 132 + w * 32 + r] = (acc1[i][e] + winter[t] * acc2[i][e]) * scl[t];
    }
  __syncthreads();
  {
    const int t = tid >> 2, part = tid & 3;
    float s = 0.f;
#pragma unroll
    for (int j = 0; j < 32; ++j) s += Hs[t * 132 + j * 4 + part];
    s += __shfl_xor(s, 1); s += __shfl_xor(s, 2);
    const float mu = s * (1.f / 128.f);
    float q = 0.f;
#pragma unroll
    for (int j = 0; j < 32; ++j) { const float d = Hs[t * 132 + j * 4 + part] - mu; q += d * d; }
    q += __shfl_xor(q, 1); q += __shfl_xor(q, 2);
    if (part == 0) { mus[t] = mu; rss[t] = rsqrtf(q * (1.f / 128.f) + LN_EPS); }
  }
  __syncthreads();
  const float* mg = p.mh_g + l * 512 + hh * 128;
#pragma unroll
  for (int i = 0; i < 4; ++i) {
    const int pc = tid + 256 * i, t = pc >> 4, v0 = (pc & 15) * 8;
    float o[8]; unpack8(*(const uint4*)(p.qkvo + (size_t)(tok0 + t) * 2048 + 1536 + hh * 128 + v0), o);
    float gg[8]; ld8f(mg + v0, gg);
    const float mu = mus[t], rs = rss[t];
    float y[8];
#pragma unroll
    for (int j = 0; j < 8; ++j) y[j] = sigmoidf_(o[j]) * ((Hs[t * 132 + v0 + j] - mu) * rs * gg[j]);
    *(uint4*)(p.hbf + (size_t)(tok0 + t) * 1024 + hh * 128 + v0) = pack8(y);
  }
  __syncthreads();
}

DI void mlstm_sample(const Params& p, int l, int item, char* smem) {
  const int tid = tidx(), lane = tid & 63, w = tid >> 6;
  const int b = item >> 2, hh = item & 3;
  const int tok0 = NP + b * 4;
  float* qs = (float*)smem;
  float* ks = qs + 512;
  float* vs = ks + 512;
  float* hs = vs + 512;
  float* ns = hs + 512;
  float* qk = ns + 128;
  float* nq = qk + 16;
  const size_t sidx = (size_t)(l * 128 + b) * 4 + hh;
  for (int i = tid; i < 1536; i += 256) {
    const int m = i >> 9, t = (i >> 7) & 3, d = i & 127;
    qs[i] = bf2f(p.qkvo[(size_t)(tok0 + t) * 2048 + m * 512 + hh * 128 + d]);
  }
  if (tid < 128) ns[tid] = p.stN[sidx * 128 + tid];
  __syncthreads();
  {
    const int dp = tid >> 3, part = tid & 7;
    if (dp < 20) {
      const float* x = qs + (dp < 16 ? (dp >> 2) : (dp - 16)) * 128 + part * 16;
      const float* y = (dp < 16 ? ks + (dp & 3) * 128 : ns) + part * 16;
      float a = 0.f;
#pragma unroll
      for (int d = 0; d < 16; ++d) a += x[d] * y[d];
      a += __shfl_xor(a, 1); a += __shfl_xor(a, 2); a += __shfl_xor(a, 4);
      if (part == 0) { if (dp < 16) qk[dp] = a; else nq[dp - 16] = a; }
    }
  }
  float ig[4], bc[4];
  {
    float run = 0.f;
#pragma unroll
    for (int t = 0; t < 4; ++t) { const float* f = p.F + (size_t)(tok0 + t) * FS + 768; ig[t] = f[hh]; run += logsigmoidf_(f[4 + hh]); bc[t] = run; }
  }
  const float mprev = p.stM[sidx];
  float mt[4], wint[4];
#pragma unroll
  for (int t = 0; t < 4; ++t) {
    float mm = bc[t] + mprev;
#pragma unroll
    for (int s = 0; s < 4; ++s) if (s <= t) mm = fmaxf(mm, bc[t] - bc[s] + ig[s]);
    mt[t] = mm; wint[t] = __expf(bc[t] + mprev - mm);
  }
  const float bend = bc[3];
  float mnew = bend + mprev;
#pragma unroll
  for (int s = 0; s < 4; ++s) mnew = fmaxf(mnew, bend - bc[s] + ig[s]);
  float wcs[4];
#pragma unroll
  for (int s = 0; s < 4; ++s) wcs[s] = __expf(bend - bc[s] + ig[s] - mnew);
  const float dec = __expf(bend + mprev - mnew);
  __syncthreads();
  float a[4][4], den[4];
#pragma unroll
  for (int t = 0; t < 4; ++t) {
    float ds = 0.f;
#pragma unroll
    for (int s = 0; s < 4; ++s) { a[t][s] = (s <= t) ? __expf(bc[t] - bc[s] + ig[s] - mt[t]) * qk[t * 4 + s] : 0.f; ds += a[t][s]; }
    den[t] = ds + wint[t] * nq[t];
  }
  {
    const int k4i = tid & 31, rgrp = tid >> 5, l5 = lane & 31;
    const bool bb4 = l5 & 16, bb3 = l5 & 8;
    float4 q4[4], k4[4];
#pragma unroll
    for (int t = 0; t < 4; ++t) { q4[t] = *(const float4*)(qs + t * 128 + k4i * 4); k4[t] = *(const float4*)(ks + t * 128 + k4i * 4); }
    const float wint_t = bb4 ? (bb3 ? wint[3] : wint[2]) : (bb3 ? wint[1] : wint[0]);
    const float den_t = bb4 ? (bb3 ? den[3] : den[2]) : (bb3 ? den[1] : den[0]);
    const float mt_t = bb4 ? (bb3 ? mt[3] : mt[2]) : (bb3 ? mt[1] : mt[0]);
    const float invd_t = 1.f / fmaxf(fabsf(den_t), __expf(-mt_t));
    float a_t[4];
#pragma unroll
    for (int s = 0; s < 4; ++s) a_t[s] = bb4 ? (bb3 ? a[3][s] : a[2][s]) : (bb3 ? a[1][s] : a[0][s]);
    const int tsel = (bb4 ? 2 : 0) + (bb3 ? 1 : 0);
    const float* cbase = p.stC + sidx * 16384 + k4i * 4;
    float* obase = p.out + O_CS + sidx * 16384 + k4i * 4;
#pragma unroll 4
    for (int j = 0; j < 16; ++j) {
      const int vrow = rgrp + 8 * j;
      const float4 cv = *(const float4*)(cbase + vrow * 128);
      const float v0 = vs[vrow], v1 = vs[128 + vrow], v2 = vs[256 + vrow], v3 = vs[384 + vrow];
      float pt[4];
#pragma unroll
      for (int t = 0; t < 4; ++t) pt[t] = cv.x * q4[t].x + cv.y * q4[t].y + cv.z * q4[t].z + cv.w * q4[t].w;
      const float w0 = wcs[0] * v0, w1 = wcs[1] * v1, w2 = wcs[2] * v2, w3 = wcs[3] * v3;
      float4 cn;
      cn.x = dec * cv.x + w0 * k4[0].x + w1 * k4[1].x + w2 * k4[2].x + w3 * k4[3].x;
      cn.y = dec * cv.y + w0 * k4[0].y + w1 * k4[1].y + w2 * k4[2].y + w3 * k4[3].y;
      cn.z = dec * cv.z + w0 * k4[0].z + w1 * k4[1].z + w2 * k4[2].z + w3 * k4[3].z;
      cn.w = dec * cv.w + w0 * k4[0].w + w1 * k4[1].w + w2 * k4[2].w + w3 * k4[3].w;
      *(float4*)(obase + vrow * 128) = cn;
      float r2[2];
#pragma unroll
      for (int jj = 0; jj < 2; ++jj) { const float x = pt[jj], y = pt[jj + 2]; r2[jj] = (bb4 ? y : x) + __shfl_xor(bb4 ? x : y, 16); }
      float r1 = (bb3 ? r2[1] : r2[0]) + __shfl_xor(bb3 ? r2[0] : r2[1], 8);
      r1 += __shfl_xor(r1, 4); r1 += __shfl_xor(r1, 2); r1 += __shfl_xor(r1, 1);
      if ((l5 & 7) == 0) hs[tsel * 128 + vrow] = (wint_t * r1 + a_t[0] * v0 + a_t[1] * v1 + a_t[2] * v2 + a_t[3] * v3) * invd_t;
    }
  }
  if (tid < 128) {
    float nn = dec * ns[tid];
#pragma unroll
    for (int s = 0; s < 4; ++s) nn += wcs[s] * ks[s * 128 + tid];
    p.out[O_NS + sidx * 128 + tid] = nn;
  }
  if (tid == 0) p.out[O_MS + sidx] = mnew;
  __syncthreads();
  {
    const int t = w;
    const float h0 = hs[t * 128 + lane], h1 = hs[t * 128 + 64 + lane];
    const float mu = wsum(h0 + h1) * (1.f / 128.f);
    const float d0 = h0 - mu, d1 = h1 - mu;
    const float rs = rsqrtf(wsum(d0 * d0 + d1 * d1) * (1.f / 128.f) + LN_EPS);
    const float* mg = p.mh_g + l * 512 + hh * 128;
    const bf16_t* op = p.qkvo + (size_t)(tok0 + t) * 2048 + 1536 + hh * 128;
    bf16_t* yp = p.hbf + (size_t)(tok0 + t) * 1024 + hh * 128;
    yp[lane] = (bf16_t)f2bf(sigmoidf_(bf2f(op[lane])) * d0 * rs * mg[lane]);
    yp[64 + lane] = (bf16_t)f2bf(sigmoidf_(bf2f(op[64 + lane])) * d1 * rs * mg[64 + lane]);
  }
  __syncthreads();
}

DI void sgu_prompt(const Params& p, int l, int item, char* smem) {
  const int tid = tidx(), lane = tid & 63, w = tid >> 6, r = lane & 31, h = lane >> 5;
  const int g = item & 3, bc = item >> 2;
  const int tok0 = bc * 128;
  bf16_t* Ws = (bf16_t*)smem;
  bf16_t* Vt = (bf16_t*)(smem + 34816);
  {
    const int s = tid >> 1, hf = tid & 1;
    const float* vp = p.F + (size_t)(tok0 + s) * FS + 256 + g * 64 + hf * 32;
    float x[32];
#pragma unroll
    for (int q = 0; q < 4; ++q) ld8f(vp + q * 8, x + q * 8);
    float sm = 0.f;
#pragma unroll
    for (int j = 0; j < 32; ++j) sm += x[j];
    sm += __shfl_xor(sm, 1);
    const float mu = sm * (1.f / 64.f);
    float q2 = 0.f;
#pragma unroll
    for (int j = 0; j < 32; ++j) { const float d = x[j] - mu; q2 += d * d; }
    q2 += __shfl_xor(q2, 1);
    const float rs = rsqrtf(q2 * (1.f / 64.f) + LN_EPS);
    const float* gp = p.sgu_g + l * 256 + g * 64 + hf * 32;
    const float* bp = p.sgu_b + l * 256 + g * 64 + hf * 32;
#pragma unroll
    for (int j = 0; j < 32; ++j) Vt[(hf * 32 + j) * 136 + s] = (bf16_t)f2bf((x[j] - mu) * rs * gp[j] + bp[j]);
  }
  {
    const float* wsp = p.w_s + (size_t)(l * 4 + g) * 16384;
#pragma unroll
    for (int i = 0; i < 16; ++i) {
      const int e4 = tid + 256 * i, t = e4 >> 5, s0 = (e4 & 31) * 4;
      const float4 v = *(const float4*)(wsp + t * 128 + s0);
      const float a0 = s0 <= t ? v.x : 0.f, a1 = s0 + 1 <= t ? v.y : 0.f, a2 = s0 + 2 <= t ? v.z : 0.f, a3 = s0 + 3 <= t ? v.w : 0.f;
      *(uint2*)(Ws + t * 136 + s0) = make_uint2(pack2(a0, a1), pack2(a2, a3));
    }
  }
  __syncthreads();
  f32x16 acc[2];
#pragma unroll
  for (int j = 0; j < 2; ++j)
#pragma unroll
    for (int e = 0; e < 16; ++e) acc[j][e] = 0.f;
#pragma unroll
  for (int ks = 0; ks < 8; ++ks) {
    const bf16x8 a = ld8(Ws + (w * 32 + r) * 136 + ks * 16 + h * 8);
#pragma unroll
    for (int j = 0; j < 2; ++j) { const bf16x8 bb = ld8(Vt + (j * 32 + r) * 136 + ks * 16 + h * 8); acc[j] = MFMA32(a, bb, acc[j]); }
  }
  const float* bsp = p.b_s + (l * 4 + g) * 128;
#pragma unroll
  for (int j = 0; j < 2; ++j)
#pragma unroll
    for (int e = 0; e < 16; ++e) {
      const int t = w * 32 + crow(e, h), d = j * 32 + r;
      const float u = p.F[(size_t)(tok0 + t) * FS + g * 64 + d];
      p.hbf[(size_t)(tok0 + t) * 1024 + 512 + g * 64 + d] = (bf16_t)f2bf(u * (acc[j][e] + bsp[t]));
    }
  __syncthreads();
}

DI void sgu_sample(const Params& p, int l, int b) {
  const int tid = tidx(), g = tid >> 6;
  const int tok0 = NP + b * 4;
  float vn[4];
  const float gg = p.sgu_g[l * 256 + tid], bb = p.sgu_b[l * 256 + tid];
#pragma unroll
  for (int t = 0; t < 4; ++t) {
    const float x = p.F[(size_t)(tok0 + t) * FS + 256 + tid];
    const float mu = wsum(x) * (1.f / 64.f);
    const float d = x - mu;
    const float rs = rsqrtf(wsum(d * d) * (1.f / 64.f) + LN_EPS);
    vn[t] = d * rs * gg + bb;
    p.out[O_SV + ((size_t)(l * 128 + b) * 4 + t) * 256 + tid] = vn[t];
  }
  const float* wsp = p.w_s + (size_t)(l * 4 + g) * 16384;
  const float* bsp = p.b_s + (l * 4 + g) * 128;
#pragma unroll
  for (int t = 0; t < 4; ++t) {
    float mix = bsp[t];
#pragma unroll
    for (int s = 0; s < 4; ++s) if (s <= t) mix += wsp[t * 128 + s] * vn[s];
    const float u = p.F[(size_t)(tok0 + t) * FS + tid];
    p.hbf[(size_t)(tok0 + t) * 1024 + 512 + tid] = (bf16_t)f2bf(u * mix);
  }
}

DI void pool_tail(const Params& p, int l, int tokbase, const float* P, int tid) {
  const int g = tid >> 6, e = tid & 63;
  float acc[16];
#pragma unroll
  for (int i = 0; i < 16; ++i) acc[i] = 0.f;
  const float* wp = p.w_pool + (size_t)(l * 4 + g) * 4096 + e;
#pragma unroll 4
  for (int d4 = 0; d4 < 16; ++d4) {
    const float w0 = wp[(d4 * 4) * 64], w1 = wp[(d4 * 4 + 1) * 64], w2 = wp[(d4 * 4 + 2) * 64], w3 = wp[(d4 * 4 + 3) * 64];
#pragma unroll
    for (int tt = 0; tt < 16; ++tt) {
      const float4 p4 = *(const float4*)(P + tt * 256 + g * 64 + d4 * 4);
      acc[tt] += p4.x * w0 + p4.y * w1 + p4.z * w2 + p4.w * w3;
    }
  }
  const float ps = p.pool_scale[l * 256 + tid];
#pragma unroll
  for (int tt = 0; tt < 16; ++tt) p.hbf[(size_t)(tokbase + tt) * 1024 + 768 + tid] = (bf16_t)f2bf(acc[tt] * ps);
}

DI void pool_prompt(const Params& p, int l, int item, char* smem) {
  const int tid = tidx();
  const int b = item >> 7, t0 = (item & 127) * 16;
  float* X = (float*)smem;
  float* P = X + 31 * 256;
#pragma unroll
  for (int i = 0; i < 31; ++i) { const int t = t0 - 15 + i; const int tc = t >= 0 ? t : 0; const float v = p.F[(size_t)(b * 2048 + tc) * FS + 512 + tid]; X[i * 256 + tid] = t >= 0 ? v : 0.f; }
  __syncthreads();
  const int g = tid >> 6, wsz = 2 << g;
#pragma unroll 4
  for (int tt = 0; tt < 16; ++tt) {
    float s = 0.f;
#pragma unroll
    for (int j = 0; j < 16; ++j) { const float xv = X[(15 + tt - j) * 256 + tid]; s += j < wsz ? xv : 0.f; }
    const int pos = t0 + tt;
    const float cnt = (float)(pos + 1 < wsz ? pos + 1 : wsz);
    P[tt * 256 + tid] = s / cnt - X[(15 + tt) * 256 + tid];
  }
  if (t0 == 2032)
    for (int tt = 1; tt < 16; ++tt) p.out[O_PP + ((size_t)(l * 8 + b) * 15 + (tt - 1)) * 256 + tid] = X[(15 + tt) * 256 + tid];
  __syncthreads();
  pool_tail(p, l, b * 2048 + t0, P, tid);
  __syncthreads();
}

DI void pool_sample(const Params& p, int l, int item, char* smem) {
  const int tid = tidx();
  const int b0 = item * 4;
  float* X = (float*)smem;
  float* P = X + 31 * 256;
  const int g = tid >> 6, wsz = 2 << g;
  for (int bi = 0; bi < 4; ++bi) {
    const int b = b0 + bi;
#pragma unroll
    for (int i = 0; i < 19; ++i)
      X[i * 256 + tid] = i < 15 ? p.stPool[((size_t)(l * 128 + b) * 15 + i) * 256 + tid] : p.F[(size_t)(NP + b * 4 + (i - 15)) * FS + 512 + tid];
    __syncthreads();
#pragma unroll
    for (int t = 0; t < 4; ++t) {
      float s = 0.f;
#pragma unroll
      for (int j = 0; j < 16; ++j) { const float xv = X[(15 + t - j) * 256 + tid]; s += j < wsz ? xv : 0.f; }
      P[(bi * 4 + t) * 256 + tid] = s / (float)wsz - X[(15 + t) * 256 + tid];
    }
#pragma unroll
    for (int i = 0; i < 15; ++i) p.out[O_PS + ((size_t)(l * 128 + b) * 15 + i) * 256 + tid] = X[(4 + i) * 256 + tid];
    __syncthreads();
  }
  pool_tail(p, l, NP + b0 * 4, P, tid);
  __syncthreads();
}

DI void phaseB1(const Params& p, int l, char* smem) {
  const int G = gridDim.x, bx = bidx();
  for (int it = bx; it < 512; it += G) mlstm_sample(p, l, it, smem);
  for (int it = (bx + 256) % G; it < 1024; it += G) mlstm_i(p, l, it, smem);
  for (int it = bx; it < 512; it += G) sgu_prompt(p, l, it, smem);
  for (int it = (bx + 128) % G; it < 128; it += G) sgu_sample(p, l, it);
  for (int it = bx; it < 1024; it += G) pool_prompt(p, l, it, smem);
  for (int it = (bx + 64) % G; it < 32; it += G) pool_sample(p, l, it, smem);
}

DI void phaseB3(const Params& p, int l, char* smem) {
  for (int it = bidx(); it < 1024; it += gridDim.x) mlstm_iii(p, l, it, smem);
}

__device__ const unsigned kCandWords[16] = {0x03020100u, 0x07060504u, 0x0b0a0908u, 0x0f0e0d0cu, 0x13121110u, 0x17161514u, 0x23222120u, 0x32313024u,
                                            0x42414033u, 0x61605150u, 0x90807170u, 0xd0c0b0a0u, 0xfffff0e0u, 0xffffffffu, 0xffffffffu, 0xffffffffu};

DI void ce_(int& a, int& b, bool desc) { const int hi = max(a, b), lo = min(a, b); a = desc ? hi : lo; b = desc ? lo : hi; }
DI void bitonic_sort16(int* v) {
#pragma unroll
  for (int k = 2; k <= 16; k <<= 1) {
#pragma unroll
    for (int j = k >> 1; j >= 1; j >>= 1) {
#pragma unroll
      for (int i = 0; i < 16; ++i) { const int l = i ^ j; if (l > i) ce_(v[i], v[l], (i & k) == 0); }
    }
  }
}
DI void bitonic_merge16(int* v) {
#pragma unroll
  for (int j = 8; j >= 1; j >>= 1) {
#pragma unroll
    for (int i = 0; i < 16; ++i) { const int l = i ^ j; if (l > i) ce_(v[i], v[l], true); }
  }
}

DI void phaseF(const Params& p, int l, char* smem) {
  const int tid = tidx(), lane = tid & 63, w = tid >> 6, r = lane & 31, h = lane >> 5;
  float* Sc = (float*)smem;
  float* ls = (float*)(smem + 33024);
  int* li = (int*)(smem + 41472);
  int* jp = (int*)(smem + 49920);
  for (int it = bidx(); it < 264 * 8; it += gridDim.x) {
    const int tile = it >> 3, hd = it & 7;
    const int tok0 = tile * 64;
    for (int pp = 0; pp < 2; ++pp) {
      f32x16 acc[2];
#pragma unroll
      for (int i = 0; i < 2; ++i)
#pragma unroll
        for (int e = 0; e < 16; ++e) acc[i][e] = 0.f;
      const bf16_t* qp = p.qkvo + (size_t)(tok0 + r) * 2048 + (hd * 2 + pp) * 128 + h * 8;
      const bf16_t* kp = p.keysb + ((size_t)((l * 8 + hd) * 2 + pp) * 128 + w * 32 + r) * 128 + h * 8;
#pragma unroll
      for (int ks = 0; ks < 8; ++ks) {
        const bf16x8 bb = ld8(kp + ks * 16);
#pragma unroll
        for (int i = 0; i < 2; ++i) { const bf16x8 a = ld8(qp + (size_t)i * 32 * 2048 + ks * 16); acc[i] = MFMA32(a, bb, acc[i]); }
      }
#pragma unroll
      for (int i = 0; i < 2; ++i)
#pragma unroll
        for (int e = 0; e < 16; ++e) Sc[(i * 32 + crow(e, h)) * 129 + w * 32 + r] = acc[i][e];
      __syncthreads();
      {
        const int row = tid >> 2, part = tid & 3;
        int va[16], vb[16];
#pragma unroll
        for (int j = 0; j < 16; ++j) {
          const int fa = __float_as_int(Sc[row * 129 + j * 4 + part]);
          const int ma = fa ^ ((fa >> 31) & 0x7fffffff);
          va[j] = (ma & ~127) | (127 - (j * 4 + part));
          const int fb = __float_as_int(Sc[row * 129 + (j + 16) * 4 + part]);
          const int mb = fb ^ ((fb >> 31) & 0x7fffffff);
          vb[j] = (mb & ~127) | (127 - ((j + 16) * 4 + part));
        }
        bitonic_sort16(va); bitonic_sort16(vb);
        int vc[16];
#pragma unroll
        for (int i = 0; i < 16; ++i) vc[i] = max(va[i], vb[15 - i]);
        bitonic_merge16(vc);
#pragma unroll
        for (int o = 1; o < 4; o <<= 1) {
          int vp[16];
#pragma unroll
          for (int i = 0; i < 16; ++i) vp[i] = (o == 1) ? dpp_xor1(vc[15 - i]) : dpp_xor2(vc[15 - i]);
#pragma unroll
          for (int i = 0; i < 16; ++i) vc[i] = max(vc[i], vp[i]);
          bitonic_merge16(vc);
        }
        if (part == 0) {
#pragma unroll
          for (int i = 0; i < 16; ++i) {
            const int mono = vc[i] & ~127;
            ls[row * 33 + pp * 16 + i] = __int_as_float(mono ^ ((mono >> 31) & 0x7fffffff));
            li[row * 33 + pp * 16 + i] = 127 - (vc[i] & 127);
          }
        }
      }
      __syncthreads();
    }
    {
      const int row = tid >> 2, part = tid & 3;
      int vc[16];
#pragma unroll
      for (int k = 0; k < 16; ++k) {
        const unsigned cw = kCandWords[k];
        const unsigned ij = (cw >> (8 * part)) & 0xffu;
        const int c = 4 * k + part;
        int key = (int)0x80000000;
        if (ij != 0xffu) {
          const float v = ls[row * 33 + (ij >> 4)] + ls[row * 33 + 16 + (ij & 15)];
          const int fb = __float_as_int(v);
          const int mono = fb ^ ((fb >> 31) & 0x7fffffff);
          key = (mono & ~63) | (63 - c);
        }
        vc[k] = key;
      }
      bitonic_sort16(vc);
#pragma unroll
      for (int o = 1; o < 4; o <<= 1) {
        int vp[16];
#pragma unroll
        for (int i = 0; i < 16; ++i) vp[i] = (o == 1) ? dpp_xor1(vc[15 - i]) : dpp_xor2(vc[15 - i]);
#pragma unroll
        for (int i = 0; i < 16; ++i) vc[i] = max(vc[i], vp[i]);
        bitonic_merge16(vc);
      }
      float sc[16];
      float sum = 0.f;
#pragma unroll
      for (int st = 0; st < 16; ++st) {
        const int mono = vc[st] & ~63;
        sc[st] = __int_as_float(mono ^ ((mono >> 31) & 0x7fffffff));
      }
      const float s0 = sc[0];
#pragma unroll
      for (int st = 0; st < 16; ++st) { sc[st] = __expf(sc[st] - s0); sum += sc[st]; }
      const float inv = 1.f / sum;
      int oid[4]; float og[4];
#pragma unroll
      for (int q = 0; q < 4; ++q) {
        const int kq = part == 0 ? vc[q] : (part == 1 ? vc[4 + q] : (part == 2 ? vc[8 + q] : vc[12 + q]));
        const float gq = part == 0 ? sc[q] : (part == 1 ? sc[4 + q] : (part == 2 ? sc[8 + q] : sc[12 + q]));
        const int c = 63 - (kq & 63);
        const unsigned ij = (kCandWords[c >> 2] >> (8 * (c & 3))) & 0xffu;
        oid[q] = li[row * 33 + (ij >> 4)] * 128 + li[row * 33 + 16 + (ij & 15)];
        og[q] = gq * inv;
      }
      *(int4*)(p.pidx + (size_t)(tok0 + row) * 128 + hd * 16 + part * 4) = make_int4(oid[0], oid[1], oid[2], oid[3]);
      *(float4*)(p.pgate + (size_t)(tok0 + row) * 128 + hd * 16 + part * 4) = make_float4(og[0], og[1], og[2], og[3]);
    }
    __syncthreads();
  }
}

constexpr int GT = 12;
DI void phaseG(const Params& p, int l, char* smem) {
  const int tid = tidx(), lane = tid & 63, w = tid >> 6, g = lane >> 3, sub = lane & 7;
  const int TW = gridDim.x * 4, wg = bidx() * 4 + w;
  const unsigned char* Uq = p.Uq + (size_t)l * 16384 * 1024;
  const unsigned char* Vq = p.Vq + (size_t)l * 16384 * 1024;
  const float* usc = p.uscale + l * 16384; const float* vsc = p.vscale + l * 16384;
  const float* adaL = p.ada + (size_t)l * 136 * 6144;
  const float* g2g = p.ln2_g + l * 1024; const float* g2b = p.ln2_b + l * 1024;
  float* dstbase = (l == 1) ? p.out : p.XZ;
  float* Y = p.F;
  int* spk0 = (int*)smem + w * (4 * GT * 64) + lane;
  int* spk1 = spk0 + GT * 64;
  const int* gpk0 = (const int*)smem + w * (4 * GT * 64) + 8 * g;
  const int* gpk1 = gpk0 + GT * 64;
  int* sa0 = spk0 + 2 * GT * 64;
  int* sa1 = spk0 + 3 * GT * 64;
  const unsigned sub16 = (unsigned)sub << 4;
  const bool b2 = sub & 4, b1 = sub & 2, b0 = sub & 1;
  const bool b5 = g & 4, b4 = g & 2, b3 = g & 1;
  for (int base = wg; base < NT; base += TW * GT) {
    const int nt = min(GT, (NT - base + TW - 1) / TW);
    for (int i = 0; i < nt; ++i) {
      const int tok = base + i * TW;
      spk0[i * 64] = p.pidx[(size_t)tok * 128 + 8 * sub + g];
      spk1[i * 64] = p.pidx[(size_t)tok * 128 + 64 + 8 * sub + g];
      sa0[i * 64] = 0; sa1[i * 64] = 0;
    }
    const int nsteps = 8 * nt;
#define G_NEXT(c_, i_, cn_, in_) { in_ = (i_) + 1; cn_ = (c_); if (in_ == nt) { in_ = 0; cn_ = (c_) + 1; } if (cn_ == 8) { cn_ = (c_); in_ = (i_); } }
#define U_GATHER(BUF, XS, c_, i_)                                                                            \
    { const unsigned char* tb_ = Uq + (size_t)(c_) * 16384 * 128;                                            \
      XS = *(const uint4*)(p.xq + (size_t)(base + (i_) * TW) * 1024 + (c_) * 128 + sub * 16);                \
      const int4 ka_ = *(const int4*)(gpk0 + (i_) * 64), kb_ = *(const int4*)(gpk0 + (i_) * 64 + 4);         \
      const int4 kc_ = *(const int4*)(gpk1 + (i_) * 64), kd_ = *(const int4*)(gpk1 + (i_) * 64 + 4);         \
      const int kk_[16] = {ka_.x, ka_.y, ka_.z, ka_.w, kb_.x, kb_.y, kb_.z, kb_.w, kc_.x, kc_.y, kc_.z, kc_.w, kd_.x, kd_.y, kd_.z, kd_.w}; \
      _Pragma("unroll") for (int ld = 0; ld < 16; ++ld) {                                                    \
        const unsigned e_ = (unsigned)kk_[ld] & 0xffffu;                                                     \
        BUF[ld] = *(const uint4*)(tb_ + ((e_ << 7) | sub16)); } }
#define U_COMPUTE(BUF, XS, i_)                                                                               \
    {                                                                                                        \
      int t[16];                                                                                             \
      _Pragma("unroll") for (int ld = 0; ld < 16; ++ld) {                                                    \
        int v = __builtin_amdgcn_sdot4((int)BUF[ld].x, (int)XS.x, 0, false);                                 \
        v = __builtin_amdgcn_sdot4((int)BUF[ld].y, (int)XS.y, v, false);                                     \
        v = __builtin_amdgcn_sdot4((int)BUF[ld].z, (int)XS.z, v, false);                                     \
        v = __builtin_amdgcn_sdot4((int)BUF[ld].w, (int)XS.w, v, false); t[ld] = v; }                        \
      int wsum2[2];                                                                                          \
      _Pragma("unroll") for (int k = 0; k < 2; ++k) {                                                        \
        int u4[4], v2[2];                                                                                    \
        _Pragma("unroll") for (int j = 0; j < 4; ++j) { const int x = t[8 * k + j], y = t[8 * k + j + 4]; u4[j] = (b2 ? y : x) + dpp_xor4(b2 ? x : y); } \
        _Pragma("unroll") for (int j = 0; j < 2; ++j) { const int x = u4[j], y = u4[j + 2]; v2[j] = (b1 ? y : x) + dpp_xor2(b1 ? x : y); } \
        { const int x = v2[0], y = v2[1]; wsum2[k] = (b0 ? y : x) + dpp_xor1(b0 ? x : y); } }               \
      sa0[(i_) * 64] += wsum2[0]; sa1[(i_) * 64] += wsum2[1];                                                \
    }
    {
      uint4 A[16]; uint4 xa;
      for (int c = 0; c < 8; ++c)
        for (int i = 0; i < nt; ++i) {
          U_GATHER(A, xa, c, i)
          U_COMPUTE(A, xa, i)
        }
    }
    for (int i = 0; i < nt; ++i) {
      const int tok = base + i * TW;
      const float xsc = p.xscale[tok];
      const float gv0 = p.pgate[(size_t)tok * 128 + 8 * sub + g], gv1 = p.pgate[(size_t)tok * 128 + 64 + 8 * sub + g];
      const int e0 = spk0[i * 64], e1 = spk1[i * 64];
      const float a0 = (float)sa0[i * 64] * usc[e0] * xsc, a1 = (float)sa1[i * 64] * usc[e1] * xsc;
      const float c0f = gv0 * 0.5f * a0 * (1.f + erff(a0 * 0.70710678118654752f)) * vsc[e0];
      const float c1f = gv1 * 0.5f * a1 * (1.f + erff(a1 * 0.70710678118654752f)) * vsc[e1];
      spk0[i * 64] = e0 | (int)(f2bf(c0f) << 16); spk1[i * 64] = e1 | (int)(f2bf(c1f) << 16);
    }
    {
      uint4 A[16]; unsigned ca[8];
#define V_GATHER(BUF, CF, c_, i_)                                                                            \
      { const unsigned char* tb_ = Vq + (size_t)(c_) * 16384 * 128;                                          \
        const int4 ka_ = *(const int4*)(gpk0 + (i_) * 64), kb_ = *(const int4*)(gpk0 + (i_) * 64 + 4);       \
        const int4 kc_ = *(const int4*)(gpk1 + (i_) * 64), kd_ = *(const int4*)(gpk1 + (i_) * 64 + 4);       \
        const int kk_[16] = {ka_.x, ka_.y, ka_.z, ka_.w, kb_.x, kb_.y, kb_.z, kb_.w, kc_.x, kc_.y, kc_.z, kc_.w, kd_.x, kd_.y, kd_.z, kd_.w}; \
        _Pragma("unroll") for (int ld = 0; ld < 16; ++ld) {                                                  \
          const unsigned pv_ = (unsigned)kk_[ld];                                                            \
          BUF[ld] = *(const uint4*)(tb_ + (((pv_ & 0xffffu) << 7) | sub16));                                 \
          if (ld & 1) CF[ld >> 1] |= pv_ & 0xffff0000u; else CF[ld >> 1] = pv_ >> 16; } }
#define FP8ACC(w_, o_) { const f32x2 lo = __builtin_amdgcn_cvt_pk_f32_fp8((int)(w_), false); const f32x2 hi = __builtin_amdgcn_cvt_pk_f32_fp8((int)(w_), true); \
        yv[(o_) / 2] = lo * cf2 + yv[(o_) / 2]; yv[(o_) / 2 + 1] = hi * cf2 + yv[(o_) / 2 + 1]; }
#define V_COMPUTE(BUF, CF, c_, i_)                                                                           \
      {                                                                                                      \
        f32x2 yv[8];                                                                                         \
        _Pragma("unroll") for (int j = 0; j < 8; ++j) { yv[j].x = 0.f; yv[j].y = 0.f; }                      \
        _Pragma("unroll") for (int ld = 0; ld < 16; ++ld) {                                                  \
          const float cf = (ld & 1) ? __uint_as_float(CF[ld >> 1] & 0xffff0000u) : __uint_as_float(CF[ld >> 1] << 16); \
          f32x2 cf2; cf2.x = cf; cf2.y = cf;                                                                 \
          unsigned w0_ = BUF[ld].x, w1_ = BUF[ld].y, w2_ = BUF[ld].z, w3_ = BUF[ld].w;                      \
          asm volatile("" : "+v"(w0_), "+v"(w1_), "+v"(w2_), "+v"(w3_));                                   \
          FP8ACC(w0_, 0) FP8ACC(w1_, 4) FP8ACC(w2_, 8) FP8ACC(w3_, 12)                                      \
          asm volatile("" : "+v"(yv[0]), "+v"(yv[1]), "+v"(yv[2]), "+v"(yv[3]), "+v"(yv[4]), "+v"(yv[5]), "+v"(yv[6]), "+v"(yv[7])); } \
        float y16[16];                                                                                       \
        _Pragma("unroll") for (int j = 0; j < 8; ++j) { y16[2 * j] = yv[j].x; y16[2 * j + 1] = yv[j].y; }    \
        float z8[8], z4[4], z2[2];                                                                           \
        _Pragma("unroll") for (int j = 0; j < 8; ++j) { const float x = y16[j], y = y16[j + 8]; z8[j] = (b5 ? y : x) + __shfl_xor(b5 ? x : y, 32); } \
        _Pragma("unroll") for (int j = 0; j < 4; ++j) { const float x = z8[j], y = z8[j + 4]; z4[j] = (b4 ? y : x) + __shfl_xor(b4 ? x : y, 16); } \
        _Pragma("unroll") for (int j = 0; j < 2; ++j) { const float x = z4[j], y = z4[j + 2]; z2[j] = (b3 ? y : x) + dpp_xor8f(b3 ? x : y); } \
        *(float2*)(Y + (size_t)(base + (i_) * TW) * 1024 + (c_) * 128 + sub * 16 + 2 * g) = make_float2(z2[0], z2[1]); \
      }
      for (int c = 0; c < 8; ++c)
        for (int i = 0; i < nt; ++i) {
          V_GATHER(A, ca, c, i)
          V_COMPUTE(A, ca, c, i)
        }
    }
    __threadfence();
    for (int i = 0; i < nt; ++i) {
      const int tok = base + i * TW;
      const int c0i = lane * 8, c1i = 512 + lane * 8;
      const float* ad = adaL + (size_t)cond_row(tok) * 6144;
      const float* xr = p.XZ + (size_t)tok * 1024;
      const float* yr = Y + (size_t)tok * 1024;
      float z[16], gg[16], y[16];
      ld8f(xr + c0i, z); ld8f(xr + c1i, z + 8);
      ld8f(yr + c0i, y); ld8f(yr + c1i, y + 8);
      ld8f(ad + 5120 + c0i, gg); ld8f(ad + 5120 + c1i, gg + 8);
      float sm = 0.f;
#pragma unroll
      for (int j = 0; j < 16; ++j) { z[j] = ALPHA * z[j] + gg[j] * y[j]; sm += z[j]; }
      const float mu = wsum(sm) * (1.f / 1024.f);
      float q = 0.f;
#pragma unroll
      for (int j = 0; j < 16; ++j) { const float d = z[j] - mu; q += d * d; }
      const float rstd = rsqrtf(wsum(q) * (1.f / 1024.f) + LN_EPS);
      float bb[16];
      ld8f(g2g + c0i, gg); ld8f(g2g + c1i, gg + 8); ld8f(g2b + c0i, bb); ld8f(g2b + c1i, bb + 8);
#pragma unroll
      for (int j = 0; j < 16; ++j) z[j] = (z[j] - mu) * rstd * gg[j] + bb[j];
      float* dr = dstbase + (size_t)tok * 1024;
      st8f(dr + c0i, z); st8f(dr + c1i, z + 8);
      if (l == 0) {
        const float* ad1 = p.ada + (size_t)(136 + cond_row(tok)) * 6144;
        mod_store(p.hbf + (size_t)tok * 1024 + c0i, z, ad1 + 1024 + c0i, ad1 + c0i);
        mod_store(p.hbf + (size_t)tok * 1024 + c1i, z + 8, ad1 + 1024 + c1i, ad1 + c1i);
      }
    }
  }
}

#define XB_TMO      128
#define XB_XCNT(j)  (256  + 64 * (j))
#define XB_XSUB(j)  (1280 + 64 * (j))
#define XB_XGEN(j)  (2304 + 64 * (j))
#define XB_TOP      3328
#define XB_TOPGEN   3392
#define XCD_BAR_WORDS 3456
#define XB_SPIN_CAP (1u << 18)
#define LAS __attribute__((address_space(3)))
DI unsigned xb_ld(unsigned* p) { return __hip_atomic_load(p, __ATOMIC_RELAXED, __HIP_MEMORY_SCOPE_AGENT); }
DI unsigned xb_add(unsigned* p, unsigned v) { return __hip_atomic_fetch_add(p, v, __ATOMIC_RELAXED, __HIP_MEMORY_SCOPE_AGENT); }
DI unsigned xb_xcc_id() { return (unsigned)__builtin_amdgcn_s_getreg((3 << 11) | 20) & 0xFu; }
#define XB_SPIN(cond, bar) do { unsigned _sp = 0; while (cond) { __builtin_amdgcn_s_sleep(1); \
    if ((++_sp & 255u) == 0u) { if (xb_ld(&(bar)[XB_TMO])) break; if (_sp > XB_SPIN_CAP) { atomicAdd(&(bar)[XB_TMO], 1u); break; } } } } while (0)
struct XcdBarrier { unsigned* bar; unsigned x; volatile LAS unsigned* st; };
DI XcdBarrier xcd_barrier_post(unsigned* bar, volatile LAS unsigned* st) {
  XcdBarrier b; b.bar = bar; b.x = xb_xcc_id(); b.st = st;
  if (threadIdx.x == 0) (void)xb_add(&bar[XB_XCNT(b.x)], 1u);
  return b;
}
DI void xcd_barrier_complete(unsigned* bar, unsigned x, unsigned& nloc, unsigned& nx) {
  const unsigned G = gridDim.x * gridDim.y * gridDim.z;
  unsigned sum, cnt, mine, sp = 0u;
  for (;;) {
    sum = 0u; cnt = 0u; mine = 0u;
#pragma unroll
    for (unsigned j = 0; j < 16; ++j) { const unsigned c = xb_ld(&bar[XB_XCNT(j)]); sum += c; cnt += (c > 0u) ? 1u : 0u; mine = (j == x) ? c : mine; }
    if (sum == G) break;
    __builtin_amdgcn_s_sleep(1);
    if ((++sp & 255u) == 0u) { if (xb_ld(&bar[XB_TMO])) break; if (sp > XB_SPIN_CAP) { atomicAdd(&bar[XB_TMO], 1u); break; } }
  }
  nloc = mine > 0u ? mine : 1u; nx = cnt > 0u ? cnt : 1u;
}
DI void xcd_barrier(const XcdBarrier& b) {
  asm volatile("s_waitcnt vmcnt(0)" ::: "memory");
  __syncthreads();
  if (threadIdx.x == 0) {
    unsigned* bar = b.bar;
    __builtin_amdgcn_s_waitcnt(0);
    unsigned nloc = b.st[0], nx = b.st[1];
    if (nloc == 0u) { xcd_barrier_complete(bar, b.x, nloc, nx); b.st[0] = nloc; b.st[1] = nx; }
    const unsigned old = xb_add(&bar[XB_XSUB(b.x)], 1u);
    const unsigned gen = old / nloc;
    if (old + 1u == (gen + 1u) * nloc) {
      __builtin_amdgcn_fence(__ATOMIC_RELEASE, "agent");
      asm volatile("s_waitcnt vmcnt(0)" ::: "memory");
      const unsigned og = xb_add(&bar[XB_TOP], 1u);
      const unsigned tg = og / nx;
      if (og + 1u == (tg + 1u) * nx) xb_add(&bar[XB_TOPGEN], 1u);
      else XB_SPIN(xb_ld(&bar[XB_TOPGEN]) == tg, bar);
      __builtin_amdgcn_fence(__ATOMIC_ACQUIRE, "agent");
      xb_add(&bar[XB_XGEN(b.x)], 1u);
      asm volatile("s_waitcnt vmcnt(0)" ::: "memory");
    } else {
      XB_SPIN(xb_ld(&bar[XB_XGEN(b.x)]) == gen, bar);
      __builtin_amdgcn_fence(__ATOMIC_ACQUIRE, "agent");
      asm volatile("s_waitcnt vmcnt(0)" ::: "memory");
    }
  }
  __syncthreads();
}

__global__ void __launch_bounds__(256, 2) fwd_megakernel(Params p, int ph_lo, int ph_hi) {
  __shared__ __attribute__((aligned(16))) char smem[63488];
  __shared__ uint4 xb_words;
  cg::grid_group grid = cg::this_grid();
  if (threadIdx.x == 0) xb_words = make_uint4(0u, 0u, 0u, 0u);
  __syncthreads();
  const XcdBarrier xb = xcd_barrier_post(p.bar, (volatile LAS unsigned*)&xb_words);
  for (int ph = ph_lo; ph < ph_hi; ++ph) {
    if (ph == 0) phase0(p, smem);
    else if (ph == 1) phase1(p);
    else {
      const int l = (ph - 2) / 9, s = (ph - 2) % 9;
      switch (s) {
        case 0: phaseA(p, l, smem); break;
        case 1: phaseB1(p, l, smem); break;
        case 2: phaseB2(p, l); break;
        case 3: phaseB3(p, l, smem); break;
        case 4: phaseC(p, l, smem); break;
        case 5: phaseD(p, l); break;
        case 6: phaseE(p, l, smem); break;
        case 7: phaseF(p, l, smem); break;
        default: phaseG(p, l, smem); break;
      }
    }
    if (ph + 1 < ph_hi) { if (ph_lo < 0) grid.sync(); xcd_barrier(xb); }
  }
}

#ifndef MULTI_LAUNCH
#define MULTI_LAUNCH 0
#endif

extern "C" void kernel_launch(void* const* d_in, const int* in_sizes, int n_in, void* d_out, int out_size, void* d_ws,
                              size_t ws_size, hipStream_t stream) {
  static int grid_blocks = 0;
  if (!grid_blocks) {
    int dev = 0, cus = 0, per_cu = 0;
    hipGetDevice(&dev);
    hipDeviceGetAttribute(&cus, hipDeviceAttributeMultiprocessorCount, dev);
    hipOccupancyMaxActiveBlocksPerMultiprocessor(&per_cu, fwd_megakernel, 256, 0);
    if (per_cu > 2) per_cu = 2;
    if (per_cu < 1) per_cu = 1;
    grid_blocks = cus * per_cu;
  }
  Params p{};
  const float* const* in = (const float* const*)d_in;
  p.x_prompt = in[0]; p.x_sample = in[1]; p.stC = in[2]; p.stN = in[3]; p.stM = in[4]; p.stPool = in[5];
  p.c_prompt = in[6]; p.c_sample = in[7]; p.w_ada = in[8]; p.b_ada = in[9]; p.w_in = in[10]; p.b_gate = in[11];
  p.mh_g = in[12]; p.sgu_g = in[13]; p.sgu_b = in[14]; p.w_s = in[15]; p.b_s = in[16]; p.w_pool = in[17];
  p.pool_scale = in[18]; p.w_o = in[19]; p.ln1_g = in[20]; p.ln1_b = in[21]; p.w_pq = in[22]; p.peer_keys = in[23];
  p.peer_u = in[24]; p.peer_v = in[25]; p.ln2_g = in[26]; p.ln2_b = in[27];
  p.out = (float*)d_out;
  char* ws = (char*)d_ws; size_t off = 0;
  auto take = [&](size_t bytes) { char* r = ws + off; off += (bytes + 255) & ~(size_t)255; return r; };
  p.ada = (float*)take((size_t)2 * 136 * 6144 * 4);
  p.WinT = (bf16_t*)take((size_t)2 * NIN * 1024 * 2);
  p.WoT = (bf16_t*)take((size_t)2 * 1024 * 1024 * 2);
  p.WpqT = (bf16_t*)take((size_t)2 * 2048 * 1024 * 2);
  p.keysb = (bf16_t*)take((size_t)524288 * 2);
  p.Uq = (unsigned char*)take((size_t)2 * 16384 * 1024);
  p.Vq = (unsigned char*)take((size_t)2 * 16384 * 1024);
  p.xq = (unsigned char*)take((size_t)NT * 1024);
  p.uscale = (float*)take((size_t)2 * 16384 * 4);
  p.vscale = (float*)take((size_t)2 * 16384 * 4);
  p.xscale = (float*)take((size_t)NT * 4);
  p.hbf = (bf16_t*)take((size_t)NT * 1024 * 2);
  p.qkvo = (bf16_t*)take((size_t)NT * 2048 * 2);
  p.KT = (bf16_t*)take((size_t)32 * 128 * 2048 * 2);
  p.VT = (bf16_t*)take((size_t)32 * 128 * 2048 * 2);
  p.F = (float*)take((size_t)NT * FS * 4);
  p.CH = (float*)take((size_t)1024 * CHS * 4);
  p.scal = (float*)take((size_t)2048 * 4);
  p.mstart = (float*)take((size_t)1024 * 4);
  p.XZ = (float*)take((size_t)NT * 1024 * 4);
  p.pgate = (float*)take((size_t)NT * 128 * 4);
  p.pidx = (int*)take((size_t)NT * 128 * 4);
  p.bar = (unsigned*)take((size_t)XCD_BAR_WORDS * 4);
  if (off > ws_size) fprintf(stderr, "workspace too small: need %zu have %zu\n", off, ws_size);
  (void)hipMemsetAsync(p.bar, 0, (size_t)XCD_BAR_WORDS * 4, stream);
#if MULTI_LAUNCH
  for (int ph = 0; ph < 20; ++ph) hipLaunchKernelGGL(fwd_megakernel, dim3(grid_blocks), dim3(256), 0, stream, p, ph, ph + 1);
#else
  int lo = 0, hi = 20;
  void* args[] = {&p, &lo, &hi};
  hipError_t e = hipLaunchCooperativeKernel((void*)fwd_megakernel, dim3(grid_blocks), dim3(256), args, 0, stream);
  if (e != hipSuccess) fprintf(stderr, "cooperative launch failed: %s (grid %d)\n", hipGetErrorString(e), grid_blocks);
#endif
}
```

```cpp
#include <hip/hip_runtime.h>
#include <hip/hip_cooperative_groups.h>
#include <cstdio>
#include <cstdint>
namespace cg = cooperative_groups;

typedef unsigned short bf16_t;
typedef __attribute__((ext_vector_type(8))) short bf16x8;
typedef __attribute__((ext_vector_type(16))) float f32x16;
typedef __attribute__((ext_vector_type(2))) __bf16 bf2_t;
typedef __attribute__((ext_vector_type(2))) float f32x2;
#define DI __device__ __forceinline__
#define MFMA32(a, b, c) __builtin_amdgcn_mfma_f32_32x32x16_bf16((a), (b), (c), 0, 0, 0)

constexpr int NP = 16384, NS = 512, NT = 16896;
constexpr int NIN = 2944;
constexpr int FS = 776;
constexpr float ALPHA = 1.4142135623730951f;
constexpr float LN_EPS = 1e-5f;
constexpr int CHS = 129 * 128;

struct Params {
  const float *x_prompt, *x_sample, *stC, *stN, *stM, *stPool, *c_prompt, *c_sample;
  const float *w_ada, *b_ada, *w_in, *b_gate, *mh_g, *sgu_g, *sgu_b, *w_s, *b_s, *w_pool, *pool_scale, *w_o,
      *ln1_g, *ln1_b, *w_pq, *peer_keys, *peer_u, *peer_v, *ln2_g, *ln2_b;
  float* out;
  float* ada;
  bf16_t *WinT, *WoT, *WpqT, *keysb, *hbf, *qkvo, *KT, *VT;
  unsigned char *Uq, *Vq, *xq;
  float *uscale, *vscale, *xscale;
  float *F, *CH, *scal, *mstart, *XZ, *pgate;
  int* pidx;
  unsigned* bar;
};

constexpr size_t O_YP = 0;
constexpr size_t O_YS = 16777216;
constexpr size_t O_CP = O_YS + 524288;
constexpr size_t O_NP = O_CP + 1048576;
constexpr size_t O_MP = O_NP + 8192;
constexpr size_t O_PP = O_MP + 64;
constexpr size_t O_CS = O_PP + 61440;
constexpr size_t O_NS = O_CS + 16777216;
constexpr size_t O_MS = O_NS + 131072;
constexpr size_t O_PS = O_MS + 1024;
constexpr size_t O_SV = O_PS + 983040;

DI int tidx() { int t = threadIdx.x; asm volatile("" : "+v"(t)); return t; }
DI int bidx() { int b = blockIdx.x; asm volatile("" : "+s"(b)); return b; }
DI unsigned f2bf(float x) { unsigned u = __float_as_uint(x); u += 0x7fffu + ((u >> 16) & 1u); return u >> 16; }
DI unsigned pack2(float a, float b) { return f2bf(a) | (f2bf(b) << 16); }
DI float bflo(unsigned u) { return __uint_as_float(u << 16); }
DI float bfhi(unsigned u) { return __uint_as_float(u & 0xffff0000u); }
DI float bf2f(bf16_t h) { return __uint_as_float(((unsigned)h) << 16); }
DI uint4 pack8(const float* v) { return make_uint4(pack2(v[0], v[1]), pack2(v[2], v[3]), pack2(v[4], v[5]), pack2(v[6], v[7])); }
DI void unpack8(uint4 u, float* v) {
  v[0] = bflo(u.x); v[1] = bfhi(u.x); v[2] = bflo(u.y); v[3] = bfhi(u.y);
  v[4] = bflo(u.z); v[5] = bfhi(u.z); v[6] = bflo(u.w); v[7] = bfhi(u.w);
}
DI int crow(int reg, int h) { return (reg & 3) + 8 * (reg >> 2) + 4 * h; }
DI int cond_row(int tok) { return tok < NP ? (tok >> 11) : 8 + ((tok - NP) >> 2); }
DI int dpp_xor1(int x) { return __builtin_amdgcn_update_dpp(0, x, 0xB1, 0xF, 0xF, true); }
DI int dpp_xor2(int x) { return __builtin_amdgcn_update_dpp(0, x, 0x4E, 0xF, 0xF, true); }
DI int dpp_xor4(int x) { return __builtin_amdgcn_update_dpp(0, __builtin_amdgcn_update_dpp(0, x, 0x141, 0xF, 0xF, true), 0x1B, 0xF, 0xF, true); }
DI int dpp_xor8(int x) { return __builtin_amdgcn_update_dpp(0, x, 0x128, 0xF, 0xF, true); }
DI float dpp_xor8f(float x) { return __builtin_bit_cast(float, dpp_xor8(__builtin_bit_cast(int, x))); }
DI float wsum(float v) { for (int o = 32; o > 0; o >>= 1) v += __shfl_xor(v, o); return v; }
DI float wmax(float v) { for (int o = 32; o > 0; o >>= 1) v = fmaxf(v, __shfl_xor(v, o)); return v; }
DI float sigmoidf_(float x) { return 1.f / (1.f + __expf(-x)); }
DI float logsigmoidf_(float x) { return fminf(x, 0.f) - log1pf(__expf(-fabsf(x))); }
DI float dot2bf(unsigned a, unsigned b, float c) {
  return __builtin_amdgcn_fdot2_f32_bf16(__builtin_bit_cast(bf2_t, a), __builtin_bit_cast(bf2_t, b), c, false);
}
DI bf16x8 ld8(const bf16_t* p) { return __builtin_bit_cast(bf16x8, *(const uint4*)p); }
DI void ld8f(const float* p, float* v) {
  float4 a = ((const float4*)p)[0], b = ((const float4*)p)[1];
  v[0] = a.x; v[1] = a.y; v[2] = a.z; v[3] = a.w; v[4] = b.x; v[5] = b.y; v[6] = b.z; v[7] = b.w;
}
DI void st8f(float* p, const float* v) {
  ((float4*)p)[0] = make_float4(v[0], v[1], v[2], v[3]); ((float4*)p)[1] = make_float4(v[4], v[5], v[6], v[7]);
}

template <class Epi>
DI void gemm128(const bf16_t* __restrict__ A, const bf16_t* __restrict__ Bt, int m0, int n0, char* smem, const Epi& epi) {
  const int tid = tidx(), lane = tid & 63, w = tid >> 6, wm = w >> 1, wn = w & 1, r = lane & 31, h = lane >> 5;
  bf16_t* As = (bf16_t*)smem;
  bf16_t* Bs = As + 128 * 72;
  f32x16 acc[2][2];
#pragma unroll
  for (int i = 0; i < 2; ++i)
#pragma unroll
    for (int j = 0; j < 2; ++j)
#pragma unroll
      for (int e = 0; e < 16; ++e) acc[i][j][e] = 0.f;
  typedef __attribute__((ext_vector_type(4))) unsigned u32x4;
  u32x4 ra0, ra1, ra2, ra3, rb0, rb1, rb2, rb3;
  u32x4 sa0, sa1, sa2, sa3, sb0, sb1, sb2, sb3;
  const int prow = tid >> 3, pc = (tid & 7) * 8;
  const bf16_t* ap = A + (size_t)(m0 + prow) * 1024 + pc;
  const bf16_t* bp = Bt + (size_t)(n0 + prow) * 1024 + pc;
#define GLD(P, k0_)                                                                                          \
  P##a0 = *(const u32x4*)(ap + (k0_)); P##a1 = *(const u32x4*)(ap + 32 * 1024 + (k0_));                      \
  P##a2 = *(const u32x4*)(ap + 64 * 1024 + (k0_)); P##a3 = *(const u32x4*)(ap + 96 * 1024 + (k0_));         \
  P##b0 = *(const u32x4*)(bp + (k0_)); P##b1 = *(const u32x4*)(bp + 32 * 1024 + (k0_));                      \
  P##b2 = *(const u32x4*)(bp + 64 * 1024 + (k0_)); P##b3 = *(const u32x4*)(bp + 96 * 1024 + (k0_));
#define LST(P)                                                                                               \
  *(u32x4*)(As + (prow) * 72 + pc) = P##a0; *(u32x4*)(As + (prow + 32) * 72 + pc) = P##a1;                   \
  *(u32x4*)(As + (prow + 64) * 72 + pc) = P##a2; *(u32x4*)(As + (prow + 96) * 72 + pc) = P##a3;              \
  *(u32x4*)(Bs + (prow) * 72 + pc) = P##b0; *(u32x4*)(Bs + (prow + 32) * 72 + pc) = P##b1;                   \
  *(u32x4*)(Bs + (prow + 64) * 72 + pc) = P##b2; *(u32x4*)(Bs + (prow + 96) * 72 + pc) = P##b3;
  GLD(r, 0)
  __builtin_amdgcn_sched_barrier(0);
  GLD(s, 64)
  __builtin_amdgcn_sched_barrier(0);
#define GEMM_COMPUTE()                                                                                       \
  _Pragma("unroll") for (int ks = 0; ks < 4; ++ks) {                                                         \
    bf16x8 a[2], b[2];                                                                                       \
    _Pragma("unroll") for (int i = 0; i < 2; ++i) a[i] = ld8(As + (wm * 64 + i * 32 + r) * 72 + ks * 16 + h * 8); \
    _Pragma("unroll") for (int j = 0; j < 2; ++j) b[j] = ld8(Bs + (wn * 64 + j * 32 + r) * 72 + ks * 16 + h * 8); \
    _Pragma("unroll") for (int i = 0; i < 2; ++i)                                                            \
      _Pragma("unroll") for (int j = 0; j < 2; ++j) acc[i][j] = MFMA32(a[i], b[j], acc[i][j]);               \
  }
#pragma unroll 1
  for (int kt = 0; kt < 16; kt += 2) {
    __syncthreads();
    LST(r)
    __syncthreads();
    { const int k0 = (kt + 2 < 16 ? kt + 2 : 14) * 64; GLD(r, k0) }
    GEMM_COMPUTE()
    __syncthreads();
    LST(s)
    __syncthreads();
    { const int k0 = (kt + 3 < 16 ? kt + 3 : 15) * 64; GLD(s, k0) }
    GEMM_COMPUTE()
  }
#pragma unroll
  for (int i = 0; i < 2; ++i)
#pragma unroll
    for (int j = 0; j < 2; ++j)
#pragma unroll
      for (int g = 0; g < 4; ++g)
        epi(m0 + wm * 64 + i * 32 + 8 * g + 4 * h, n0 + wn * 64 + j * 32 + r, acc[i][j][4 * g], acc[i][j][4 * g + 1],
            acc[i][j][4 * g + 2], acc[i][j][4 * g + 3]);
}

DI void phase0(const Params& p, char* smem) {
  const int tid = tidx(), G = gridDim.x;
  auto do_ada = [&]() __attribute__((always_inline)) {
    float* S = (float*)smem;
    const int lane = tid & 63, w = tid >> 6;
    for (int it0 = bidx(); it0 < 2 * 24 * 9; it0 += G) {
      int it = it0;
      if ((G & 7) == 0 && G >= 512) {
        const int x = it0 & 7, slot = it0 >> 3;
        if (slot >= 54) continue;
        it = ((slot / 9) * 8 + x) * 9 + slot % 9;
      }
      const int l = it / 216, rem = it % 216, cb = rem / 9, rg = rem % 9;
      float acc[64];
#pragma unroll
      for (int i = 0; i < 64; ++i) acc[i] = 0.f;
      for (int half = 0; half < 2; ++half) {
#pragma unroll
        for (int q = 0; q < 16; ++q) {
          const int row = rg * 16 + q, rowc = row < 136 ? row : 135;
          const float* cp = (rowc < 8 ? p.c_prompt + rowc * 1024 : p.c_sample + (rowc - 8) * 1024) + half * 512;
          const float m = row < 136 ? 1.f : 0.f;
#pragma unroll
          for (int j = 0; j < 2; ++j) { const float c = cp[tid + 256 * j]; S[(tid + 256 * j) * 16 + q] = m * c / (1.f + __expf(-c)); }
        }
        __syncthreads();
        const float* wp = p.w_ada + ((size_t)l * 1024 + half * 512 + w * 128) * 6144 + cb * 256 + lane * 4;
        const float* sp = S + w * 128 * 16;
#pragma unroll 8
        for (int kk = 0; kk < 128; ++kk) {
          const float4 wv = *(const float4*)(wp + (size_t)kk * 6144);
#pragma unroll
          for (int q4 = 0; q4 < 4; ++q4) {
            const float4 s4 = *(const float4*)(sp + kk * 16 + q4 * 4);
            acc[(q4 * 4 + 0) * 4 + 0] += s4.x * wv.x; acc[(q4 * 4 + 0) * 4 + 1] += s4.x * wv.y; acc[(q4 * 4 + 0) * 4 + 2] += s4.x * wv.z; acc[(q4 * 4 + 0) * 4 + 3] += s4.x * wv.w;
            acc[(q4 * 4 + 1) * 4 + 0] += s4.y * wv.x; acc[(q4 * 4 + 1) * 4 + 1] += s4.y * wv.y; acc[(q4 * 4 + 1) * 4 + 2] += s4.y * wv.z; acc[(q4 * 4 + 1) * 4 + 3] += s4.y * wv.w;
            acc[(q4 * 4 + 2) * 4 + 0] += s4.z * wv.x; acc[(q4 * 4 + 2) * 4 + 1] += s4.z * wv.y; acc[(q4 * 4 + 2) * 4 + 2] += s4.z * wv.z; acc[(q4 * 4 + 2) * 4 + 3] += s4.z * wv.w;
            acc[(q4 * 4 + 3) * 4 + 0] += s4.w * wv.x; acc[(q4 * 4 + 3) * 4 + 1] += s4.w * wv.y; acc[(q4 * 4 + 3) * 4 + 2] += s4.w * wv.z; acc[(q4 * 4 + 3) * 4 + 3] += s4.w * wv.w;
          }
        }
        __syncthreads();
      }
      const float4 bb = *(const float4*)(p.b_ada + l * 6144 + cb * 256 + lane * 4);
#pragma unroll
      for (int pass = 0; pass < 2; ++pass) {
#pragma unroll
        for (int j = 0; j < 32; ++j) S[(w * 32 + j) * 64 + lane] = acc[pass * 32 + j];
        __syncthreads();
#pragma unroll
        for (int rr = 0; rr < 2; ++rr) {
          const int r = 2 * w + rr, row = rg * 16 + pass * 8 + r;
          float o[4];
#pragma unroll
          for (int c = 0; c < 4; ++c) o[c] = S[(0 * 32 + r * 4 + c) * 64 + lane] + S[(1 * 32 + r * 4 + c) * 64 + lane] + S[(2 * 32 + r * 4 + c) * 64 + lane] + S[(3 * 32 + r * 4 + c) * 64 + lane];
          if (row < 136) *(float4*)(p.ada + ((size_t)l * 136 + row) * 6144 + cb * 256 + lane * 4) = make_float4(o[0] + bb.x, o[1] + bb.y, o[2] + bb.z, o[3] + bb.w);
        }
        __syncthreads();
      }
    }
  };
  auto do_transposes = [&]() __attribute__((always_inline)) {
    float* T = (float*)smem;
    for (int it = bidx(); it < 3008; it += G) {
      const int l = it / 1504; int j = it % 1504;
      const float* src; bf16_t* dst; int ldsrc, kind;
      if (j < 736) { kind = 0; src = p.w_in + (size_t)l * 1024 * 2824; ldsrc = 2824; dst = p.WinT + (size_t)l * NIN * 1024; }
      else if (j < 992) { j -= 736; kind = 1; src = p.w_o + (size_t)l * 1024 * 1024; ldsrc = 1024; dst = p.WoT + (size_t)l * 1024 * 1024; }
      else { j -= 992; kind = 2; src = p.w_pq + (size_t)l * 1024 * 2048; ldsrc = 2048; dst = p.WpqT + (size_t)l * 2048 * 1024; }
      const int nt = j >> 4, kt = j & 15;
      const int tn = tid & 63, tk0 = tid >> 6;
      const int n = nt * 64 + tn;
      int e = n;
      if (kind == 0) e = n < 2048 ? n : (n < 2816 ? n + 8 : (n < 2824 ? 2048 + (n - 2816) : -1));
#pragma unroll
      for (int i = 0; i < 16; ++i) { const int k = tk0 + 4 * i; T[k * 65 + tn] = e >= 0 ? src[(size_t)(kt * 64 + k) * ldsrc + e] : 0.f; }
      __syncthreads();
      const int nn = tid >> 2, kq = (tid & 3) * 16;
      unsigned pk[8];
#pragma unroll
      for (int q = 0; q < 8; ++q) pk[q] = pack2(T[(kq + 2 * q) * 65 + nn], T[(kq + 2 * q + 1) * 65 + nn]);
      uint4* d4 = (uint4*)(dst + (size_t)(nt * 64 + nn) * 1024 + kt * 64 + kq);
      d4[0] = make_uint4(pk[0], pk[1], pk[2], pk[3]);
      d4[1] = make_uint4(pk[4], pk[5], pk[6], pk[7]);
      __syncthreads();
    }
  };
  auto do_quant = [&]() __attribute__((always_inline)) {
    const size_t nk8 = 524288 / 8;
    for (size_t i = (size_t)bidx() * 256 + tid; i < nk8; i += (size_t)G * 256) {
      const float* s = p.peer_keys + i * 8;
      const float4 a = ((const float4*)s)[0], b = ((const float4*)s)[1];
      *(uint4*)(p.keysb + i * 8) = make_uint4(pack2(a.x, a.y), pack2(a.z, a.w), pack2(b.x, b.y), pack2(b.z, b.w));
    }
    const int lane = tid & 63, w = tid >> 6;
    for (int row0 = (bidx() * 4 + w) * 2; row0 < 65536; row0 += G * 8) {
      float v[2][16];
#pragma unroll
      for (int r = 0; r < 2; ++r) {
        const int row = row0 + r; const int tab = row >> 15, le = row & 32767;
        const float* src = (tab ? p.peer_v : p.peer_u) + (size_t)le * 1024 + lane * 16;
        ld8f(src, v[r]); ld8f(src + 8, v[r] + 8);
      }
#pragma unroll
      for (int r = 0; r < 2; ++r) {
        const int row = row0 + r; const int tab = row >> 15, le = row & 32767, l = le >> 14, e = le & 16383;
        float m = 0.f;
#pragma unroll
        for (int j = 0; j < 16; ++j) m = fmaxf(m, fabsf(v[r][j]));
        m = wmax(m);
        unsigned wd[4];
        if (tab == 0) {
          const float inv = m > 0.f ? 127.f / m : 0.f;
#pragma unroll
          for (int q = 0; q < 4; ++q) {
            const int q0 = (int)rintf(v[r][4 * q] * inv), q1 = (int)rintf(v[r][4 * q + 1] * inv), q2 = (int)rintf(v[r][4 * q + 2] * inv), q3 = (int)rintf(v[r][4 * q + 3] * inv);
            wd[q] = (unsigned)(q0 & 255) | ((unsigned)(q1 & 255) << 8) | ((unsigned)(q2 & 255) << 16) | ((unsigned)(q3 & 255) << 24);
          }
          if (lane == 0) p.uscale[le] = m * (1.f / 127.f);
        } else {
          const float inv = m > 0.f ? 400.f / m : 0.f;
#pragma unroll
          for (int q = 0; q < 4; ++q) {
            int pk = __builtin_amdgcn_cvt_pk_fp8_f32(v[r][4 * q] * inv, v[r][4 * q + 1] * inv, 0, false);
            pk = __builtin_amdgcn_cvt_pk_fp8_f32(v[r][4 * q + 2] * inv, v[r][4 * q + 3] * inv, pk, true);
            wd[q] = (unsigned)pk;
          }
          if (lane == 0) p.vscale[le] = m * (1.f / 400.f);
        }
        unsigned char* dst = (tab ? p.Vq : p.Uq) + (((size_t)(l * 8 + (lane >> 3)) * 16384 + e) << 7) + (lane & 7) * 16;
        *(uint4*)dst = make_uint4(wd[0], wd[1], wd[2], wd[3]);
      }
    }
  };
  if ((bidx() / (gridDim.x >> 1)) & 1) { do_quant(); do_transposes(); do_ada(); }
  else { do_ada(); do_transposes(); do_quant(); }
}

DI void mod_store(bf16_t* dst, const float* x, const float* sc, const float* sh) {
  float s[8], t[8], o[8];
  ld8f(sc, s); ld8f(sh, t);
#pragma unroll
  for (int j = 0; j < 8; ++j) o[j] = x[j] * (1.f + s[j]) + t[j];
  *(uint4*)dst = pack8(o);
}

DI void phase1(const Params& p) {
  const int tid = tidx(), lane = tid & 63, w = tid >> 6;
  for (int tok = bidx() * 4 + w; tok < NT; tok += gridDim.x * 4) {
    const float* xr = tok < NP ? p.x_prompt + (size_t)tok * 1024 : p.x_sample + (size_t)(tok - NP) * 1024;
    const float* ad = p.ada + (size_t)cond_row(tok) * 6144;
#pragma unroll
    for (int hf = 0; hf < 2; ++hf) {
      const int c = hf * 512 + lane * 8;
      float x[8]; ld8f(xr + c, x);
      mod_store(p.hbf + (size_t)tok * 1024 + c, x, ad + 1024 + c, ad + c);
    }
  }
}

DI void tile_decode(int u, int NTL, int MTL, int& mt, int& nt) {
  const int per_mg = 8 * NTL;
  const int mg = u / per_mg; int v = u - mg * per_mg;
  const int rm = min(8, MTL - 8 * mg);
  int ng = 0;
  for (;;) { const int cn = min(8, NTL - 8 * ng); const int sz = rm * cn; if (v < sz) { mt = 8 * mg + v / cn; nt = 8 * ng + v % cn; return; } v -= sz; ++ng; }
}
template <class Epi>
DI void gemm_micro32(const bf16_t* __restrict__ A, const bf16_t* __restrict__ Bt, int m0, int n0, char* smem, const Epi& epi) {
  const int tid = tidx(), lane = tid & 63, w = tid >> 6, r = lane & 31, h = lane >> 5;
  float* red = (float*)smem;
  f32x16 acc;
#pragma unroll
  for (int e = 0; e < 16; ++e) acc[e] = 0.f;
  const bf16_t* ap = A + (size_t)(m0 + r) * 1024 + w * 256 + h * 8;
  const bf16_t* bp = Bt + (size_t)(n0 + r) * 1024 + w * 256 + h * 8;
#pragma unroll
  for (int ks = 0; ks < 16; ++ks) { const bf16x8 a = ld8(ap + ks * 16); const bf16x8 b = ld8(bp + ks * 16); acc = MFMA32(a, b, acc); }
  __syncthreads();
#pragma unroll
  for (int e = 0; e < 16; ++e) red[(w * 16 + e) * 64 + lane] = acc[e];
  __syncthreads();
  if (w == 0) {
#pragma unroll
    for (int e = 0; e < 16; ++e) acc[e] = red[e * 64 + lane] + red[(16 + e) * 64 + lane] + red[(32 + e) * 64 + lane] + red[(48 + e) * 64 + lane];
#pragma unroll
    for (int g = 0; g < 4; ++g) epi(m0 + 8 * g + 4 * h, n0 + r, acc[4 * g], acc[4 * g + 1], acc[4 * g + 2], acc[4 * g + 3]);
  }
}

template <class Epi>
DI void gemm_phase(const bf16_t* A, const bf16_t* Bt, int NTL, char* smem, const Epi& epi, bool micro_sample) {
  const int MTL = micro_sample ? 128 : 132;
  const int T = MTL * NTL, G = gridDim.x, bx = bidx();
  if ((G & 7) == 0) {
    const int x = bx & 7, slot = bx >> 3, per = G >> 3;
    const int lo = (int)(((long long)T * x) >> 3), hi = (int)(((long long)T * (x + 1)) >> 3);
    for (int u = lo + slot; u < hi; u += per) { int mt, nt; tile_decode(u, NTL, MTL, mt, nt); gemm128(A, Bt, mt * 128, nt * 128, smem, epi); }
  } else {
    for (int t = bx; t < T; t += G) { const int mt = t / NTL, nt = t % NTL; gemm128(A, Bt, mt * 128, nt * 128, smem, epi); }
  }
  if (micro_sample) {
    const int NB = NTL * 4;
    for (int t = bx; t < 16 * NB; t += G) { const int mb = t & 15, nb = t >> 4; gemm_micro32(A, Bt, NP + mb * 32, nb * 32, smem, epi); }
  }
}

struct EpiA {
  const Params& p; const float* bg;
  DI void operator()(int row4, int col, float v0, float v1, float v2, float v3) const {
    if (col < 2048) {
      const float s = col < 512 ? 0.08838834764831845f : 1.f;
      bf16_t* q = p.qkvo + (size_t)row4 * 2048 + col;
      if (!(col >= 1024 && col < 1536 && row4 < NP)) {
        q[0] = (bf16_t)f2bf(v0 * s); q[2048] = (bf16_t)f2bf(v1 * s); q[4096] = (bf16_t)f2bf(v2 * s); q[6144] = (bf16_t)f2bf(v3 * s);
      }
      if (col >= 512 && col < 1536 && row4 < NP) {
        int cc = col - 512; bf16_t* T = cc < 512 ? p.KT : p.VT; cc &= 511;
        const int hh = cc >> 7, d = cc & 127, b = row4 >> 11, t = row4 & 2047;
        *(uint2*)(T + ((size_t)((b * 4 + hh) * 128 + d)) * 2048 + t) = make_uint2(pack2(v0, v1), pack2(v2, v3));
      }
    } else if (col < 2816) {
      float* f = p.F + (size_t)row4 * FS + (col - 2048);
      f[0] = v0; f[FS] = v1; f[2 * FS] = v2; f[3 * FS] = v3;
    } else if (col < 2824) {
      const int g = col - 2816; const float bb = bg[g];
      float* f = p.F + (size_t)row4 * FS + 768 + g;
      f[0] = v0 + bb; f[FS] = v1 + bb; f[2 * FS] = v2 + bb; f[3 * FS] = v3 + bb;
    }
  }
};
DI void phaseA(const Params& p, int l, char* smem) {
  const bf16_t* Bt = p.WinT + (size_t)l * NIN * 1024;
  EpiA epi{p, p.b_gate + l * 8};
  gemm_phase(p.hbf, Bt, 23, smem, epi, false);
}

struct EpiC {
  const Params& p; const float* adaL; int l;
  DI void operator()(int row4, int col, float v0, float v1, float v2, float v3) const {
    const float* xr = (l == 0) ? (row4 < NP ? p.x_prompt + (size_t)row4 * 1024 : p.x_sample + (size_t)(row4 - NP) * 1024)
                               : p.XZ + (size_t)row4 * 1024;
    const float g1 = adaL[(size_t)cond_row(row4) * 6144 + 2048 + col];
    const float x0 = xr[col], x1 = xr[1024 + col], x2 = xr[2048 + col], x3 = xr[3072 + col];
    float* z = p.XZ + (size_t)row4 * 1024 + col;
    z[0] = ALPHA * x0 + g1 * v0; z[1024] = ALPHA * x1 + g1 * v1; z[2048] = ALPHA * x2 + g1 * v2; z[3072] = ALPHA * x3 + g1 * v3;
  }
};
DI void phaseC(const Params& p, int l, char* smem) {
  const bf16_t* Bt = p.WoT + (size_t)l * 1024 * 1024;
  EpiC epi{p, p.ada + (size_t)l * 136 * 6144, l};
  gemm_phase(p.hbf, Bt, 8, smem, epi, true);
}

struct EpiE {
  const Params& p;
  DI void operator()(int row4, int col, float v0, float v1, float v2, float v3) const {
    bf16_t* q = p.qkvo + (size_t)row4 * 2048 + col;
    q[0] = (bf16_t)f2bf(v0); q[2048] = (bf16_t)f2bf(v1); q[4096] = (bf16_t)f2bf(v2); q[6144] = (bf16_t)f2bf(v3);
  }
};
DI void phaseE(const Params& p, int l, char* smem) {
  const bf16_t* Bt = p.WpqT + (size_t)l * 2048 * 1024;
  EpiE epi{p};
  gemm_phase(p.hbf, Bt, 16, smem, epi, true);
}

DI void phaseD(const Params& p, int l) {
  const int tid = tidx(), lane = tid & 63, w = tid >> 6;
  const float* adaL = p.ada + (size_t)l * 136 * 6144;
  const float* g = p.ln1_g + l * 1024; const float* bta = p.ln1_b + l * 1024;
  for (int tok = bidx() * 4 + w; tok < NT; tok += gridDim.x * 4) {
    float* zr = p.XZ + (size_t)tok * 1024;
    const int c0 = lane * 8, c1 = 512 + lane * 8;
    float z[16]; ld8f(zr + c0, z); ld8f(zr + c1, z + 8);
    float s = 0.f;
#pragma unroll
    for (int j = 0; j < 16; ++j) s += z[j];
    const float mu = wsum(s) * (1.f / 1024.f);
    float q = 0.f;
#pragma unroll
    for (int j = 0; j < 16; ++j) { const float d = z[j] - mu; q += d * d; }
    const float rstd = rsqrtf(wsum(q) * (1.f / 1024.f) + LN_EPS);
    float gg[16], bb[16];
    ld8f(g + c0, gg); ld8f(g + c1, gg + 8); ld8f(bta + c0, bb); ld8f(bta + c1, bb + 8);
#pragma unroll
    for (int j = 0; j < 16; ++j) z[j] = (z[j] - mu) * rstd * gg[j] + bb[j];
    st8f(zr + c0, z); st8f(zr + c1, z + 8);
    const float* ad = adaL + (size_t)cond_row(tok) * 6144;
    float sc[16], sh[16], hv[16];
    ld8f(ad + 4096 + c0, sc); ld8f(ad + 4096 + c1, sc + 8); ld8f(ad + 3072 + c0, sh); ld8f(ad + 3072 + c1, sh + 8);
    float hm = 0.f;
#pragma unroll
    for (int j = 0; j < 16; ++j) { hv[j] = z[j] * (1.f + sc[j]) + sh[j]; hm = fmaxf(hm, fabsf(hv[j])); }
    *(uint4*)(p.hbf + (size_t)tok * 1024 + c0) = pack8(hv);
    *(uint4*)(p.hbf + (size_t)tok * 1024 + c1) = pack8(hv + 8);
    hm = wmax(hm);
    const float hinv = hm > 0.f ? 127.f / hm : 0.f;
    unsigned qw[4];
#pragma unroll
    for (int q = 0; q < 4; ++q) {
      const int q0 = (int)rintf(hv[4 * q] * hinv), q1 = (int)rintf(hv[4 * q + 1] * hinv), q2 = (int)rintf(hv[4 * q + 2] * hinv), q3 = (int)rintf(hv[4 * q + 3] * hinv);
      qw[q] = (unsigned)(q0 & 255) | ((unsigned)(q1 & 255) << 8) | ((unsigned)(q2 & 255) << 16) | ((unsigned)(q3 & 255) << 24);
    }
    *(uint2*)(p.xq + (size_t)tok * 1024 + c0) = make_uint2(qw[0], qw[1]);
    *(uint2*)(p.xq + (size_t)tok * 1024 + c1) = make_uint2(qw[2], qw[3]);
    if (lane == 0) p.xscale[tok] = hm * (1.f / 127.f);
  }
}

DI void mlstm_i(const Params& p, int l, int item, char* smem) {
  const int tid = tidx(), lane = tid & 63, w = tid >> 6, r = lane & 31, h = lane >> 5;
  const int bh = item >> 5, c = item & 31, b = bh >> 2, hh = bh & 3;
  const int tok0 = b * 2048 + c * 64;
  float* wc = (float*)smem;
  bf16_t* Vs = (bf16_t*)(smem + 256);
  bf16_t* Ks = Vs + 128 * 72;
  {
#pragma unroll
    for (int i = 0; i < 4; ++i) {
      const int pc = tid + 256 * i, row = pc >> 3, cc = (pc & 7) * 8;
      *(uint4*)(Vs + row * 72 + cc) = *(const uint4*)(p.VT + ((size_t)(bh * 128 + row)) * 2048 + c * 64 + cc);
      *(uint4*)(Ks + row * 72 + cc) = *(const uint4*)(p.KT + ((size_t)(bh * 128 + row)) * 2048 + c * 64 + cc);
    }
  }
  if (w == 0) {
    const float* f = p.F + (size_t)(tok0 + lane) * FS + 768;
    const float gi = f[hh], gf = f[4 + hh];
    float x = logsigmoidf_(gf);
#pragma unroll
    for (int o = 1; o < 64; o <<= 1) { const float t = __shfl_up(x, o); if (lane >= o) x += t; }
    const float bend = __shfl(x, 63);
    const float dend = bend - x + gi;
    const float mloc = wmax(dend);
    wc[lane] = __expf(dend - mloc);
    if (lane == 0) { p.scal[(bh * 32 + c) * 2] = bend; p.scal[(bh * 32 + c) * 2 + 1] = mloc; }
  }
  __syncthreads();
  const int vi = w >> 1, ki = w & 1;
  f32x16 acc[2][2];
#pragma unroll
  for (int i = 0; i < 2; ++i)
#pragma unroll
    for (int j = 0; j < 2; ++j)
#pragma unroll
      for (int e = 0; e < 16; ++e) acc[i][j][e] = 0.f;
  const bf16_t* vt = Vs + (vi * 64 + r) * 72 + h * 8;
  const bf16_t* kt = Ks + (ki * 64 + r) * 72 + h * 8;
#pragma unroll
  for (int ks = 0; ks < 4; ++ks) {
    float wv[8];
#pragma unroll
    for (int j = 0; j < 8; ++j) wv[j] = wc[ks * 16 + h * 8 + j];
    bf16x8 a[2], bb[2];
#pragma unroll
    for (int i = 0; i < 2; ++i) {
      const uint4 u = *(const uint4*)(vt + i * 32 * 72 + ks * 16);
      float x[8]; unpack8(u, x);
#pragma unroll
      for (int j = 0; j < 8; ++j) x[j] *= wv[j];
      a[i] = __builtin_bit_cast(bf16x8, pack8(x));
    }
#pragma unroll
    for (int j = 0; j < 2; ++j) bb[j] = ld8(kt + j * 32 * 72 + ks * 16);
#pragma unroll
    for (int i = 0; i < 2; ++i)
#pragma unroll
      for (int j = 0; j < 2; ++j) acc[i][j] = MFMA32(a[i], bb[j], acc[i][j]);
  }
  float* ch = p.CH + (size_t)(bh * 32 + c) * CHS;
#pragma unroll
  for (int i = 0; i < 2; ++i)
#pragma unroll
    for (int j = 0; j < 2; ++j)
#pragma unroll
      for (int e = 0; e < 16; ++e) ch[(vi * 64 + i * 32 + crow(e, h)) * 128 + ki * 64 + j * 32 + r] = acc[i][j][e];
  if (tid < 128) {
    float s = 0.f;
#pragma unroll
    for (int q = 0; q < 8; ++q) {
      float x[8]; unpack8(*(const uint4*)(Ks + tid * 72 + q * 8), x);
#pragma unroll
      for (int j = 0; j < 8; ++j) s += wc[q * 8 + j] * x[j];
    }
    ch[128 * 128 + tid] = s;
  }
  __syncthreads();
}

DI void phaseB2(const Params& p, int l) {
  const int tid = tidx();
  for (int it = bidx(); it < 32 * 17; it += gridDim.x) {
    const int bh = it / 17, sl = it % 17;
    const int e4 = sl * 256 + tid;
    if (e4 >= 4128) continue;
    float m = 0.f;
    float4 C = make_float4(0.f, 0.f, 0.f, 0.f);
    float4* base = (float4*)(p.CH + (size_t)bh * 32 * CHS) + e4;
#pragma unroll 4
    for (int c = 0; c < 32; ++c) {
      const float bend = p.scal[(bh * 32 + c) * 2], mloc = p.scal[(bh * 32 + c) * 2 + 1];
      float4* q = base + (size_t)c * (CHS / 4);
      const float4 d = *q;
      *q = C;
      if (e4 == 0) p.mstart[bh * 32 + c] = m;
      const float mn = fmaxf(bend + m, mloc);
      const float dec = __expf(bend + m - mn), sc = __expf(mloc - mn);
      C.x = dec * C.x + sc * d.x; C.y = dec * C.y + sc * d.y; C.z = dec * C.z + sc * d.z; C.w = dec * C.w + sc * d.w;
      m = mn;
    }
    if (e4 < 4096) *((float4*)(p.out + O_CP + (size_t)(l * 32 + bh) * 16384) + e4) = C;
    else *((float4*)(p.out + O_NP + (size_t)(l * 32 + bh) * 128) + (e4 - 4096)) = C;
    if (e4 == 0) p.out[O_MP + l * 32 + bh] = m;
  }
}

DI void mlstm_iii(const Params& p, int l, int item, char* smem) {
  const int tid = tidx(), lane = tid & 63, w = tid >> 6, r = lane & 31, h = lane >> 5;
  const int bh = item >> 5, c = item & 31, b = bh >> 2, hh = bh & 3;
  const int tok0 = b * 2048 + c * 64;
  bf16_t* Qs = (bf16_t*)smem;
  bf16_t* As = (bf16_t*)(smem + 17408);
  float* Hs = (float*)(smem + 26624);
  float* sv = (float*)(smem + 60416);
  float *rowoff = sv, *gsrc = sv + 64, *winter = sv + 128, *enm = sv + 192, *scl = sv + 256, *nvec = sv + 320, *mus = sv + 448, *rss = sv + 512;
  const float* ch = p.CH + (size_t)(bh * 32 + c) * CHS;
#pragma unroll
  for (int i = 0; i < 4; ++i) {
    const int pc = tid + 256 * i, row = pc >> 4, cc = (pc & 15) * 8;
    *(uint4*)(Qs + row * 136 + cc) = *(const uint4*)(p.qkvo + (size_t)(tok0 + row) * 2048 + hh * 128 + cc);
  }
  if (tid < 128) nvec[tid] = ch[128 * 128 + tid];
  if (w == 0) {
    const float* f = p.F + (size_t)(tok0 + lane) * FS + 768;
    const float gi = f[hh], gf = f[4 + hh];
    float x = logsigmoidf_(gf);
#pragma unroll
    for (int o = 1; o < 64; o <<= 1) { const float t = __shfl_up(x, o); if (lane >= o) x += t; }
    const float u = gi - x;
    float pm = u;
#pragma unroll
    for (int o = 1; o < 64; o <<= 1) { const float t = __shfl_up(pm, o); if (lane >= o) pm = fmaxf(pm, t); }
    const float mc = p.mstart[bh * 32 + c];
    const float inter = x + mc;
    const float mt = fmaxf(inter, x + pm);
    rowoff[lane] = x - mt; gsrc[lane] = u; winter[lane] = __expf(inter - mt); enm[lane] = __expf(-mt);
  }
  __syncthreads();
  {
    const int ti = w >> 1, si = w & 1;
    f32x16 acc;
#pragma unroll
    for (int e = 0; e < 16; ++e) acc[e] = 0.f;
    if (si <= ti) {
      const bf16_t* kp = p.qkvo + (size_t)(tok0 + si * 32 + r) * 2048 + 512 + hh * 128 + h * 8;
#pragma unroll
      for (int ks = 0; ks < 8; ++ks) {
        const bf16x8 a = ld8(Qs + (ti * 32 + r) * 136 + ks * 16 + h * 8);
        const bf16x8 bb = ld8(kp + ks * 16);
        acc = MFMA32(a, bb, acc);
      }
    }
    const int s = si * 32 + r;
    const float gs = gsrc[s];
#pragma unroll
    for (int e = 0; e < 16; ++e) {
      const int t = ti * 32 + crow(e, h);
      const float v = (s <= t) ? __expf(rowoff[t] + gs) * acc[e] : 0.f;
      As[t * 72 + s] = (bf16_t)f2bf(v);
    }
  }
  __syncthreads();
  f32x16 acc1[2], acc2[2];
#pragma unroll
  for (int i = 0; i < 2; ++i)
#pragma unroll
    for (int e = 0; e < 16; ++e) { acc1[i][e] = 0.f; acc2[i][e] = 0.f; }
  {
    const bf16_t* vt = p.VT + ((size_t)(bh * 128 + w * 32 + r)) * 2048 + c * 64 + h * 8;
#pragma unroll 2
    for (int ks = 0; ks < 4; ++ks) {
      const bf16x8 bb = ld8(vt + ks * 16);
#pragma unroll
      for (int i = 0; i < 2; ++i) { const bf16x8 a = ld8(As + (i * 32 + r) * 72 + ks * 16 + h * 8); acc1[i] = MFMA32(a, bb, acc1[i]); }
    }
    const float* cp = ch + (size_t)(w * 32 + r) * 128 + h * 8;
#pragma unroll 4
    for (int ks = 0; ks < 8; ++ks) {
      float x[8]; ld8f(cp + ks * 16, x);
      const bf16x8 bb = __builtin_bit_cast(bf16x8, pack8(x));
#pragma unroll
      for (int i = 0; i < 2; ++i) { const bf16x8 a = ld8(Qs + (i * 32 + r) * 136 + ks * 16 + h * 8); acc2[i] = MFMA32(a, bb, acc2[i]); }
    }
  }
  if (tid < 64) {
    const int t = tid;
    float di = 0.f;
#pragma unroll
    for (int q = 0; q < 8; ++q) { float x[8]; unpack8(*(const uint4*)(As + t * 72 + q * 8), x);
#pragma unroll
      for (int j = 0; j < 8; ++j) di += x[j]; }
    float nq = 0.f;
#pragma unroll 2
    for (int q = 0; q < 16; ++q) { float x[8]; unpack8(*(const uint4*)(Qs + t * 136 + q * 8), x);
#pragma unroll
      for (int j = 0; j < 8; ++j) nq += x[j] * nvec[q * 8 + j]; }
    const float den = di + winter[t] * nq;
    scl[t] = 1.f / fmaxf(fabsf(den), enm[t]);
  }
  __syncthreads();
#pragma unroll
  for (int i = 0; i < 2; ++i)
#pragma unroll
    for (int e = 0; e < 16; ++e) {
      const int t = i * 32 + crow(e, h);
      Hs[t * 132 + w * 32 + r] = (acc1[i][e] + winter[t] * acc2[i][e]) * scl[t];
    }
  __syncthreads();
  {
    const int t = tid >> 2, part = tid & 3;
    float s = 0.f;
#pragma unroll
    for (int j = 0; j < 32; ++j) s += Hs[t * 132 + j * 4 + part];
    s += __shfl_xor(s, 1); s += __shfl_xor(s, 2);
    const float mu = s * (1.f / 128.f);
    float q = 0.f;
#pragma unroll
    for (int j = 0; j < 32; ++j) { const float d = Hs[t * 132 + j * 4 + part] - mu; q += d * d; }
    q += __shfl_xor(q, 1); q += __shfl_xor(q, 2);
    if (part == 0) { mus[t] = mu; rss[t] = rsqrtf(q * (1.f / 128.f) + LN_EPS); }
  }
  __syncthreads();
  const float* mg = p.mh_g + l * 512 + hh * 128;
#pragma unroll
  for (int i = 0; i < 4; ++i) {
    const int pc = tid + 256 * i, t = pc >> 4, v0 = (pc & 15) * 8;
    float o[8]; unpack8(*(const uint4*)(p.qkvo + (size_t)(tok0 + t) * 2048 + 1536 + hh * 128 + v0), o);
    float gg[8]; ld8f(mg + v0, gg);
    const float mu = mus[t], rs = rss[t];
    float y[8];
#pragma unroll
    for (int j = 0; j < 8; ++j) y[j] = sigmoidf_(o[j]) * ((Hs[t * 132 + v0 + j] - mu) * rs * gg[j]);
    *(uint4*)(p.hbf + (size_t)(tok0 + t) * 1024 + hh * 128 + v0) = pack8(y);
  }
  __syncthreads();
}

DI void mlstm_sample(const Params& p, int l, int item, char* smem) {
  const int tid = tidx(), lane = tid & 63, w = tid >> 6;
  const int b = item >> 2, hh = item & 3;
  const int tok0 = NP + b * 4;
  float* qs = (float*)smem;
  float* ks = qs + 512;
  float* vs = ks + 512;
  float* hs = vs + 512;
  float* ns = hs + 512;
  float* qk = ns + 128;
  float* nq = qk + 16;
  const size_t sidx = (size_t)(l * 128 + b) * 4 + hh;
  for (int i = tid; i < 1536; i += 256) {
    const int m = i >> 9, t = (i >> 7) & 3, d = i & 127;
    qs[i] = bf2f(p.qkvo[(size_t)(tok0 + t) * 2048 + m * 512 + hh * 128 + d]);
  }
  if (tid < 128) ns[tid] = p.stN[sidx * 128 + tid];
  __syncthreads();
  {
    const int dp = tid >> 3, part = tid & 7;
    if (dp < 20) {
      const float* x = qs + (dp < 16 ? (dp >> 2) : (dp - 16)) * 128 + part * 16;
      const float* y = (dp < 16 ? ks + (dp & 3) * 128 : ns) + part * 16;
      float a = 0.f;
#pragma unroll
      for (int d = 0; d < 16; ++d) a += x[d] * y[d];
      a += __shfl_xor(a, 1); a += __shfl_xor(a, 2); a += __shfl_xor(a, 4);
      if (part == 0) { if (dp < 16) qk[dp] = a; else nq[dp - 16] = a; }
    }
  }
  float ig[4], bc[4];
  {
    float run = 0.f;
#pragma unroll
    for (int t = 0; t < 4; ++t) { const float* f = p.F + (size_t)(tok0 + t) * FS + 768; ig[t] = f[hh]; run += logsigmoidf_(f[4 + hh]); bc[t] = run; }
  }
  const float mprev = p.stM[sidx];
  float mt[4], wint[4];
#pragma unroll
  for (int t = 0; t < 4; ++t) {
    float mm = bc[t] + mprev;
#pragma unroll
    for (int s = 0; s < 4; ++s) if (s <= t) mm = fmaxf(mm, bc[t] - bc[s] + ig[s]);
    mt[t] = mm; wint[t] = __expf(bc[t] + mprev - mm);
  }
  const float bend = bc[3];
  float mnew = bend + mprev;
#pragma unroll
  for (int s = 0; s < 4; ++s) mnew = fmaxf(mnew, bend - bc[s] + ig[s]);
  float wcs[4];
#pragma unroll
  for (int s = 0; s < 4; ++s) wcs[s] = __expf(bend - bc[s] + ig[s] - mnew);
  const float dec = __expf(bend + mprev - mnew);
  __syncthreads();
  float a[4][4], den[4];
#pragma unroll
  for (int t = 0; t < 4; ++t) {
    float ds = 0.f;
#pragma unroll
    for (int s = 0; s < 4; ++s) { a[t][s] = (s <= t) ? __expf(bc[t] - bc[s] + ig[s] - mt[t]) * qk[t * 4 + s] : 0.f; ds += a[t][s]; }
    den[t] = ds + wint[t] * nq[t];
  }
  {
    const int k4i = tid & 31, rgrp = tid >> 5, l5 = lane & 31;
    const bool bb4 = l5 & 16, bb3 = l5 & 8;
    float4 q4[4], k4[4];
#pragma unroll
    for (int t = 0; t < 4; ++t) { q4[t] = *(const float4*)(qs + t * 128 + k4i * 4); k4[t] = *(const float4*)(ks + t * 128 + k4i * 4); }
    const float wint_t = bb4 ? (bb3 ? wint[3] : wint[2]) : (bb3 ? wint[1] : wint[0]);
    const float den_t = bb4 ? (bb3 ? den[3] : den[2]) : (bb3 ? den[1] : den[0]);
    const float mt_t = bb4 ? (bb3 ? mt[3] : mt[2]) : (bb3 ? mt[1] : mt[0]);
    const float invd_t = 1.f / fmaxf(fabsf(den_t), __expf(-mt_t));
    float a_t[4];
#pragma unroll
    for (int s = 0; s < 4; ++s) a_t[s] = bb4 ? (bb3 ? a[3][s] : a[2][s]) : (bb3 ? a[1][s] : a[0][s]);
    const int tsel = (bb4 ? 2 : 0) + (bb3 ? 1 : 0);
    const float* cbase = p.stC + sidx * 16384 + k4i * 4;
    float* obase = p.out + O_CS + sidx * 16384 + k4i * 4;
#pragma unroll 4
    for (int j = 0; j < 16; ++j) {
      const int vrow = rgrp + 8 * j;
      const float4 cv = *(const float4*)(cbase + vrow * 128);
      const float v0 = vs[vrow], v1 = vs[128 + vrow], v2 = vs[256 + vrow], v3 = vs[384 + vrow];
      float pt[4];
#pragma unroll
      for (int t = 0; t < 4; ++t) pt[t] = cv.x * q4[t].x + cv.y * q4[t].y + cv.z * q4[t].z + cv.w * q4[t].w;
      const float w0 = wcs[0] * v0, w1 = wcs[1] * v1, w2 = wcs[2] * v2, w3 = wcs[3] * v3;
      float4 cn;
      cn.x = dec * cv.x + w0 * k4[0].x + w1 * k4[1].x + w2 * k4[2].x + w3 * k4[3].x;
      cn.y = dec * cv.y + w0 * k4[0].y + w1 * k4[1].y + w2 * k4[2].y + w3 * k4[3].y;
      cn.z = dec * cv.z + w0 * k4[0].z + w1 * k4[1].z + w2 * k4[2].z + w3 * k4[3].z;
      cn.w = dec * cv.w + w0 * k4[0].w + w1 * k4[1].w + w2 * k4[2].w + w3 * k4[3].w;
      *(float4*)(obase + vrow * 128) = cn;
      float r2[2];
#pragma unroll
      for (int jj = 0; jj < 2; ++jj) { const float x = pt[jj], y = pt[jj + 2]; r2[jj] = (bb4 ? y : x) + __shfl_xor(bb4 ? x : y, 16); }
      float r1 = (bb3 ? r2[1] : r2[0]) + __shfl_xor(bb3 ? r2[0] : r2[1], 8);
      r1 += __shfl_xor(r1, 4); r1 += __shfl_xor(r1, 2); r1 += __shfl_xor(r1, 1);
      if ((l5 & 7) == 0) hs[tsel * 128 + vrow] = (wint_t * r1 + a_t[0] * v0 + a_t[1] * v1 + a_t[2] * v2 + a_t[3] * v3) * invd_t;
    }
  }
  if (tid < 128) {
    float nn = dec * ns[tid];
#pragma unroll
    for (int s = 0; s < 4; ++s) nn += wcs[s] * ks[s * 128 + tid];
    p.out[O_NS + sidx * 128 + tid] = nn;
  }
  if (tid == 0) p.out[O_MS + sidx] = mnew;
  __syncthreads();
  {
    const int t = w;
    const float h0 = hs[t * 128 + lane], h1 = hs[t * 128 + 64 + lane];
    const float mu = wsum(h0 + h1) * (1.f / 128.f);
    const float d0 = h0 - mu, d1 = h1 - mu;
    const float rs = rsqrtf(wsum(d0 * d0 + d1 * d1) * (1.f / 128.f) + LN_EPS);
    const float* mg = p.mh_g + l * 512 + hh * 128;
    const bf16_t* op = p.qkvo + (size_t)(tok0 + t) * 2048 + 1536 + hh * 128;
    bf16_t* yp = p.hbf + (size_t)(tok0 + t) * 1024 + hh * 128;
    yp[lane] = (bf16_t)f2bf(sigmoidf_(bf2f(op[lane])) * d0 * rs * mg[lane]);
    yp[64 + lane] = (bf16_t)f2bf(sigmoidf_(bf2f(op[64 + lane])) * d1 * rs * mg[64 + lane]);
  }
  __syncthreads();
}

DI void sgu_prompt(const Params& p, int l, int item, char* smem) {
  const int tid = tidx(), lane = tid & 63, w = tid >> 6, r = lane & 31, h = lane >> 5;
  const int g = item & 3, bc = item >> 2;
  const int tok0 = bc * 128;
  bf16_t* Ws = (bf16_t*)smem;
  bf16_t* Vt = (bf16_t*)(smem + 34816);
  {
    const int s = tid >> 1, hf = tid & 1;
    const float* vp = p.F + (size_t)(tok0 + s) * FS + 256 + g * 64 + hf * 32;
    float x[32];
#pragma unroll
    for (int q = 0; q < 4; ++q) ld8f(vp + q * 8, x + q * 8);
    float sm = 0.f;
#pragma unroll
    for (int j = 0; j < 32; ++j) sm += x[j];
    sm += __shfl_xor(sm, 1);
    const float mu = sm * (1.f / 64.f);
    float q2 = 0.f;
#pragma unroll
    for (int j = 0; j < 32; ++j) { const float d = x[j] - mu; q2 += d * d; }
    q2 += __shfl_xor(q2, 1);
    const float rs = rsqrtf(q2 * (1.f / 64.f) + LN_EPS);
    const float* gp = p.sgu_g + l * 256 + g * 64 + hf * 32;
    const float* bp = p.sgu_b + l * 256 + g * 64 + hf * 32;
#pragma unroll
    for (int j = 0; j < 32; ++j) Vt[(hf * 32 + j) * 136 + s] = (bf16_t)f2bf((x[j] - mu) * rs * gp[j] + bp[j]);
  }
  {
    const float* wsp = p.w_s + (size_t)(l * 4 + g) * 16384;
#pragma unroll
    for (int i = 0; i < 16; ++i) {
      const int e4 = tid + 256 * i, t = e4 >> 5, s0 = (e4 & 31) * 4;
      const float4 v = *(const float4*)(wsp + t * 128 + s0);
      const float a0 = s0 <= t ? v.x : 0.f, a1 = s0 + 1 <= t ? v.y : 0.f, a2 = s0 + 2 <= t ? v.z : 0.f, a3 = s0 + 3 <= t ? v.w : 0.f;
      *(uint2*)(Ws + t * 136 + s0) = make_uint2(pack2(a0, a1), pack2(a2, a3));
    }
  }
  __syncthreads();
  f32x16 acc[2];
#pragma unroll
  for (int j = 0; j < 2; ++j)
#pragma unroll
    for (int e = 0; e < 16; ++e) acc[j][e] = 0.f;
#pragma unroll
  for (int ks = 0; ks < 8; ++ks) {
    const bf16x8 a = ld8(Ws + (w * 32 + r) * 136 + ks * 16 + h * 8);
#pragma unroll
    for (int j = 0; j < 2; ++j) { const bf16x8 bb = ld8(Vt + (j * 32 + r) * 136 + ks * 16 + h * 8); acc[j] = MFMA32(a, bb, acc[j]); }
  }
  const float* bsp = p.b_s + (l * 4 + g) * 128;
#pragma unroll
  for (int j = 0; j < 2; ++j)
#pragma unroll
    for (int e = 0; e < 16; ++e) {
      const int t = w * 32 + crow(e, h), d = j * 32 + r;
      const float u = p.F[(size_t)(tok0 + t) * FS + g * 64 + d];
      p.hbf[(size_t)(tok0 + t) * 1024 + 512 + g * 64 + d] = (bf16_t)f2bf(u * (acc[j][e] + bsp[t]));
    }
  __syncthreads();
}

DI void sgu_sample(const Params& p, int l, int b) {
  const int tid = tidx(), g = tid >> 6;
  const int tok0 = NP + b * 4;
  float vn[4];
  const float gg = p.sgu_g[l * 256 + tid], bb = p.sgu_b[l * 256 + tid];
#pragma unroll
  for (int t = 0; t < 4; ++t) {
    const float x = p.F[(size_t)(tok0 + t) * FS + 256 + tid];
    const float mu = wsum(x) * (1.f / 64.f);
    const float d = x - mu;
    const float rs = rsqrtf(wsum(d * d) * (1.f / 64.f) + LN_EPS);
    vn[t] = d * rs * gg + bb;
    p.out[O_SV + ((size_t)(l * 128 + b) * 4 + t) * 256 + tid] = vn[t];
  }
  const float* wsp = p.w_s + (size_t)(l * 4 + g) * 16384;
  const float* bsp = p.b_s + (l * 4 + g) * 128;
#pragma unroll
  for (int t = 0; t < 4; ++t) {
    float mix = bsp[t];
#pragma unroll
    for (int s = 0; s < 4; ++s) if (s <= t) mix += wsp[t * 128 + s] * vn[s];
    const float u = p.F[(size_t)(tok0 + t) * FS + tid];
    p.hbf[(size_t)(tok0 + t) * 1024 + 512 + tid] = (bf16_t)f2bf(u * mix);
  }
}

DI void pool_tail(const Params& p, int l, int tokbase, const float* P, int tid) {
  const int g = tid >> 6, e = tid & 63;
  float acc[16];
#pragma unroll
  for (int i = 0; i < 16; ++i) acc[i] = 0.f;
  const float* wp = p.w_pool + (size_t)(l * 4 + g) * 4096 + e;
#pragma unroll 4
  for (int d4 = 0; d4 < 16; ++d4) {
    const float w0 = wp[(d4 * 4) * 64], w1 = wp[(d4 * 4 + 1) * 64], w2 = wp[(d4 * 4 + 2) * 64], w3 = wp[(d4 * 4 + 3) * 64];
#pragma unroll
    for (int tt = 0; tt < 16; ++tt) {
      const float4 p4 = *(const float4*)(P + tt * 256 + g * 64 + d4 * 4);
      acc[tt] += p4.x * w0 + p4.y * w1 + p4.z * w2 + p4.w * w3;
    }
  }
  const float ps = p.pool_scale[l * 256 + tid];
#pragma unroll
  for (int tt = 0; tt < 16; ++tt) p.hbf[(size_t)(tokbase + tt) * 1024 + 768 + tid] = (bf16_t)f2bf(acc[tt] * ps);
}

DI void pool_prompt(const Params& p, int l, int item, char* smem) {
  const int tid = tidx();
  const int b = item >> 7, t0 = (item & 127) * 16;
  float* X = (float*)smem;
  float* P = X + 31 * 256;
#pragma unroll
  for (int i = 0; i < 31; ++i) { const int t = t0 - 15 + i; const int tc = t >= 0 ? t : 0; const float v = p.F[(size_t)(b * 2048 + tc) * FS + 512 + tid]; X[i * 256 + tid] = t >= 0 ? v : 0.f; }
  __syncthreads();
  const int g = tid >> 6, wsz = 2 << g;
#pragma unroll 4
  for (int tt = 0; tt < 16; ++tt) {
    float s = 0.f;
#pragma unroll
    for (int j = 0; j < 16; ++j) { const float xv = X[(15 + tt - j) * 256 + tid]; s += j < wsz ? xv : 0.f; }
    const int pos = t0 + tt;
    const float cnt = (float)(pos + 1 < wsz ? pos + 1 : wsz);
    P[tt * 256 + tid] = s / cnt - X[(15 + tt) * 256 + tid];
  }
  if (t0 == 2032)
    for (int tt = 1; tt < 16; ++tt) p.out[O_PP + ((size_t)(l * 8 + b) * 15 + (tt - 1)) * 256 + tid] = X[(15 + tt) * 256 + tid];
  __syncthreads();
  pool_tail(p, l, b * 2048 + t0, P, tid);
  __syncthreads();
}

DI void pool_sample(const Params& p, int l, int item, char* smem) {
  const int tid = tidx();
  const int b0 = item * 4;
  float* X = (float*)smem;
  float* P = X + 31 * 256;
  const int g = tid >> 6, wsz = 2 << g;
  for (int bi = 0; bi < 4; ++bi) {
    const int b = b0 + bi;
#pragma unroll
    for (int i = 0; i < 19; ++i)
      X[i * 256 + tid] = i < 15 ? p.stPool[((size_t)(l * 128 + b) * 15 + i) * 256 + tid] : p.F[(size_t)(NP + b * 4 + (i - 15)) * FS + 512 + tid];
    __syncthreads();
#pragma unroll
    for (int t = 0; t < 4; ++t) {
      float s = 0.f;
#pragma unroll
      for (int j = 0; j < 16; ++j) { const float xv = X[(15 + t - j) * 256 + tid]; s += j < wsz ? xv : 0.f; }
      P[(bi * 4 + t) * 256 + tid] = s / (float)wsz - X[(15 + t) * 256 + tid];
    }
#pragma unroll
    for (int i = 0; i < 15; ++i) p.out[O_PS + ((size_t)(l * 128 + b) * 15 + i) * 256 + tid] = X[(4 + i) * 256 + tid];
    __syncthreads();
  }
  pool_tail(p, l, NP + b0 * 4, P, tid);
  __syncthreads();
}

DI void phaseB1(const Params& p, int l, char* smem) {
  const int G = gridDim.x, bx = bidx();
  for (int it = bx; it < 512; it += G) mlstm_sample(p, l, it, smem);
  for (int it = (bx + 256) % G; it < 1024; it += G) mlstm_i(p, l, it, smem);
  for (int it = bx; it < 512; it += G) sgu_prompt(p, l, it, smem);
  for (int it = (bx + 128) % G; it < 128; it += G) sgu_sample(p, l, it);
  for (int it = bx; it < 1024; it += G) pool_prompt(p, l, it, smem);
  for (int it = (bx + 64) % G; it < 32; it += G) pool_sample(p, l, it, smem);
}

DI void phaseB3(const Params& p, int l, char* smem) {
  for (int it = bidx(); it < 1024; it += gridDim.x) mlstm_iii(p, l, it, smem);
}

__device__ const unsigned kCandWords[16] = {0x03020100u, 0x07060504u, 0x0b0a0908u, 0x0f0e0d0cu, 0x13121110u, 0x17161514u, 0x23222120u, 0x32313024u,
                                            0x42414033u, 0x61605150u, 0x90807170u, 0xd0c0b0a0u, 0xfffff0e0u, 0xffffffffu, 0xffffffffu, 0xffffffffu};

DI void ce_(int& a, int& b, bool desc) { const int hi = max(a, b), lo = min(a, b); a = desc ? hi : lo; b = desc ? lo : hi; }
DI void bitonic_sort16(int* v) {
#pragma unroll
  for (int k = 2; k <= 16; k <<= 1) {
#pragma unroll
    for (int j = k >> 1; j >= 1; j >>= 1) {
#pragma unroll
      for (int i = 0; i < 16; ++i) { const int l = i ^ j; if (l > i) ce_(v[i], v[l], (i & k) == 0); }
    }
  }
}
DI void bitonic_merge16(int* v) {
#pragma unroll
  for (int j = 8; j >= 1; j >>= 1) {
#pragma unroll
    for (int i = 0; i < 16; ++i) { const int l = i ^ j; if (l > i) ce_(v[i], v[l], true); }
  }
}

DI void phaseF(const Params& p, int l, char* smem) {
  const int tid = tidx(), lane = tid & 63, w = tid >> 6, r = lane & 31, h = lane >> 5;
  float* Sc = (float*)smem;
  float* ls = (float*)(smem + 33024);
  int* li = (int*)(smem + 41472);
  int* jp = (int*)(smem + 49920);
  for (int it = bidx(); it < 264 * 8; it += gridDim.x) {
    const int tile = it >> 3, hd = it & 7;
    const int tok0 = tile * 64;
    for (int pp = 0; pp < 2; ++pp) {
      f32x16 acc[2];
#pragma unroll
      for (int i = 0; i < 2; ++i)
#pragma unroll
        for (int e = 0; e < 16; ++e) acc[i][e] = 0.f;
      const bf16_t* qp = p.qkvo + (size_t)(tok0 + r) * 2048 + (hd * 2 + pp) * 128 + h * 8;
      const bf16_t* kp = p.keysb + ((size_t)((l * 8 + hd) * 2 + pp) * 128 + w * 32 + r) * 128 + h * 8;
#pragma unroll
      for (int ks = 0; ks < 8; ++ks) {
        const bf16x8 bb = ld8(kp + ks * 16);
#pragma unroll
        for (int i = 0; i < 2; ++i) { const bf16x8 a = ld8(qp + (size_t)i * 32 * 2048 + ks * 16); acc[i] = MFMA32(a, bb, acc[i]); }
      }
#pragma unroll
      for (int i = 0; i < 2; ++i)
#pragma unroll
        for (int e = 0; e < 16; ++e) Sc[(i * 32 + crow(e, h)) * 129 + w * 32 + r] = acc[i][e];
      __syncthreads();
      {
        const int row = tid >> 2, part = tid & 3;
        int va[16], vb[16];
#pragma unroll
        for (int j = 0; j < 16; ++j) {
          const int fa = __float_as_int(Sc[row * 129 + j * 4 + part]);
          const int ma = fa ^ ((fa >> 31) & 0x7fffffff);
          va[j] = (ma & ~127) | (127 - (j * 4 + part));
          const int fb = __float_as_int(Sc[row * 129 + (j + 16) * 4 + part]);
          const int mb = fb ^ ((fb >> 31) & 0x7fffffff);
          vb[j] = (mb & ~127) | (127 - ((j + 16) * 4 + part));
        }
        bitonic_sort16(va); bitonic_sort16(vb);
        int vc[16];
#pragma unroll
        for (int i = 0; i < 16; ++i) vc[i] = max(va[i], vb[15 - i]);
        bitonic_merge16(vc);
#pragma unroll
        for (int o = 1; o < 4; o <<= 1) {
          int vp[16];
#pragma unroll
          for (int i = 0; i < 16; ++i) vp[i] = (o == 1) ? dpp_xor1(vc[15 - i]) : dpp_xor2(vc[15 - i]);
#pragma unroll
          for (int i = 0; i < 16; ++i) vc[i] = max(vc[i], vp[i]);
          bitonic_merge16(vc);
        }
        if (part == 0) {
#pragma unroll
          for (int i = 0; i < 16; ++i) {
            const int mono = vc[i] & ~127;
            ls[row * 33 + pp * 16 + i] = __int_as_float(mono ^ ((mono >> 31) & 0x7fffffff));
            li[row * 33 + pp * 16 + i] = 127 - (vc[i] & 127);
          }
        }
      }
      __syncthreads();
    }
    {
      const int row = tid >> 2, part = tid & 3;
      int vc[16];
#pragma unroll
      for (int k = 0; k < 16; ++k) {
        const unsigned cw = kCandWords[k];
        const unsigned ij = (cw >> (8 * part)) & 0xffu;
        const int c = 4 * k + part;
        int key = (int)0x80000000;
        if (ij != 0xffu) {
          const float v = ls[row * 33 + (ij >> 4)] + ls[row * 33 + 16 + (ij & 15)];
          const int fb = __float_as_int(v);
          const int mono = fb ^ ((fb >> 31) & 0x7fffffff);
          key = (mono & ~63) | (63 - c);
        }
        vc[k] = key;
      }
      bitonic_sort16(vc);
#pragma unroll
      for (int o = 1; o < 4; o <<= 1) {
        int vp[16];
#pragma unroll
        for (int i = 0; i < 16; ++i) vp[i] = (o == 1) ? dpp_xor1(vc[15 - i]) : dpp_xor2(vc[15 - i]);
#pragma unroll
        for (int i = 0; i < 16; ++i) vc[i] = max(vc[i], vp[i]);
        bitonic_merge16(vc);
      }
      float sc[16];
      float sum = 0.f;
#pragma unroll
      for (int st = 0; st < 16; ++st) {
        const int mono = vc[st] & ~63;
        sc[st] = __int_as_float(mono ^ ((mono >> 31) & 0x7fffffff));
      }
      const float s0 = sc[0];
#pragma unroll
      for (int st = 0; st < 16; ++st) { sc[st] = __expf(sc[st] - s0); sum += sc[st]; }
      const float inv = 1.f / sum;
      int oid[4]; float og[4];
#pragma unroll
      for (int q = 0; q < 4; ++q) {
        const int kq = part == 0 ? vc[q] : (part == 1 ? vc[4 + q] : (part == 2 ? vc[8 + q] : vc[12 + q]));
        const float gq = part == 0 ? sc[q] : (part == 1 ? sc[4 + q] : (part == 2 ? sc[8 + q] : sc[12 + q]));
        const int c = 63 - (kq & 63);
        const unsigned ij = (kCandWords[c >> 2] >> (8 * (c & 3))) & 0xffu;
        oid[q] = li[row * 33 + (ij >> 4)] * 128 + li[row * 33 + 16 + (ij & 15)];
        og[q] = gq * inv;
      }
      *(int4*)(p.pidx + (size_t)(tok0 + row) * 128 + hd * 16 + part * 4) = make_int4(oid[0], oid[1], oid[2], oid[3]);
      *(float4*)(p.pgate + (size_t)(tok0 + row) * 128 + hd * 16 + part * 4) = make_float4(og[0], og[1], og[2], og[3]);
    }
    __syncthreads();
  }
}

constexpr int GT = 12;
DI void phaseG(const Params& p, int l, char* smem) {
  const int tid = tidx(), lane = tid & 63, w = tid >> 6, g = lane >> 3, sub = lane & 7;
  const int TW = gridDim.x * 4, wg = bidx() * 4 + w;
  const unsigned char* Uq = p.Uq + (size_t)l * 16384 * 1024;
  const unsigned char* Vq = p.Vq + (size_t)l * 16384 * 1024;
  const float* usc = p.uscale + l * 16384; const float* vsc = p.vscale + l * 16384;
  const float* adaL = p.ada + (size_t)l * 136 * 6144;
  const float* g2g = p.ln2_g + l * 1024; const float* g2b = p.ln2_b + l * 1024;
  float* dstbase = (l == 1) ? p.out : p.XZ;
  float* Y = p.F;
  int* spk0 = (int*)smem + w * (4 * GT * 64) + lane;
  int* spk1 = spk0 + GT * 64;
  const int* gpk0 = (const int*)smem + w * (4 * GT * 64) + 8 * g;
  const int* gpk1 = gpk0 + GT * 64;
  int* sa0 = spk0 + 2 * GT * 64;
  int* sa1 = spk0 + 3 * GT * 64;
  const unsigned sub16 = (unsigned)sub << 4;
  const bool b2 = sub & 4, b1 = sub & 2, b0 = sub & 1;
  const bool b5 = g & 4, b4 = g & 2, b3 = g & 1;
  for (int base = wg; base < NT; base += TW * GT) {
    const int nt = min(GT, (NT - base + TW - 1) / TW);
    for (int i = 0; i < nt; ++i) {
      const int tok = base + i * TW;
      spk0[i * 64] = p.pidx[(size_t)tok * 128 + 8 * sub + g];
      spk1[i * 64] = p.pidx[(size_t)tok * 128 + 64 + 8 * sub + g];
      sa0[i * 64] = 0; sa1[i * 64] = 0;
    }
    const int nsteps = 8 * nt;
#define G_NEXT(c_, i_, cn_, in_) { in_ = (i_) + 1; cn_ = (c_); if (in_ == nt) { in_ = 0; cn_ = (c_) + 1; } if (cn_ == 8) { cn_ = (c_); in_ = (i_); } }
#define U_GATHER(BUF, XS, c_, i_)                                                                            \
    { const unsigned char* tb_ = Uq + (size_t)(c_) * 16384 * 128;                                            \
      XS = *(const uint4*)(p.xq + (size_t)(base + (i_) * TW) * 1024 + (c_) * 128 + sub * 16);                \
      const int4 ka_ = *(const int4*)(gpk0 + (i_) * 64), kb_ = *(const int4*)(gpk0 + (i_) * 64 + 4);         \
      const int4 kc_ = *(const int4*)(gpk1 + (i_) * 64), kd_ = *(const int4*)(gpk1 + (i_) * 64 + 4);         \
      const int kk_[16] = {ka_.x, ka_.y, ka_.z, ka_.w, kb_.x, kb_.y, kb_.z, kb_.w, kc_.x, kc_.y, kc_.z, kc_.w, kd_.x, kd_.y, kd_.z, kd_.w}; \
      _Pragma("unroll") for (int ld = 0; ld < 16; ++ld) {                                                    \
        const unsigned e_ = (unsigned)kk_[ld] & 0xffffu;                                                     \
        BUF[ld] = *(const uint4*)(tb_ + ((e_ << 7) | sub16)); } }
#define U_COMPUTE(BUF, XS, i_)                                                                               \
    {                                                                                                        \
      int t[16];                                                                                             \
      _Pragma("unroll") for (int ld = 0; ld < 16; ++ld) {                                                    \
        int v = __builtin_amdgcn_sdot4((int)BUF[ld].x, (int)XS.x, 0, false);                                 \
        v = __builtin_amdgcn_sdot4((int)BUF[ld].y, (int)XS.y, v, false);                                     \
        v = __builtin_amdgcn_sdot4((int)BUF[ld].z, (int)XS.z, v, false);                                     \
        v = __builtin_amdgcn_sdot4((int)BUF[ld].w, (int)XS.w, v, false); t[ld] = v; }                        \
      int wsum2[2];                                                                                          \
      _Pragma("unroll") for (int k = 0; k < 2; ++k) {                                                        \
        int u4[4], v2[2];                                                                                    \
        _Pragma("unroll") for (int j = 0; j < 4; ++j) { const int x = t[8 * k + j], y = t[8 * k + j + 4]; u4[j] = (b2 ? y : x) + dpp_xor4(b2 ? x : y); } \
        _Pragma("unroll") for (int j = 0; j < 2; ++j) { const int x = u4[j], y = u4[j + 2]; v2[j] = (b1 ? y : x) + dpp_xor2(b1 ? x : y); } \
        { const int x = v2[0], y = v2[1]; wsum2[k] = (b0 ? y : x) + dpp_xor1(b0 ? x : y); } }               \
      sa0[(i_) * 64] += wsum2[0]; sa1[(i_) * 64] += wsum2[1];                                                \
    }
    {
      uint4 A[16]; uint4 xa;
      for (int c = 0; c < 8; ++c)
        for (int i = 0; i < nt; ++i) {
          U_GATHER(A, xa, c, i)
          U_COMPUTE(A, xa, i)
        }
    }
    for (int i = 0; i < nt; ++i) {
      const int tok = base + i * TW;
      const float xsc = p.xscale[tok];
      const float gv0 = p.pgate[(size_t)tok * 128 + 8 * sub + g], gv1 = p.pgate[(size_t)tok * 128 + 64 + 8 * sub + g];
      const int e0 = spk0[i * 64], e1 = spk1[i * 64];
      const float a0 = (float)sa0[i * 64] * usc[e0] * xsc, a1 = (float)sa1[i * 64] * usc[e1] * xsc;
      const float c0f = gv0 * 0.5f * a0 * (1.f + erff(a0 * 0.70710678118654752f)) * vsc[e0];
      const float c1f = gv1 * 0.5f * a1 * (1.f + erff(a1 * 0.70710678118654752f)) * vsc[e1];
      spk0[i * 64] = e0 | (int)(f2bf(c0f) << 16); spk1[i * 64] = e1 | (int)(f2bf(c1f) << 16);
    }
    {
      uint4 A[16]; unsigned ca[8];
#define V_GATHER(BUF, CF, c_, i_)                                                                            \
      { const unsigned char* tb_ = Vq + (size_t)(c_) * 16384 * 128;                                          \
        const int4 ka_ = *(const int4*)(gpk0 + (i_) * 64), kb_ = *(const int4*)(gpk0 + (i_) * 64 + 4);       \
        const int4 kc_ = *(const int4*)(gpk1 + (i_) * 64), kd_ = *(const int4*)(gpk1 + (i_) * 64 + 4);       \
        const int kk_[16] = {ka_.x, ka_.y, ka_.z, ka_.w, kb_.x, kb_.y, kb_.z, kb_.w, kc_.x, kc_.y, kc_.z, kc_.w, kd_.x, kd_.y, kd_.z, kd_.w}; \
        _Pragma("unroll") for (int ld = 0; ld < 16; ++ld) {                                                  \
          const unsigned pv_ = (unsigned)kk_[ld];                                                            \
          BUF[ld] = *(const uint4*)(tb_ + (((pv_ & 0xffffu) << 7) | sub16));                                 \
          if (ld & 1) CF[ld >> 1] |= pv_ & 0xffff0000u; else CF[ld >> 1] = pv_ >> 16; } }
#define FP8ACC(w_, o_) { const f32x2 lo = __builtin_amdgcn_cvt_pk_f32_fp8((int)(w_), false); const f32x2 hi = __builtin_amdgcn_cvt_pk_f32_fp8((int)(w_), true); \
        yv[(o_) / 2] = lo * cf2 + yv[(o_) / 2]; yv[(o_) / 2 + 1] = hi * cf2 + yv[(o_) / 2 + 1]; }
#define V_COMPUTE(BUF, CF, c_, i_)                                                                           \
      {                                                                                                      \
        f32x2 yv[8];                                                                                         \
        _Pragma("unroll") for (int j = 0; j < 8; ++j) { yv[j].x = 0.f; yv[j].y = 0.f; }                      \
        _Pragma("unroll") for (int ld = 0; ld < 16; ++ld) {                                                  \
          const float cf = (ld & 1) ? __uint_as_float(CF[ld >> 1] & 0xffff0000u) : __uint_as_float(CF[ld >> 1] << 16); \
          f32x2 cf2; cf2.x = cf; cf2.y = cf;                                                                 \
          unsigned w0_ = BUF[ld].x, w1_ = BUF[ld].y, w2_ = BUF[ld].z, w3_ = BUF[ld].w;                      \
          asm volatile("" : "+v"(w0_), "+v"(w1_), "+v"(w2_), "+v"(w3_));                                   \
          FP8ACC(w0_, 0) FP8ACC(w1_, 4) FP8ACC(w2_, 8) FP8ACC(w3_, 12)                                      \
          asm volatile("" : "+v"(yv[0]), "+v"(yv[1]), "+v"(yv[2]), "+v"(yv[3]), "+v"(yv[4]), "+v"(yv[5]), "+v"(yv[6]), "+v"(yv[7])); } \
        float y16[16];                                                                                       \
        _Pragma("unroll") for (int j = 0; j < 8; ++j) { y16[2 * j] = yv[j].x; y16[2 * j + 1] = yv[j].y; }    \
        float z8[8], z4[4], z2[2];                                                                           \
        _Pragma("unroll") for (int j = 0; j < 8; ++j) { const float x = y16[j], y = y16[j + 8]; z8[j] = (b5 ? y : x) + __shfl_xor(b5 ? x : y, 32); } \
        _Pragma("unroll") for (int j = 0; j < 4; ++j) { const float x = z8[j], y = z8[j + 4]; z4[j] = (b4 ? y : x) + __shfl_xor(b4 ? x : y, 16); } \
        _Pragma("unroll") for (int j = 0; j < 2; ++j) { const float x = z4[j], y = z4[j + 2]; z2[j] = (b3 ? y : x) + dpp_xor8f(b3 ? x : y); } \
        *(float2*)(Y + (size_t)(base + (i_) * TW) * 1024 + (c_) * 128 + sub * 16 + 2 * g) = make_float2(z2[0], z2[1]); \
      }
      for (int c = 0; c < 8; ++c)
        for (int i = 0; i < nt; ++i) {
          V_GATHER(A, ca, c, i)
          V_COMPUTE(A, ca, c, i)
        }
    }
    __threadfence();
    for (int i = 0; i < nt; ++i) {
      const int tok = base + i * TW;
      const int c0i = lane * 8, c1i = 512 + lane * 8;
      const float* ad = adaL + (size_t)cond_row(tok) * 6144;
      const float* xr = p.XZ + (size_t)tok * 1024;
      const float* yr = Y + (size_t)tok * 1024;
      float z[16], gg[16], y[16];
      ld8f(xr + c0i, z); ld8f(xr + c1i, z + 8);
      ld8f(yr + c0i, y); ld8f(yr + c1i, y + 8);
      ld8f(ad + 5120 + c0i, gg); ld8f(ad + 5120 + c1i, gg + 8);
      float sm = 0.f;
#pragma unroll
      for (int j = 0; j < 16; ++j) { z[j] = ALPHA * z[j] + gg[j] * y[j]; sm += z[j]; }
      const float mu = wsum(sm) * (1.f / 1024.f);
      float q = 0.f;
#pragma unroll
      for (int j = 0; j < 16; ++j) { const float d = z[j] - mu; q += d * d; }
      const float rstd = rsqrtf(wsum(q) * (1.f / 1024.f) + LN_EPS);
      float bb[16];
      ld8f(g2g + c0i, gg); ld8f(g2g + c1i, gg + 8); ld8f(g2b + c0i, bb); ld8f(g2b + c1i, bb + 8);
#pragma unroll
      for (int j = 0; j < 16; ++j) z[j] = (z[j] - mu) * rstd * gg[j] + bb[j];
      float* dr = dstbase + (size_t)tok * 1024;
      st8f(dr + c0i, z); st8f(dr + c1i, z + 8);
      if (l == 0) {
        const float* ad1 = p.ada + (size_t)(136 + cond_row(tok)) * 6144;
        mod_store(p.hbf + (size_t)tok * 1024 + c0i, z, ad1 + 1024 + c0i, ad1 + c0i);
        mod_store(p.hbf + (size_t)tok * 1024 + c1i, z + 8, ad1 + 1024 + c1i, ad1 + c1i);
      }
    }
  }
}

#define XB_TMO      128
#define XB_XCNT(j)  (256  + 64 * (j))
#define XB_XSUB(j)  (1280 + 64 * (j))
#define XB_XGEN(j)  (2304 + 64 * (j))
#define XB_TOP      3328
#define XB_TOPGEN   3392
#define XCD_BAR_WORDS 3456
#define XB_SPIN_CAP (1u << 18)
#define LAS __attribute__((address_space(3)))
DI unsigned xb_ld(unsigned* p) { return __hip_atomic_load(p, __ATOMIC_RELAXED, __HIP_MEMORY_SCOPE_AGENT); }
DI unsigned xb_add(unsigned* p, unsigned v) { return __hip_atomic_fetch_add(p, v, __ATOMIC_RELAXED, __HIP_MEMORY_SCOPE_AGENT); }
DI unsigned xb_xcc_id() { return (unsigned)__builtin_amdgcn_s_getreg((3 << 11) | 20) & 0xFu; }
#define XB_SPIN(cond, bar) do { unsigned _sp = 0; while (cond) { __builtin_amdgcn_s_sleep(1); \
    if ((++_sp & 255u) == 0u) { if (xb_ld(&(bar)[XB_TMO])) break; if (_sp > XB_SPIN_CAP) { atomicAdd(&(bar)[XB_TMO], 1u); break; } } } } while (0)
struct XcdBarrier { unsigned* bar; unsigned x; volatile LAS unsigned* st; };
DI XcdBarrier xcd_barrier_post(unsigned* bar, volatile LAS unsigned* st) {
  XcdBarrier b; b.bar = bar; b.x = xb_xcc_id(); b.st = st;
  if (threadIdx.x == 0) (void)xb_add(&bar[XB_XCNT(b.x)], 1u);
  return b;
}
DI void xcd_barrier_complete(unsigned* bar, unsigned x, unsigned& nloc, unsigned& nx) {
  const unsigned G = gridDim.x * gridDim.y * gridDim.z;
  unsigned sum, cnt, mine, sp = 0u;
  for (;;) {
    sum = 0u; cnt = 0u; mine = 0u;
#pragma unroll
    for (unsigned j = 0; j < 16; ++j) { const unsigned c = xb_ld(&bar[XB_XCNT(j)]); sum += c; cnt += (c > 0u) ? 1u : 0u; mine = (j == x) ? c : mine; }
    if (sum == G) break;
    __builtin_amdgcn_s_sleep(1);
    if ((++sp & 255u) == 0u) { if (xb_ld(&bar[XB_TMO])) break; if (sp > XB_SPIN_CAP) { atomicAdd(&bar[XB_TMO], 1u); break; } }
  }
  nloc = mine > 0u ? mine : 1u; nx = cnt > 0u ? cnt : 1u;
}
DI void xcd_barrier(const XcdBarrier& b) {
  asm volatile("s_waitcnt vmcnt(0)" ::: "memory");
  __syncthreads();
  if (threadIdx.x == 0) {
    unsigned* bar = b.bar;
    __builtin_amdgcn_s_waitcnt(0);
    unsigned nloc = b.st[0], nx = b.st[1];
    if (nloc == 0u) { xcd_barrier_complete(bar, b.x, nloc, nx); b.st[0] = nloc; b.st[1] = nx; }
    const unsigned old = xb_add(&bar[XB_XSUB(b.x)], 1u);
    const unsigned gen = old / nloc;
    if (old + 1u == (gen + 1u) * nloc) {
      __builtin_amdgcn_fence(__ATOMIC_RELEASE, "agent");
      asm volatile("s_waitcnt vmcnt(0)" ::: "memory");
      const unsigned og = xb_add(&bar[XB_TOP], 1u);
      const unsigned tg = og / nx;
      if (og + 1u == (tg + 1u) * nx) xb_add(&bar[XB_TOPGEN], 1u);
      else XB_SPIN(xb_ld(&bar[XB_TOPGEN]) == tg, bar);
      __builtin_amdgcn_fence(__ATOMIC_ACQUIRE, "agent");
      xb_add(&bar[XB_XGEN(b.x)], 1u);
      asm volatile("s_waitcnt vmcnt(0)" ::: "memory");
    } else {
      XB_SPIN(xb_ld(&bar[XB_XGEN(b.x)]) == gen, bar);
      __builtin_amdgcn_fence(__ATOMIC_ACQUIRE, "agent");
      asm volatile("s_waitcnt vmcnt(0)" ::: "memory");
    }
  }
  __syncthreads();
}

__global__ void __launch_bounds__(256, 2) fwd_megakernel(Params p, int ph_lo, int ph_hi) {
  __shared__ __attribute__((aligned(16))) char smem[63488];
  __shared__ uint4 xb_words;
  cg::grid_group grid = cg::this_grid();
  if (threadIdx.x == 0) xb_words = make_uint4(0u, 0u, 0u, 0u);
  __syncthreads();
  const XcdBarrier xb = xcd_barrier_post(p.bar, (volatile LAS unsigned*)&xb_words);
  for (int ph = ph_lo; ph < ph_hi; ++ph) {
    if (ph == 0) phase0(p, smem);
    else if (ph == 1) phase1(p);
    else {
      const int l = (ph - 2) / 9, s = (ph - 2) % 9;
      switch (s) {
        case 0: phaseA(p, l, smem); break;
        case 1: phaseB1(p, l, smem); break;
        case 2: phaseB2(p, l); break;
        case 3: phaseB3(p, l, smem); break;
        case 4: phaseC(p, l, smem); break;
        case 5: phaseD(p, l); break;
        case 6: phaseE(p, l, smem); break;
        case 7: phaseF(p, l, smem); break;
        default: phaseG(p, l, smem); break;
      }
    }
    if (ph + 1 < ph_hi) { if (ph_lo < 0) grid.sync(); xcd_barrier(xb); }
  }
}

#ifndef MULTI_LAUNCH
#define MULTI_LAUNCH 0
#endif

extern "C" void kernel_launch(void* const* d_in, const int* in_sizes, int n_in, void* d_out, int out_size, void* d_ws,
                              size_t ws_size, hipStream_t stream) {
  static int grid_blocks = 0;
  if (!grid_blocks) {
    int dev = 0, cus = 0, per_cu = 0;
    hipGetDevice(&dev);
    hipDeviceGetAttribute(&cus, hipDeviceAttributeMultiprocessorCount, dev);
    hipOccupancyMaxActiveBlocksPerMultiprocessor(&per_cu, fwd_megakernel, 256, 0);
    if (per_cu > 2) per_cu = 2;
    if (per_cu < 1) per_cu = 1;
    grid_blocks = cus * per_cu;
  }
  Params p{};
  const float* const* in = (const float* const*)d_in;
  p.x_prompt = in[0]; p.x_sample = in[1]; p.stC = in[2]; p.stN = in[3]; p.stM = in[4]; p.stPool = in[5];
  p.c_prompt = in[6]; p.c_sample = in[7]; p.w_ada = in[8]; p.b_ada = in[9]; p.w_in = in[10]; p.b_gate = in[11];
  p.mh_g = in[12]; p.sgu_g = in[13]; p.sgu_b = in[14]; p.w_s = in[15]; p.b_s = in[16]; p.w_pool = in[17];
  p.pool_scale = in[18]; p.w_o = in[19]; p.ln1_g = in[20]; p.ln1_b = in[21]; p.w_pq = in[22]; p.peer_keys = in[23];
  p.peer_u = in[24]; p.peer_v = in[25]; p.ln2_g = in[26]; p.ln2_b = in[27];
  p.out = (float*)d_out;
  char* ws = (char*)d_ws; size_t off = 0;
  auto take = [&](size_t bytes) { char* r = ws + off; off += (bytes + 255) & ~(size_t)255; return r; };
  p.ada = (float*)take((size_t)2 * 136 * 6144 * 4);
  p.WinT = (bf16_t*)take((size_t)2 * NIN * 1024 * 2);
  p.WoT = (bf16_t*)take((size_t)2 * 1024 * 1024 * 2);
  p.WpqT = (bf16_t*)take((size_t)2 * 2048 * 1024 * 2);
  p.keysb = (bf16_t*)take((size_t)524288 * 2);
  p.Uq = (unsigned char*)take((size_t)2 * 16384 * 1024);
  p.Vq = (unsigned char*)take((size_t)2 * 16384 * 1024);
  p.xq = (unsigned char*)take((size_t)NT * 1024);
  p.uscale = (float*)take((size_t)2 * 16384 * 4);
  p.vscale = (float*)take((size_t)2 * 16384 * 4);
  p.xscale = (float*)take((size_t)NT * 4);
  p.hbf = (bf16_t*)take((size_t)NT * 1024 * 2);
  p.qkvo = (bf16_t*)take((size_t)NT * 2048 * 2);
  p.KT = (bf16_t*)take((size_t)32 * 128 * 2048 * 2);
  p.VT = (bf16_t*)take((size_t)32 * 128 * 2048 * 2);
  p.F = (float*)take((size_t)NT * FS * 4);
  p.CH = (float*)take((size_t)1024 * CHS * 4);
  p.scal = (float*)take((size_t)2048 * 4);
  p.mstart = (float*)take((size_t)1024 * 4);
  p.XZ = (float*)take((size_t)NT * 1024 * 4);
  p.pgate = (float*)take((size_t)NT * 128 * 4);
  p.pidx = (int*)take((size_t)NT * 128 * 4);
  p.bar = (unsigned*)take((size_t)XCD_BAR_WORDS * 4);
  if (off > ws_size) fprintf(stderr, "workspace too small: need %zu have %zu\n", off, ws_size);
  (void)hipMemsetAsync(p.bar, 0, (size_t)XCD_BAR_WORDS * 4, stream);
#if MULTI_LAUNCH
  for (int ph = 0; ph < 20; ++ph) hipLaunchKernelGGL(fwd_megakernel, dim3(grid_blocks), dim3(256), 0, stream, p, ph, ph + 1);
#else
  int lo = 0, hi = 20;
  void* args[] = {&p, &lo, &hi};
  hipError_t e = hipLaunchCooperativeKernel((void*)fwd_megakernel, dim3(grid_blocks), dim3(256), args, 0, stream);
  if (e != hipSuccess) fprintf(stderr, "cooperative launch failed: %s (grid %d)\n", hipGetErrorString(e), grid_blocks);
#endif
}
```

```cpp
#include <hip/hip_runtime.h>
#include <hip/hip_cooperative_groups.h>
#include <cstdio>
#include <cstdint>
namespace cg = cooperative_groups;

typedef unsigned short bf16_t;
typedef __attribute__((ext_vector_type(8))) short bf16x8;
typedef __attribute__((ext_vector_type(16))) float f32x16;
typedef __attribute__((ext_vector_type(2))) __bf16 bf2_t;
typedef __attribute__((ext_vector_type(2))) float f32x2;
#define DI __device__ __forceinline__
#define MFMA32(a, b, c) __builtin_amdgcn_mfma_f32_32x32x16_bf16((a), (b), (c), 0, 0, 0)

constexpr int NP = 16384, NS = 512, NT = 16896;
constexpr int NIN = 2944;
constexpr int FS = 776;
constexpr float ALPHA = 1.4142135623730951f;
constexpr float LN_EPS = 1e-5f;
constexpr int CHS = 129 * 128;

struct Params {
  const float *x_prompt, *x_sample, *stC, *stN, *stM, *stPool, *c_prompt, *c_sample;
  const float *w_ada, *b_ada, *w_in, *b_gate, *mh_g, *sgu_g, *sgu_b, *w_s, *b_s, *w_pool, *pool_scale, *w_o,
      *ln1_g, *ln1_b, *w_pq, *peer_keys, *peer_u, *peer_v, *ln2_g, *ln2_b;
  float* out;
  float* ada;
  bf16_t *WinT, *WoT, *WpqT, *keysb, *hbf, *qkvo, *KT, *VT;
  unsigned char *Uq, *Vq, *xq;
  float *uscale, *vscale, *xscale;
  float *F, *CH, *scal, *mstart, *XZ, *pgate;
  int* pidx;
  unsigned* bar;
};

constexpr size_t O_YP = 0;
constexpr size_t O_YS = 16777216;
constexpr size_t O_CP = O_YS + 524288;
constexpr size_t O_NP = O_CP + 1048576;
constexpr size_t O_MP = O_NP + 8192;
constexpr size_t O_PP = O_MP + 64;
constexpr size_t O_CS = O_PP + 61440;
constexpr size_t O_NS = O_CS + 16777216;
constexpr size_t O_MS = O_NS + 131072;
constexpr size_t O_PS = O_MS + 1024;
constexpr size_t O_SV = O_PS + 983040;

DI int tidx() { int t = threadIdx.x; asm volatile("" : "+v"(t)); return t; }
DI int bidx() { int b = blockIdx.x; asm volatile("" : "+s"(b)); return b; }
DI unsigned f2bf(float x) { unsigned u = __float_as_uint(x); u += 0x7fffu + ((u >> 16) & 1u); return u >> 16; }
DI unsigned pack2(float a, float b) { return f2bf(a) | (f2bf(b) << 16); }
DI float bflo(unsigned u) { return __uint_as_float(u << 16); }
DI float bfhi(unsigned u) { return __uint_as_float(u & 0xffff0000u); }
DI float bf2f(bf16_t h) { return __uint_as_float(((unsigned)h) << 16); }
DI uint4 pack8(const float* v) { return make_uint4(pack2(v[0], v[1]), pack2(v[2], v[3]), pack2(v[4], v[5]), pack2(v[6], v[7])); }
DI void unpack8(uint4 u, float* v) {
  v[0] = bflo(u.x); v[1] = bfhi(u.x); v[2] = bflo(u.y); v[3] = bfhi(u.y);
  v[4] = bflo(u.z); v[5] = bfhi(u.z); v[6] = bflo(u.w); v[7] = bfhi(u.w);
}
DI int crow(int reg, int h) { return (reg & 3) + 8 * (reg >> 2) + 4 * h; }
DI int cond_row(int tok) { return tok < NP ? (tok >> 11) : 8 + ((tok - NP) >> 2); }
DI int dpp_xor1(int x) { return __builtin_amdgcn_update_dpp(0, x, 0xB1, 0xF, 0xF, true); }
DI int dpp_xor2(int x) { return __builtin_amdgcn_update_dpp(0, x, 0x4E, 0xF, 0xF, true); }
DI int dpp_xor4(int x) { return __builtin_amdgcn_update_dpp(0, __builtin_amdgcn_update_dpp(0, x, 0x141, 0xF, 0xF, true), 0x1B, 0xF, 0xF, true); }
DI int dpp_xor8(int x) { return __builtin_amdgcn_update_dpp(0, x, 0x128, 0xF, 0xF, true); }
DI float dpp_xor8f(float x) { return __builtin_bit_cast(float, dpp_xor8(__builtin_bit_cast(int, x))); }
DI float wsum(float v) { for (int o = 32; o > 0; o >>= 1) v += __shfl_xor(v, o); return v; }
DI float wmax(float v) { for (int o = 32; o > 0; o >>= 1) v = fmaxf(v, __shfl_xor(v, o)); return v; }
DI float sigmoidf_(float x) { return 1.f / (1.f + __expf(-x)); }
DI float logsigmoidf_(float x) { return fminf(x, 0.f) - log1pf(__expf(-fabsf(x))); }
DI float dot2bf(unsigned a, unsigned b, float c) {
  return __builtin_amdgcn_fdot2_f32_bf16(__builtin_bit_cast(bf2_t, a), __builtin_bit_cast(bf2_t, b), c, false);
}
DI bf16x8 ld8(const bf16_t* p) { return __builtin_bit_cast(bf16x8, *(const uint4*)p); }
DI void ld8f(const float* p, float* v) {
  float4 a = ((const float4*)p)[0], b = ((const float4*)p)[1];
  v[0] = a.x; v[1] = a.y; v[2] = a.z; v[3] = a.w; v[4] = b.x; v[5] = b.y; v[6] = b.z; v[7] = b.w;
}
DI void st8f(float* p, const float* v) {
  ((float4*)p)[0] = make_float4(v[0], v[1], v[2], v[3]); ((float4*)p)[1] = make_float4(v[4], v[5], v[6], v[7]);
}

template <class Epi>
DI void gemm128(const bf16_t* __restrict__ A, const bf16_t* __restrict__ Bt, int m0, int n0, char* smem, const Epi& epi) {
  const int tid = tidx(), lane = tid & 63, w = tid >> 6, wm = w >> 1, wn = w & 1, r = lane & 31, h = lane >> 5;
  bf16_t* As = (bf16_t*)smem;
  bf16_t* Bs = As + 128 * 72;
  f32x16 acc[2][2];
#pragma unroll
  for (int i = 0; i < 2; ++i)
#pragma unroll
    for (int j = 0; j < 2; ++j)
#pragma unroll
      for (int e = 0; e < 16; ++e) acc[i][j][e] = 0.f;
  typedef __attribute__((ext_vector_type(4))) unsigned u32x4;
  u32x4 ra0, ra1, ra2, ra3, rb0, rb1, rb2, rb3;
  u32x4 sa0, sa1, sa2, sa3, sb0, sb1, sb2, sb3;
  const int prow = tid >> 3, pc = (tid & 7) * 8;
  const bf16_t* ap = A + (size_t)(m0 + prow) * 1024 + pc;
  const bf16_t* bp = Bt + (size_t)(n0 + prow) * 1024 + pc;
#define GLD(P, k0_)                                                                                          \
  P##a0 = *(const u32x4*)(ap + (k0_)); P##a1 = *(const u32x4*)(ap + 32 * 1024 + (k0_));                      \
  P##a2 = *(const u32x4*)(ap + 64 * 1024 + (k0_)); P##a3 = *(const u32x4*)(ap + 96 * 1024 + (k0_));         \
  P##b0 = *(const u32x4*)(bp + (k0_)); P##b1 = *(const u32x4*)(bp + 32 * 1024 + (k0_));                      \
  P##b2 = *(const u32x4*)(bp + 64 * 1024 + (k0_)); P##b3 = *(const u32x4*)(bp + 96 * 1024 + (k0_));
#define LST(P)                                                                                               \
  *(u32x4*)(As + (prow) * 72 + pc) = P##a0; *(u32x4*)(As + (prow + 32) * 72 + pc) = P##a1;                   \
  *(u32x4*)(As + (prow + 64) * 72 + pc) = P##a2; *(u32x4*)(As + (prow + 96) * 72 + pc) = P##a3;              \
  *(u32x4*)(Bs + (prow) * 72 + pc) = P##b0; *(u32x4*)(Bs + (prow + 32) * 72 + pc) = P##b1;                   \
  *(u32x4*)(Bs + (prow + 64) * 72 + pc) = P##b2; *(u32x4*)(Bs + (prow + 96) * 72 + pc) = P##b3;
  GLD(r, 0)
  __builtin_amdgcn_sched_barrier(0);
  GLD(s, 64)
  __builtin_amdgcn_sched_barrier(0);
#define GEMM_COMPUTE()                                                                                       \
  _Pragma("unroll") for (int ks = 0; ks < 4; ++ks) {                                                         \
    bf16x8 a[2], b[2];                                                                                       \
    _Pragma("unroll") for (int i = 0; i < 2; ++i) a[i] = ld8(As + (wm * 64 + i * 32 + r) * 72 + ks * 16 + h * 8); \
    _Pragma("unroll") for (int j = 0; j < 2; ++j) b[j] = ld8(Bs + (wn * 64 + j * 32 + r) * 72 + ks * 16 + h * 8); \
    _Pragma("unroll") for (int i = 0; i < 2; ++i)                                                            \
      _Pragma("unroll") for (int j = 0; j < 2; ++j) acc[i][j] = MFMA32(a[i], b[j], acc[i][j]);               \
  }
#pragma unroll 2
  for (int kt = 0; kt < 16; kt += 2) {
    __syncthreads();
    LST(r)
    __syncthreads();
    { const int k0 = (kt + 2 < 16 ? kt + 2 : 14) * 64; GLD(r, k0) }
    GEMM_COMPUTE()
    __syncthreads();
    LST(s)
    __syncthreads();
    { const int k0 = (kt + 3 < 16 ? kt + 3 : 15) * 64; GLD(s, k0) }
    GEMM_COMPUTE()
  }
#pragma unroll
  for (int i = 0; i < 2; ++i)
#pragma unroll
    for (int j = 0; j < 2; ++j)
#pragma unroll
      for (int g = 0; g < 4; ++g)
        epi(m0 + wm * 64 + i * 32 + 8 * g + 4 * h, n0 + wn * 64 + j * 32 + r, acc[i][j][4 * g], acc[i][j][4 * g + 1],
            acc[i][j][4 * g + 2], acc[i][j][4 * g + 3]);
}

DI void phase0(const Params& p, char* smem) {
  const int tid = tidx(), G = gridDim.x;
  auto do_ada = [&]() __attribute__((always_inline)) {
    float* S = (float*)smem;
    const int lane = tid & 63, w = tid >> 6;
    for (int it0 = bidx(); it0 < 2 * 24 * 9; it0 += G) {
      int it = it0;
      if ((G & 7) == 0 && G >= 512) {
        const int x = it0 & 7, slot = it0 >> 3;
        if (slot >= 54) continue;
        it = ((slot / 9) * 8 + x) * 9 + slot % 9;
      }
      const int l = it / 216, rem = it % 216, cb = rem / 9, rg = rem % 9;
      float acc[64];
#pragma unroll
      for (int i = 0; i < 64; ++i) acc[i] = 0.f;
      for (int half = 0; half < 2; ++half) {
#pragma unroll
        for (int q = 0; q < 16; ++q) {
          const int row = rg * 16 + q, rowc = row < 136 ? row : 135;
          const float* cp = (rowc < 8 ? p.c_prompt + rowc * 1024 : p.c_sample + (rowc - 8) * 1024) + half * 512;
          const float m = row < 136 ? 1.f : 0.f;
#pragma unroll
          for (int j = 0; j < 2; ++j) { const float c = cp[tid + 256 * j]; S[(tid + 256 * j) * 16 + q] = m * c / (1.f + __expf(-c)); }
        }
        __syncthreads();
        const float* wp = p.w_ada + ((size_t)l * 1024 + half * 512 + w * 128) * 6144 + cb * 256 + lane * 4;
        const float* sp = S + w * 128 * 16;
#pragma unroll 8
        for (int kk = 0; kk < 128; ++kk) {
          const float4 wv = *(const float4*)(wp + (size_t)kk * 6144);
#pragma unroll
          for (int q4 = 0; q4 < 4; ++q4) {
            const float4 s4 = *(const float4*)(sp + kk * 16 + q4 * 4);
            acc[(q4 * 4 + 0) * 4 + 0] += s4.x * wv.x; acc[(q4 * 4 + 0) * 4 + 1] += s4.x * wv.y; acc[(q4 * 4 + 0) * 4 + 2] += s4.x * wv.z; acc[(q4 * 4 + 0) * 4 + 3] += s4.x * wv.w;
            acc[(q4 * 4 + 1) * 4 + 0] += s4.y * wv.x; acc[(q4 * 4 + 1) * 4 + 1] += s4.y * wv.y; acc[(q4 * 4 + 1) * 4 + 2] += s4.y * wv.z; acc[(q4 * 4 + 1) * 4 + 3] += s4.y * wv.w;
            acc[(q4 * 4 + 2) * 4 + 0] += s4.z * wv.x; acc[(q4 * 4 + 2) * 4 + 1] += s4.z * wv.y; acc[(q4 * 4 + 2) * 4 + 2] += s4.z * wv.z; acc[(q4 * 4 + 2) * 4 + 3] += s4.z * wv.w;
            acc[(q4 * 4 + 3) * 4 + 0] += s4.w * wv.x; acc[(q4 * 4 + 3) * 4 + 1] += s4.w * wv.y; acc[(q4 * 4 + 3) * 4 + 2] += s4.w * wv.z; acc[(q4 * 4 + 3) * 4 + 3] += s4.w * wv.w;
          }
        }
        __syncthreads();
      }
      const float4 bb = *(const float4*)(p.b_ada + l * 6144 + cb * 256 + lane * 4);
#pragma unroll
      for (int pass = 0; pass < 2; ++pass) {
#pragma unroll
        for (int j = 0; j < 32; ++j) S[(w * 32 + j) * 64 + lane] = acc[pass * 32 + j];
        __syncthreads();
#pragma unroll
        for (int rr = 0; rr < 2; ++rr) {
          const int r = 2 * w + rr, row = rg * 16 + pass * 8 + r;
          float o[4];
#pragma unroll
          for (int c = 0; c < 4; ++c) o[c] = S[(0 * 32 + r * 4 + c) * 64 + lane] + S[(1 * 32 + r * 4 + c) * 64 + lane] + S[(2 * 32 + r * 4 + c) * 64 + lane] + S[(3 * 32 + r * 4 + c) * 64 + lane];
          if (row < 136) *(float4*)(p.ada + ((size_t)l * 136 + row) * 6144 + cb * 256 + lane * 4) = make_float4(o[0] + bb.x, o[1] + bb.y, o[2] + bb.z, o[3] + bb.w);
        }
        __syncthreads();
      }
    }
  };
  auto do_transposes = [&]() __attribute__((always_inline)) {
    float* T = (float*)smem;
    for (int it = bidx(); it < 3008; it += G) {
      const int l = it / 1504; int j = it % 1504;
      const float* src; bf16_t* dst; int ldsrc, kind;
      if (j < 736) { kind = 0; src = p.w_in + (size_t)l * 1024 * 2824; ldsrc = 2824; dst = p.WinT + (size_t)l * NIN * 1024; }
      else if (j < 992) { j -= 736; kind = 1; src = p.w_o + (size_t)l * 1024 * 1024; ldsrc = 1024; dst = p.WoT + (size_t)l * 1024 * 1024; }
      else { j -= 992; kind = 2; src = p.w_pq + (size_t)l * 1024 * 2048; ldsrc = 2048; dst = p.WpqT + (size_t)l * 2048 * 1024; }
      const int nt = j >> 4, kt = j & 15;
      const int tn = tid & 63, tk0 = tid >> 6;
      const int n = nt * 64 + tn;
      int e = n;
      if (kind == 0) e = n < 2048 ? n : (n < 2816 ? n + 8 : (n < 2824 ? 2048 + (n - 2816) : -1));
#pragma unroll
      for (int i = 0; i < 16; ++i) { const int k = tk0 + 4 * i; T[k * 65 + tn] = e >= 0 ? src[(size_t)(kt * 64 + k) * ldsrc + e] : 0.f; }
      __syncthreads();
      const int nn = tid >> 2, kq = (tid & 3) * 16;
      unsigned pk[8];
#pragma unroll
      for (int q = 0; q < 8; ++q) pk[q] = pack2(T[(kq + 2 * q) * 65 + nn], T[(kq + 2 * q + 1) * 65 + nn]);
      uint4* d4 = (uint4*)(dst + (size_t)(nt * 64 + nn) * 1024 + kt * 64 + kq);
      d4[0] = make_uint4(pk[0], pk[1], pk[2], pk[3]);
      d4[1] = make_uint4(pk[4], pk[5], pk[6], pk[7]);
      __syncthreads();
    }
  };
  auto do_quant = [&]() __attribute__((always_inline)) {
    const size_t nk8 = 524288 / 8;
    for (size_t i = (size_t)bidx() * 256 + tid; i < nk8; i += (size_t)G * 256) {
      const float* s = p.peer_keys + i * 8;
      const float4 a = ((const float4*)s)[0], b = ((const float4*)s)[1];
      *(uint4*)(p.keysb + i * 8) = make_uint4(pack2(a.x, a.y), pack2(a.z, a.w), pack2(b.x, b.y), pack2(b.z, b.w));
    }
    const int lane = tid & 63, w = tid >> 6;
    for (int row0 = (bidx() * 4 + w) * 2; row0 < 65536; row0 += G * 8) {
      float v[2][16];
#pragma unroll
      for (int r = 0; r < 2; ++r) {
        const int row = row0 + r; const int tab = row >> 15, le = row & 32767;
        const float* src = (tab ? p.peer_v : p.peer_u) + (size_t)le * 1024 + lane * 16;
        ld8f(src, v[r]); ld8f(src + 8, v[r] + 8);
      }
#pragma unroll
      for (int r = 0; r < 2; ++r) {
        const int row = row0 + r; const int tab = row >> 15, le = row & 32767, l = le >> 14, e = le & 16383;
        float m = 0.f;
#pragma unroll
        for (int j = 0; j < 16; ++j) m = fmaxf(m, fabsf(v[r][j]));
        m = wmax(m);
        unsigned wd[4];
        if (tab == 0) {
          const float inv = m > 0.f ? 127.f / m : 0.f;
#pragma unroll
          for (int q = 0; q < 4; ++q) {
            const int q0 = (int)rintf(v[r][4 * q] * inv), q1 = (int)rintf(v[r][4 * q + 1] * inv), q2 = (int)rintf(v[r][4 * q + 2] * inv), q3 = (int)rintf(v[r][4 * q + 3] * inv);
            wd[q] = (unsigned)(q0 & 255) | ((unsigned)(q1 & 255) << 8) | ((unsigned)(q2 & 255) << 16) | ((unsigned)(q3 & 255) << 24);
          }
          if (lane == 0) p.uscale[le] = m * (1.f / 127.f);
        } else {
          const float inv = m > 0.f ? 400.f / m : 0.f;
#pragma unroll
          for (int q = 0; q < 4; ++q) {
            int pk = __builtin_amdgcn_cvt_pk_fp8_f32(v[r][4 * q] * inv, v[r][4 * q + 1] * inv, 0, false);
            pk = __builtin_amdgcn_cvt_pk_fp8_f32(v[r][4 * q + 2] * inv, v[r][4 * q + 3] * inv, pk, true);
            wd[q] = (unsigned)pk;
          }
          if (lane == 0) p.vscale[le] = m * (1.f / 400.f);
        }
        unsigned char* dst = (tab ? p.Vq : p.Uq) + (((size_t)(l * 8 + (lane >> 3)) * 16384 + e) << 7) + (lane & 7) * 16;
        *(uint4*)dst = make_uint4(wd[0], wd[1], wd[2], wd[3]);
      }
    }
  };
  if ((bidx() / (gridDim.x >> 1)) & 1) { do_quant(); do_transposes(); do_ada(); }
  else { do_ada(); do_transposes(); do_quant(); }
}

DI void mod_store(bf16_t* dst, const float* x, const float* sc, const float* sh) {
  float s[8], t[8], o[8];
  ld8f(sc, s); ld8f(sh, t);
#pragma unroll
  for (int j = 0; j < 8; ++j) o[j] = x[j] * (1.f + s[j]) + t[j];
  *(uint4*)dst = pack8(o);
}

DI void phase1(const Params& p) {
  const int tid = tidx(), lane = tid & 63, w = tid >> 6;
  for (int tok = bidx() * 4 + w; tok < NT; tok += gridDim.x * 4) {
    const float* xr = tok < NP ? p.x_prompt + (size_t)tok * 1024 : p.x_sample + (size_t)(tok - NP) * 1024;
    const float* ad = p.ada + (size_t)cond_row(tok) * 6144;
#pragma unroll
    for (int hf = 0; hf < 2; ++hf) {
      const int c = hf * 512 + lane * 8;
      float x[8]; ld8f(xr + c, x);
      mod_store(p.hbf + (size_t)tok * 1024 + c, x, ad + 1024 + c, ad + c);
    }
  }
}

DI void tile_decode(int u, int NTL, int MTL, int& mt, int& nt) {
  const int per_mg = 8 * NTL;
  const int mg = u / per_mg; int v = u - mg * per_mg;
  const int rm = min(8, MTL - 8 * mg);
  int ng = 0;
  for (;;) { const int cn = min(8, NTL - 8 * ng); const int sz = rm * cn; if (v < sz) { mt = 8 * mg + v / cn; nt = 8 * ng + v % cn; return; } v -= sz; ++ng; }
}
template <class Epi>
DI void gemm_micro32(const bf16_t* __restrict__ A, const bf16_t* __restrict__ Bt, int m0, int n0, char* smem, const Epi& epi) {
  const int tid = tidx(), lane = tid & 63, w = tid >> 6, r = lane & 31, h = lane >> 5;
  float* red = (float*)smem;
  f32x16 acc;
#pragma unroll
  for (int e = 0; e < 16; ++e) acc[e] = 0.f;
  const bf16_t* ap = A + (size_t)(m0 + r) * 1024 + w * 256 + h * 8;
  const bf16_t* bp = Bt + (size_t)(n0 + r) * 1024 + w * 256 + h * 8;
#pragma unroll
  for (int ks = 0; ks < 16; ++ks) { const bf16x8 a = ld8(ap + ks * 16); const bf16x8 b = ld8(bp + ks * 16); acc = MFMA32(a, b, acc); }
  __syncthreads();
#pragma unroll
  for (int e = 0; e < 16; ++e) red[(w * 16 + e) * 64 + lane] = acc[e];
  __syncthreads();
  if (w == 0) {
#pragma unroll
    for (int e = 0; e < 16; ++e) acc[e] = red[e * 64 + lane] + red[(16 + e) * 64 + lane] + red[(32 + e) * 64 + lane] + red[(48 + e) * 64 + lane];
#pragma unroll
    for (int g = 0; g < 4; ++g) epi(m0 + 8 * g + 4 * h, n0 + r, acc[4 * g], acc[4 * g + 1], acc[4 * g + 2], acc[4 * g + 3]);
  }
}

template <class Epi>
DI void gemm_phase(const bf16_t* A, const bf16_t* Bt, int NTL, char* smem, const Epi& epi, bool micro_sample) {
  const int MTL = micro_sample ? 128 : 132;
  const int T = MTL * NTL, G = gridDim.x, bx = bidx();
  if ((G & 7) == 0) {
    const int x = bx & 7, slot = bx >> 3, per = G >> 3;
    const int lo = (int)(((long long)T * x) >> 3), hi = (int)(((long long)T * (x + 1)) >> 3);
    for (int u = lo + slot; u < hi; u += per) { int mt, nt; tile_decode(u, NTL, MTL, mt, nt); gemm128(A, Bt, mt * 128, nt * 128, smem, epi); }
  } else {
    for (int t = bx; t < T; t += G) { const int mt = t / NTL, nt = t % NTL; gemm128(A, Bt, mt * 128, nt * 128, smem, epi); }
  }
  if (micro_sample) {
    const int NB = NTL * 4;
    for (int t = bx; t < 16 * NB; t += G) { const int mb = t & 15, nb = t >> 4; gemm_micro32(A, Bt, NP + mb * 32, nb * 32, smem, epi); }
  }
}

struct EpiA {
  const Params& p; const float* bg;
  DI void operator()(int row4, int col, float v0, float v1, float v2, float v3) const {
    if (col < 2048) {
      const float s = col < 512 ? 0.08838834764831845f : 1.f;
      bf16_t* q = p.qkvo + (size_t)row4 * 2048 + col;
      if (!(col >= 1024 && col < 1536 && row4 < NP)) {
        q[0] = (bf16_t)f2bf(v0 * s); q[2048] = (bf16_t)f2bf(v1 * s); q[4096] = (bf16_t)f2bf(v2 * s); q[6144] = (bf16_t)f2bf(v3 * s);
      }
      if (col >= 512 && col < 1536 && row4 < NP) {
        int cc = col - 512; bf16_t* T = cc < 512 ? p.KT : p.VT; cc &= 511;
        const int hh = cc >> 7, d = cc & 127, b = row4 >> 11, t = row4 & 2047;
        *(uint2*)(T + ((size_t)((b * 4 + hh) * 128 + d)) * 2048 + t) = make_uint2(pack2(v0, v1), pack2(v2, v3));
      }
    } else if (col < 2816) {
      float* f = p.F + (size_t)row4 * FS + (col - 2048);
      f[0] = v0; f[FS] = v1; f[2 * FS] = v2; f[3 * FS] = v3;
    } else if (col < 2824) {
      const int g = col - 2816; const float bb = bg[g];
      float* f = p.F + (size_t)row4 * FS + 768 + g;
      f[0] = v0 + bb; f[FS] = v1 + bb; f[2 * FS] = v2 + bb; f[3 * FS] = v3 + bb;
    }
  }
};
DI void phaseA(const Params& p, int l, char* smem) {
  const bf16_t* Bt = p.WinT + (size_t)l * NIN * 1024;
  EpiA epi{p, p.b_gate + l * 8};
  gemm_phase(p.hbf, Bt, 23, smem, epi, false);
}

struct EpiC {
  const Params& p; const float* adaL; int l;
  DI void operator()(int row4, int col, float v0, float v1, float v2, float v3) const {
    const float* xr = (l == 0) ? (row4 < NP ? p.x_prompt + (size_t)row4 * 1024 : p.x_sample + (size_t)(row4 - NP) * 1024)
                               : p.XZ + (size_t)row4 * 1024;
    const float g1 = adaL[(size_t)cond_row(row4) * 6144 + 2048 + col];
    const float x0 = xr[col], x1 = xr[1024 + col], x2 = xr[2048 + col], x3 = xr[3072 + col];
    float* z = p.XZ + (size_t)row4 * 1024 + col;
    z[0] = ALPHA * x0 + g1 * v0; z[1024] = ALPHA * x1 + g1 * v1; z[2048] = ALPHA * x2 + g1 * v2; z[3072] = ALPHA * x3 + g1 * v3;
  }
};
DI void phaseC(const Params& p, int l, char* smem) {
  const bf16_t* Bt = p.WoT + (size_t)l * 1024 * 1024;
  EpiC epi{p, p.ada + (size_t)l * 136 * 6144, l};
  gemm_phase(p.hbf, Bt, 8, smem, epi, true);
}

struct EpiE {
  const Params& p;
  DI void operator()(int row4, int col, float v0, float v1, float v2, float v3) const {
    bf16_t* q = p.qkvo + (size_t)row4 * 2048 + col;
    q[0] = (bf16_t)f2bf(v0); q[2048] = (bf16_t)f2bf(v1); q[4096] = (bf16_t)f2bf(v2); q[6144] = (bf16_t)f2bf(v3);
  }
};
DI void phaseE(const Params& p, int l, char* smem) {
  const bf16_t* Bt = p.WpqT + (size_t)l * 2048 * 1024;
  EpiE epi{p};
  gemm_phase(p.hbf, Bt, 16, smem, epi, true);
}

DI void phaseD(const Params& p, int l) {
  const int tid = tidx(), lane = tid & 63, w = tid >> 6;
  const float* adaL = p.ada + (size_t)l * 136 * 6144;
  const float* g = p.ln1_g + l * 1024; const float* bta = p.ln1_b + l * 1024;
  for (int tok = bidx() * 4 + w; tok < NT; tok += gridDim.x * 4) {
    float* zr = p.XZ + (size_t)tok * 1024;
    const int c0 = lane * 8, c1 = 512 + lane * 8;
    float z[16]; ld8f(zr + c0, z); ld8f(zr + c1, z + 8);
    float s = 0.f;
#pragma unroll
    for (int j = 0; j < 16; ++j) s += z[j];
    const float mu = wsum(s) * (1.f / 1024.f);
    float q = 0.f;
#pragma unroll
    for (int j = 0; j < 16; ++j) { const float d = z[j] - mu; q += d * d; }
    const float rstd = rsqrtf(wsum(q) * (1.f / 1024.f) + LN_EPS);
    float gg[16], bb[16];
    ld8f(g + c0, gg); ld8f(g + c1, gg + 8); ld8f(bta + c0, bb); ld8f(bta + c1, bb + 8);
#pragma unroll
    for (int j = 0; j < 16; ++j) z[j] = (z[j] - mu) * rstd * gg[j] + bb[j];
    st8f(zr + c0, z); st8f(zr + c1, z + 8);
    const float* ad = adaL + (size_t)cond_row(tok) * 6144;
    float sc[16], sh[16], hv[16];
    ld8f(ad + 4096 + c0, sc); ld8f(ad + 4096 + c1, sc + 8); ld8f(ad + 3072 + c0, sh); ld8f(ad + 3072 + c1, sh + 8);
    float hm = 0.f;
#pragma unroll
    for (int j = 0; j < 16; ++j) { hv[j] = z[j] * (1.f + sc[j]) + sh[j]; hm = fmaxf(hm, fabsf(hv[j])); }
    *(uint4*)(p.hbf + (size_t)tok * 1024 + c0) = pack8(hv);
    *(uint4*)(p.hbf + (size_t)tok * 1024 + c1) = pack8(hv + 8);
    hm = wmax(hm);
    const float hinv = hm > 0.f ? 127.f / hm : 0.f;
    unsigned qw[4];
#pragma unroll
    for (int q = 0; q < 4; ++q) {
      const int q0 = (int)rintf(hv[4 * q] * hinv), q1 = (int)rintf(hv[4 * q + 1] * hinv), q2 = (int)rintf(hv[4 * q + 2] * hinv), q3 = (int)rintf(hv[4 * q + 3] * hinv);
      qw[q] = (unsigned)(q0 & 255) | ((unsigned)(q1 & 255) << 8) | ((unsigned)(q2 & 255) << 16) | ((unsigned)(q3 & 255) << 24);
    }
    *(uint2*)(p.xq + (size_t)tok * 1024 + c0) = make_uint2(qw[0], qw[1]);
    *(uint2*)(p.xq + (size_t)tok * 1024 + c1) = make_uint2(qw[2], qw[3]);
    if (lane == 0) p.xscale[tok] = hm * (1.f / 127.f);
  }
}

DI void mlstm_i(const Params& p, int l, int item, char* smem) {
  const int tid = tidx(), lane = tid & 63, w = tid >> 6, r = lane & 31, h = lane >> 5;
  const int bh = item >> 5, c = item & 31, b = bh >> 2, hh = bh & 3;
  const int tok0 = b * 2048 + c * 64;
  float* wc = (float*)smem;
  bf16_t* Vs = (bf16_t*)(smem + 256);
  bf16_t* Ks = Vs + 128 * 72;
  {
#pragma unroll
    for (int i = 0; i < 4; ++i) {
      const int pc = tid + 256 * i, row = pc >> 3, cc = (pc & 7) * 8;
      *(uint4*)(Vs + row * 72 + cc) = *(const uint4*)(p.VT + ((size_t)(bh * 128 + row)) * 2048 + c * 64 + cc);
      *(uint4*)(Ks + row * 72 + cc) = *(const uint4*)(p.KT + ((size_t)(bh * 128 + row)) * 2048 + c * 64 + cc);
    }
  }
  if (w == 0) {
    const float* f = p.F + (size_t)(tok0 + lane) * FS + 768;
    const float gi = f[hh], gf = f[4 + hh];
    float x = logsigmoidf_(gf);
#pragma unroll
    for (int o = 1; o < 64; o <<= 1) { const float t = __shfl_up(x, o); if (lane >= o) x += t; }
    const float bend = __shfl(x, 63);
    const float dend = bend - x + gi;
    const float mloc = wmax(dend);
    wc[lane] = __expf(dend - mloc);
    if (lane == 0) { p.scal[(bh * 32 + c) * 2] = bend; p.scal[(bh * 32 + c) * 2 + 1] = mloc; }
  }
  __syncthreads();
  const int vi = w >> 1, ki = w & 1;
  f32x16 acc[2][2];
#pragma unroll
  for (int i = 0; i < 2; ++i)
#pragma unroll
    for (int j = 0; j < 2; ++j)
#pragma unroll
      for (int e = 0; e < 16; ++e) acc[i][j][e] = 0.f;
  const bf16_t* vt = Vs + (vi * 64 + r) * 72 + h * 8;
  const bf16_t* kt = Ks + (ki * 64 + r) * 72 + h * 8;
#pragma unroll
  for (int ks = 0; ks < 4; ++ks) {
    float wv[8];
#pragma unroll
    for (int j = 0; j < 8; ++j) wv[j] = wc[ks * 16 + h * 8 + j];
    bf16x8 a[2], bb[2];
#pragma unroll
    for (int i = 0; i < 2; ++i) {
      const uint4 u = *(const uint4*)(vt + i * 32 * 72 + ks * 16);
      float x[8]; unpack8(u, x);
#pragma unroll
      for (int j = 0; j < 8; ++j) x[j] *= wv[j];
      a[i] = __builtin_bit_cast(bf16x8, pack8(x));
    }
#pragma unroll
    for (int j = 0; j < 2; ++j) bb[j] = ld8(kt + j * 32 * 72 + ks * 16);
#pragma unroll
    for (int i = 0; i < 2; ++i)
#pragma unroll
      for (int j = 0; j < 2; ++j) acc[i][j] = MFMA32(a[i], bb[j], acc[i][j]);
  }
  float* ch = p.CH + (size_t)(bh * 32 + c) * CHS;
#pragma unroll
  for (int i = 0; i < 2; ++i)
#pragma unroll
    for (int j = 0; j < 2; ++j)
#pragma unroll
      for (int e = 0; e < 16; ++e) ch[(vi * 64 + i * 32 + crow(e, h)) * 128 + ki * 64 + j * 32 + r] = acc[i][j][e];
  if (tid < 128) {
    float s = 0.f;
#pragma unroll
    for (int q = 0; q < 8; ++q) {
      float x[8]; unpack8(*(const uint4*)(Ks + tid * 72 + q * 8), x);
#pragma unroll
      for (int j = 0; j < 8; ++j) s += wc[q * 8 + j] * x[j];
    }
    ch[128 * 128 + tid] = s;
  }
  __syncthreads();
}

DI void phaseB2(const Params& p, int l) {
  const int tid = tidx();
  for (int it = bidx(); it < 32 * 17; it += gridDim.x) {
    const int bh = it / 17, sl = it % 17;
    const int e4 = sl * 256 + tid;
    if (e4 >= 4128) continue;
    float m = 0.f;
    float4 C = make_float4(0.f, 0.f, 0.f, 0.f);
    float4* base = (float4*)(p.CH + (size_t)bh * 32 * CHS) + e4;
#pragma unroll 4
    for (int c = 0; c < 32; ++c) {
      const float bend = p.scal[(bh * 32 + c) * 2], mloc = p.scal[(bh * 32 + c) * 2 + 1];
      float4* q = base + (size_t)c * (CHS / 4);
      const float4 d = *q;
      *q = C;
      if (e4 == 0) p.mstart[bh * 32 + c] = m;
      const float mn = fmaxf(bend + m, mloc);
      const float dec = __expf(bend + m - mn), sc = __expf(mloc - mn);
      C.x = dec * C.x + sc * d.x; C.y = dec * C.y + sc * d.y; C.z = dec * C.z + sc * d.z; C.w = dec * C.w + sc * d.w;
      m = mn;
    }
    if (e4 < 4096) *((float4*)(p.out + O_CP + (size_t)(l * 32 + bh) * 16384) + e4) = C;
    else *((float4*)(p.out + O_NP + (size_t)(l * 32 + bh) * 128) + (e4 - 4096)) = C;
    if (e4 == 0) p.out[O_MP + l * 32 + bh] = m;
  }
}

DI void mlstm_iii(const Params& p, int l, int item, char* smem) {
  const int tid = tidx(), lane = tid & 63, w = tid >> 6, r = lane & 31, h = lane >> 5;
  const int bh = item >> 5, c = item & 31, b = bh >> 2, hh = bh & 3;
  const int tok0 = b * 2048 + c * 64;
  bf16_t* Qs = (bf16_t*)smem;
  bf16_t* As = (bf16_t*)(smem + 17408);
  float* Hs = (float*)(smem + 26624);
  float* sv = (float*)(smem + 60416);
  float *rowoff = sv, *gsrc = sv + 64, *winter = sv + 128, *enm = sv + 192, *scl = sv + 256, *nvec = sv + 320, *mus = sv + 448, *rss = sv + 512;
  const float* ch = p.CH + (size_t)(bh * 32 + c) * CHS;
#pragma unroll
  for (int i = 0; i < 4; ++i) {
    const int pc = tid + 256 * i, row = pc >> 4, cc = (pc & 15) * 8;
    *(uint4*)(Qs + row * 136 + cc) = *(const uint4*)(p.qkvo + (size_t)(tok0 + row) * 2048 + hh * 128 + cc);
  }
  if (tid < 128) nvec[tid] = ch[128 * 128 + tid];
  if (w == 0) {
    const float* f = p.F + (size_t)(tok0 + lane) * FS + 768;
    const float gi = f[hh], gf = f[4 + hh];
    float x = logsigmoidf_(gf);
#pragma unroll
    for (int o = 1; o < 64; o <<= 1) { const float t = __shfl_up(x, o); if (lane >= o) x += t; }
    const float u = gi - x;
    float pm = u;
#pragma unroll
    for (int o = 1; o < 64; o <<= 1) { const float t = __shfl_up(pm, o); if (lane >= o) pm = fmaxf(pm, t); }
    const float mc = p.mstart[bh * 32 + c];
    const float inter = x + mc;
    const float mt = fmaxf(inter, x + pm);
    rowoff[lane] = x - mt; gsrc[lane] = u; winter[lane] = __expf(inter - mt); enm[lane] = __expf(-mt);
  }
  __syncthreads();
  {
    const int ti = w >> 1, si = w & 1;
    f32x16 acc;
#pragma unroll
    for (int e = 0; e < 16; ++e) acc[e] = 0.f;
    if (si <= ti) {
      const bf16_t* kp = p.qkvo + (size_t)(tok0 + si * 32 + r) * 2048 + 512 + hh * 128 + h * 8;
#pragma unroll
      for (int ks = 0; ks < 8; ++ks) {
        const bf16x8 a = ld8(Qs + (ti * 32 + r) * 136 + ks * 16 + h * 8);
        const bf16x8 bb = ld8(kp + ks * 16);
        acc = MFMA32(a, bb, acc);
      }
    }
    const int s = si * 32 + r;
    const float gs = gsrc[s];
#pragma unroll
    for (int e = 0; e < 16; ++e) {
      const int t = ti * 32 + crow(e, h);
      const float v = (s <= t) ? __expf(rowoff[t] + gs) * acc[e] : 0.f;
      As[t * 72 + s] = (bf16_t)f2bf(v);
    }
  }
  __syncthreads();
  f32x16 acc1[2], acc2[2];
#pragma unroll
  for (int i = 0; i < 2; ++i)
#pragma unroll
    for (int e = 0; e < 16; ++e) { acc1[i][e] = 0.f; acc2[i][e] = 0.f; }
  {
    const bf16_t* vt = p.VT + ((size_t)(bh * 128 + w * 32 + r)) * 2048 + c * 64 + h * 8;
#pragma unroll 2
    for (int ks = 0; ks < 4; ++ks) {
      const bf16x8 bb = ld8(vt + ks * 16);
#pragma unroll
      for (int i = 0; i < 2; ++i) { const bf16x8 a = ld8(As + (i * 32 + r) * 72 + ks * 16 + h * 8); acc1[i] = MFMA32(a, bb, acc1[i]); }
    }
    const float* cp = ch + (size_t)(w * 32 + r) * 128 + h * 8;
#pragma unroll 4
    for (int ks = 0; ks < 8; ++ks) {
      float x[8]; ld8f(cp + ks * 16, x);
      const bf16x8 bb = __builtin_bit_cast(bf16x8, pack8(x));
#pragma unroll
      for (int i = 0; i < 2; ++i) { const bf16x8 a = ld8(Qs + (i * 32 + r) * 136 + ks * 16 + h * 8); acc2[i] = MFMA32(a, bb, acc2[i]); }
    }
  }
  if (tid < 64) {
    const int t = tid;
    float di = 0.f;
#pragma unroll
    for (int q = 0; q < 8; ++q) { float x[8]; unpack8(*(const uint4*)(As + t * 72 + q * 8), x);
#pragma unroll
      for (int j = 0; j < 8; ++j) di += x[j]; }
    float nq = 0.f;
#pragma unroll 2
    for (int q = 0; q < 16; ++q) { float x[8]; unpack8(*(const uint4*)(Qs + t * 136 + q * 8), x);
#pragma unroll
      for (int j = 0; j < 8; ++j) nq += x[j] * nvec[q * 8 + j]; }
    const float den = di + winter[t] * nq;
    scl[t] = 1.f / fmaxf(fabsf(den), enm[t]);
  }
  __syncthreads();
#pragma unroll
  for (int i = 0; i < 2; ++i)
#pragma unroll
    for (int e = 0; e < 16; ++e) {
      const int t = i * 32 + crow(e, h);
      Hs[t * 132 + w * 32 + r] = (acc1[i][e] + winter[t] * acc2[i][e]) * scl[t];
    }
  __syncthreads();
  {
    const int t = tid >> 2, part = tid & 3;
    float s = 0.f;
#pragma unroll
    for (int j = 0; j < 32; ++j) s += Hs[t * 132 + j * 4 + part];
    s += __shfl_xor(s, 1); s += __shfl_xor(s, 2);
    const float mu = s * (1.f / 128.f);
    float q = 0.f;
#pragma unroll
    for (int j = 0; j < 32; ++j) { const float d = Hs[t * 132 + j * 4 + part] - mu; q += d * d; }
    q += __shfl_xor(q, 1); q += __shfl_xor(q, 2);
    if (part == 0) { mus[t] = mu; rss[t] = rsqrtf(q * (1.f / 128.f) + LN_EPS); }
  }
  __syncthreads();
  const float* mg = p.mh_g + l * 512 + hh * 128;
#pragma unroll
  for (int i = 0; i < 4; ++i) {
    const int pc = tid + 256 * i, t = pc >> 4, v0 = (pc & 15) * 8;
    float o[8]; unpack8(*(const uint4*)(p.qkvo + (size_t)(tok0 + t) * 2048 + 1536 + hh * 128 + v0), o);
    float gg[8]; ld8f(mg + v0, gg);
    const float mu = mus[t], rs = rss[t];
    float y[8];
#pragma unroll
    for (int j = 0; j < 8; ++j) y[j] = sigmoidf_(o[j]) * ((Hs[t * 132 + v0 + j] - mu) * rs * gg[j]);
    *(uint4*)(p.hbf + (size_t)(tok0 + t) * 1024 + hh * 128 + v0) = pack8(y);
  }
  __syncthreads();
}

DI void mlstm_sample(const Params& p, int l, int item, char* smem) {
  const int tid = tidx(), lane = tid & 63, w = tid >> 6;
  const int b = item >> 2, hh = item & 3;
  const int tok0 = NP + b * 4;
  float* qs = (float*)smem;
  float* ks = qs + 512;
  float* vs = ks + 512;
  float* hs = vs + 512;
  float* ns = hs + 512;
  float* qk = ns + 128;
  float* nq = qk + 16;
  const size_t sidx = (size_t)(l * 128 + b) * 4 + hh;
  for (int i = tid; i < 1536; i += 256) {
    const int m = i >> 9, t = (i >> 7) & 3, d = i & 127;
    qs[i] = bf2f(p.qkvo[(size_t)(tok0 + t) * 2048 + m * 512 + hh * 128 + d]);
  }
  if (tid < 128) ns[tid] = p.stN[sidx * 128 + tid];
  __syncthreads();
  {
    const int dp = tid >> 3, part = tid & 7;
    if (dp < 20) {
      const float* x = qs + (dp < 16 ? (dp >> 2) : (dp - 16)) * 128 + part * 16;
      const float* y = (dp < 16 ? ks + (dp & 3) * 128 : ns) + part * 16;
      float a = 0.f;
#pragma unroll
      for (int d = 0; d < 16; ++d) a += x[d] * y[d];
      a += __shfl_xor(a, 1); a += __shfl_xor(a, 2); a += __shfl_xor(a, 4);
      if (part == 0) { if (dp < 16) qk[dp] = a; else nq[dp - 16] = a; }
    }
  }
  float ig[4], bc[4];
  {
    float run = 0.f;
#pragma unroll
    for (int t = 0; t < 4; ++t) { const float* f = p.F + (size_t)(tok0 + t) * FS + 768; ig[t] = f[hh]; run += logsigmoidf_(f[4 + hh]); bc[t] = run; }
  }
  const float mprev = p.stM[sidx];
  float mt[4], wint[4];
#pragma unroll
  for (int t = 0; t < 4; ++t) {
    float mm = bc[t] + mprev;
#pragma unroll
    for (int s = 0; s < 4; ++s) if (s <= t) mm = fmaxf(mm, bc[t] - bc[s] + ig[s]);
    mt[t] = mm; wint[t] = __expf(bc[t] + mprev - mm);
  }
  const float bend = bc[3];
  float mnew = bend + mprev;
#pragma unroll
  for (int s = 0; s < 4; ++s) mnew = fmaxf(mnew, bend - bc[s] + ig[s]);
  float wcs[4];
#pragma unroll
  for (int s = 0; s < 4; ++s) wcs[s] = __expf(bend - bc[s] + ig[s] - mnew);
  const float dec = __expf(bend + mprev - mnew);
  __syncthreads();
  float a[4][4], den[4];
#pragma unroll
  for (int t = 0; t < 4; ++t) {
    float ds = 0.f;
#pragma unroll
    for (int s = 0; s < 4; ++s) { a[t][s] = (s <= t) ? __expf(bc[t] - bc[s] + ig[s] - mt[t]) * qk[t * 4 + s] : 0.f; ds += a[t][s]; }
    den[t] = ds + wint[t] * nq[t];
  }
  {
    const int k4i = tid & 31, rgrp = tid >> 5, l5 = lane & 31;
    const bool bb4 = l5 & 16, bb3 = l5 & 8;
    float4 q4[4], k4[4];
#pragma unroll
    for (int t = 0; t < 4; ++t) { q4[t] = *(const float4*)(qs + t * 128 + k4i * 4); k4[t] = *(const float4*)(ks + t * 128 + k4i * 4); }
    const float wint_t = bb4 ? (bb3 ? wint[3] : wint[2]) : (bb3 ? wint[1] : wint[0]);
    const float den_t = bb4 ? (bb3 ? den[3] : den[2]) : (bb3 ? den[1] : den[0]);
    const float mt_t = bb4 ? (bb3 ? mt[3] : mt[2]) : (bb3 ? mt[1] : mt[0]);
    const float invd_t = 1.f / fmaxf(fabsf(den_t), __expf(-mt_t));
    float a_t[4];
#pragma unroll
    for (int s = 0; s < 4; ++s) a_t[s] = bb4 ? (bb3 ? a[3][s] : a[2][s]) : (bb3 ? a[1][s] : a[0][s]);
    const int tsel = (bb4 ? 2 : 0) + (bb3 ? 1 : 0);
    const float* cbase = p.stC + sidx * 16384 + k4i * 4;
    float* obase = p.out + O_CS + sidx * 16384 + k4i * 4;
#pragma unroll 4
    for (int j = 0; j < 16; ++j) {
      const int vrow = rgrp + 8 * j;
      const float4 cv = *(const float4*)(cbase + vrow * 128);
      const float v0 = vs[vrow], v1 = vs[128 + vrow], v2 = vs[256 + vrow], v3 = vs[384 + vrow];
      float pt[4];
#pragma unroll
      for (int t = 0; t < 4; ++t) pt[t] = cv.x * q4[t].x + cv.y * q4[t].y + cv.z * q4[t].z + cv.w * q4[t].w;
      const float w0 = wcs[0] * v0, w1 = wcs[1] * v1, w2 = wcs[2] * v2, w3 = wcs[3] * v3;
      float4 cn;
      cn.x = dec * cv.x + w0 * k4[0].x + w1 * k4[1].x + w2 * k4[2].x + w3 * k4[3].x;
      cn.y = dec * cv.y + w0 * k4[0].y + w1 * k4[1].y + w2 * k4[2].y + w3 * k4[3].y;
      cn.z = dec * cv.z + w0 * k4[0].z + w1 * k4[1].z + w2 * k4[2].z + w3 * k4[3].z;
      cn.w = dec * cv.w + w0 * k4[0].w + w1 * k4[1].w + w2 * k4[2].w + w3 * k4[3].w;
      *(float4*)(obase + vrow * 128) = cn;
      float r2[2];
#pragma unroll
      for (int jj = 0; jj < 2; ++jj) { const float x = pt[jj], y = pt[jj + 2]; r2[jj] = (bb4 ? y : x) + __shfl_xor(bb4 ? x : y, 16); }
      float r1 = (bb3 ? r2[1] : r2[0]) + __shfl_xor(bb3 ? r2[0] : r2[1], 8);
      r1 += __shfl_xor(r1, 4); r1 += __shfl_xor(r1, 2); r1 += __shfl_xor(r1, 1);
      if ((l5 & 7) == 0) hs[tsel * 128 + vrow] = (wint_t * r1 + a_t[0] * v0 + a_t[1] * v1 + a_t[2] * v2 + a_t[3] * v3) * invd_t;
    }
  }
  if (tid < 128) {
    float nn = dec * ns[tid];
#pragma unroll
    for (int s = 0; s < 4; ++s) nn += wcs[s] * ks[s * 128 + tid];
    p.out[O_NS + sidx * 128 + tid] = nn;
  }
  if (tid == 0) p.out[O_MS + sidx] = mnew;
  __syncthreads();
  {
    const int t = w;
    const float h0 = hs[t * 128 + lane], h1 = hs[t * 128 + 64 + lane];
    const float mu = wsum(h0 + h1) * (1.f / 128.f);
    const float d0 = h0 - mu, d1 = h1 - mu;
    const float rs = rsqrtf(wsum(d0 * d0 + d1 * d1) * (1.f / 128.f) + LN_EPS);
    const float* mg = p.mh_g + l * 512 + hh * 128;
    const bf16_t* op = p.qkvo + (size_t)(tok0 + t) * 2048 + 1536 + hh * 128;
    bf16_t* yp = p.hbf + (size_t)(tok0 + t) * 1024 + hh * 128;
    yp[lane] = (bf16_t)f2bf(sigmoidf_(bf2f(op[lane])) * d0 * rs * mg[lane]);
    yp[64 + lane] = (bf16_t)f2bf(sigmoidf_(bf2f(op[64 + lane])) * d1 * rs * mg[64 + lane]);
  }
  __syncthreads();
}

DI void sgu_prompt(const Params& p, int l, int item, char* smem) {
  const int tid = tidx(), lane = tid & 63, w = tid >> 6, r = lane & 31, h = lane >> 5;
  const int g = item & 3, bc = item >> 2;
  const int tok0 = bc * 128;
  bf16_t* Ws = (bf16_t*)smem;
  bf16_t* Vt = (bf16_t*)(smem + 34816);
  {
    const int s = tid >> 1, hf = tid & 1;
    const float* vp = p.F + (size_t)(tok0 + s) * FS + 256 + g * 64 + hf * 32;
    float x[32];
#pragma unroll
    for (int q = 0; q < 4; ++q) ld8f(vp + q * 8, x + q * 8);
    float sm = 0.f;
#pragma unroll
    for (int j = 0; j < 32; ++j) sm += x[j];
    sm += __shfl_xor(sm, 1);
    const float mu = sm * (1.f / 64.f);
    float q2 = 0.f;
#pragma unroll
    for (int j = 0; j < 32; ++j) { const float d = x[j] - mu; q2 += d * d; }
    q2 += __shfl_xor(q2, 1);
    const float rs = rsqrtf(q2 * (1.f / 64.f) + LN_EPS);
    const float* gp = p.sgu_g + l * 256 + g * 64 + hf * 32;
    const float* bp = p.sgu_b + l * 256 + g * 64 + hf * 32;
#pragma unroll
    for (int j = 0; j < 32; ++j) Vt[(hf * 32 + j) * 136 + s] = (bf16_t)f2bf((x[j] - mu) * rs * gp[j] + bp[j]);
  }
  {
    const float* wsp = p.w_s + (size_t)(l * 4 + g) * 16384;
#pragma unroll
    for (int i = 0; i < 16; ++i) {
      const int e4 = tid + 256 * i, t = e4 >> 5, s0 = (e4 & 31) * 4;
      const float4 v = *(const float4*)(wsp + t * 128 + s0);
      const float a0 = s0 <= t ? v.x : 0.f, a1 = s0 + 1 <= t ? v.y : 0.f, a2 = s0 + 2 <= t ? v.z : 0.f, a3 = s0 + 3 <= t ? v.w : 0.f;
      *(uint2*)(Ws + t * 136 + s0) = make_uint2(pack2(a0, a1), pack2(a2, a3));
    }
  }
  __syncthreads();
  f32x16 acc[2];
#pragma unroll
  for (int j = 0; j < 2; ++j)
#pragma unroll
    for (int e = 0; e < 16; ++e) acc[j][e] = 0.f;
#pragma unroll
  for (int ks = 0; ks < 8; ++ks) {
    const bf16x8 a = ld8(Ws + (w * 32 + r) * 136 + ks * 16 + h * 8);
#pragma unroll
    for (int j = 0; j < 2; ++j) { const bf16x8 bb = ld8(Vt + (j * 32 + r) * 136 + ks * 16 + h * 8); acc[j] = MFMA32(a, bb, acc[j]); }
  }
  const float* bsp = p.b_s + (l * 4 + g) * 128;
#pragma unroll
  for (int j = 0; j < 2; ++j)
#pragma unroll
    for (int e = 0; e < 16; ++e) {
      const int t = w * 32 + crow(e, h), d = j * 32 + r;
      const float u = p.F[(size_t)(tok0 + t) * FS + g * 64 + d];
      p.hbf[(size_t)(tok0 + t) * 1024 + 512 + g * 64 + d] = (bf16_t)f2bf(u * (acc[j][e] + bsp[t]));
    }
  __syncthreads();
}

DI void sgu_sample(const Params& p, int l, int b) {
  const int tid = tidx(), g = tid >> 6;
  const int tok0 = NP + b * 4;
  float vn[4];
  const float gg = p.sgu_g[l * 256 + tid], bb = p.sgu_b[l * 256 + tid];
#pragma unroll
  for (int t = 0; t < 4; ++t) {
    const float x = p.F[(size_t)(tok0 + t) * FS + 256 + tid];
    const float mu = wsum(x) * (1.f / 64.f);
    const float d = x - mu;
    const float rs = rsqrtf(wsum(d * d) * (1.f / 64.f) + LN_EPS);
    vn[t] = d * rs * gg + bb;
    p.out[O_SV + ((size_t)(l * 128 + b) * 4 + t) * 256 + tid] = vn[t];
  }
  const float* wsp = p.w_s + (size_t)(l * 4 + g) * 16384;
  const float* bsp = p.b_s + (l * 4 + g) * 128;
#pragma unroll
  for (int t = 0; t < 4; ++t) {
    float mix = bsp[t];
#pragma unroll
    for (int s = 0; s < 4; ++s) if (s <= t) mix += wsp[t * 128 + s] * vn[s];
    const float u = p.F[(size_t)(tok0 + t) * FS + tid];
    p.hbf[(size_t)(tok0 + t) * 1024 + 512 + tid] = (bf16_t)f2bf(u * mix);
  }
}

DI void pool_tail(const Params& p, int l, int tokbase, const float* P, int tid) {
  const int g = tid >> 6, e = tid & 63;
  float acc[16];
#pragma unroll
  for (int i = 0; i < 16; ++i) acc[i] = 0.f;
  const float* wp = p.w_pool + (size_t)(l * 4 + g) * 4096 + e;
#pragma unroll 4
  for (int d4 = 0; d4 < 16; ++d4) {
    const float w0 = wp[(d4 * 4) * 64], w1 = wp[(d4 * 4 + 1) * 64], w2 = wp[(d4 * 4 + 2) * 64], w3 = wp[(d4 * 4 + 3) * 64];
#pragma unroll
    for (int tt = 0; tt < 16; ++tt) {
      const float4 p4 = *(const float4*)(P + tt * 256 + g * 64 + d4 * 4);
      acc[tt] += p4.x * w0 + p4.y * w1 + p4.z * w2 + p4.w * w3;
    }
  }
  const float ps = p.pool_scale[l * 256 + tid];
#pragma unroll
  for (int tt = 0; tt < 16; ++tt) p.hbf[(size_t)(tokbase + tt) * 1024 + 768 + tid] = (bf16_t)f2bf(acc[tt] * ps);
}

DI void pool_prompt(const Params& p, int l, int item, char* smem) {
  const int tid = tidx();
  const int b = item >> 7, t0 = (item & 127) * 16;
  float* X = (float*)smem;
  float* P = X + 31 * 256;
#pragma unroll
  for (int i = 0; i < 31; ++i) { const int t = t0 - 15 + i; const int tc = t >= 0 ? t : 0; const float v = p.F[(size_t)(b * 2048 + tc) * FS + 512 + tid]; X[i * 256 + tid] = t >= 0 ? v : 0.f; }
  __syncthreads();
  const int g = tid >> 6, wsz = 2 << g;
#pragma unroll 4
  for (int tt = 0; tt < 16; ++tt) {
    float s = 0.f;
#pragma unroll
    for (int j = 0; j < 16; ++j) { const float xv = X[(15 + tt - j) * 256 + tid]; s += j < wsz ? xv : 0.f; }
    const int pos = t0 + tt;
    const float cnt = (float)(pos + 1 < wsz ? pos + 1 : wsz);
    P[tt * 256 + tid] = s / cnt - X[(15 + tt) * 256 + tid];
  }
  if (t0 == 2032)
    for (int tt = 1; tt < 16; ++tt) p.out[O_PP + ((size_t)(l * 8 + b) * 15 + (tt - 1)) * 256 + tid] = X[(15 + tt) * 256 + tid];
  __syncthreads();
  pool_tail(p, l, b * 2048 + t0, P, tid);
  __syncthreads();
}

DI void pool_sample(const Params& p, int l, int item, char* smem) {
  const int tid = tidx();
  const int b0 = item * 4;
  float* X = (float*)smem;
  float* P = X + 31 * 256;
  const int g = tid >> 6, wsz = 2 << g;
  for (int bi = 0; bi < 4; ++bi) {
    const int b = b0 + bi;
#pragma unroll
    for (int i = 0; i < 19; ++i)
      X[i * 256 + tid] = i < 15 ? p.stPool[((size_t)(l * 128 + b) * 15 + i) * 256 + tid] : p.F[(size_t)(NP + b * 4 + (i - 15)) * FS + 512 + tid];
    __syncthreads();
#pragma unroll
    for (int t = 0; t < 4; ++t) {
      float s = 0.f;
#pragma unroll
      for (int j = 0; j < 16; ++j) { const float xv = X[(15 + t - j) * 256 + tid]; s += j < wsz ? xv : 0.f; }
      P[(bi * 4 + t) * 256 + tid] = s / (float)wsz - X[(15 + t) * 256 + tid];
    }
#pragma unroll
    for (int i = 0; i < 15; ++i) p.out[O_PS + ((size_t)(l * 128 + b) * 15 + i) * 256 + tid] = X[(4 + i) * 256 + tid];
    __syncthreads();
  }
  pool_tail(p, l, NP + b0 * 4, P, tid);
  __syncthreads();
}

DI void phaseB1(const Params& p, int l, char* smem) {
  const int G = gridDim.x, bx = bidx();
  for (int it = bx; it < 512; it += G) mlstm_sample(p, l, it, smem);
  for (int it = (bx + 256) % G; it < 1024; it += G) mlstm_i(p, l, it, smem);
  for (int it = bx; it < 512; it += G) sgu_prompt(p, l, it, smem);
  for (int it = (bx + 128) % G; it < 128; it += G) sgu_sample(p, l, it);
  for (int it = bx; it < 1024; it += G) pool_prompt(p, l, it, smem);
  for (int it = (bx + 64) % G; it < 32; it += G) pool_sample(p, l, it, smem);
}

DI void phaseB3(const Params& p, int l, char* smem) {
  for (int it = bidx(); it < 1024; it += gridDim.x) mlstm_iii(p, l, it, smem);
}

__device__ const unsigned kCandWords[16] = {0x03020100u, 0x07060504u, 0x0b0a0908u, 0x0f0e0d0cu, 0x13121110u, 0x17161514u, 0x23222120u, 0x32313024u,
                                            0x42414033u, 0x61605150u, 0x90807170u, 0xd0c0b0a0u, 0xfffff0e0u, 0xffffffffu, 0xffffffffu, 0xffffffffu};

DI void ce_(int& a, int& b, bool desc) { const int hi = max(a, b), lo = min(a, b); a = desc ? hi : lo; b = desc ? lo : hi; }
DI void bitonic_sort16(int* v) {
#pragma unroll
  for (int k = 2; k <= 16; k <<= 1) {
#pragma unroll
    for (int j = k >> 1; j >= 1; j >>= 1) {
#pragma unroll
      for (int i = 0; i < 16; ++i) { const int l = i ^ j; if (l > i) ce_(v[i], v[l], (i & k) == 0); }
    }
  }
}
DI void bitonic_merge16(int* v) {
#pragma unroll
  for (int j = 8; j >= 1; j >>= 1) {
#pragma unroll
    for (int i = 0; i < 16; ++i) { const int l = i ^ j; if (l > i) ce_(v[i], v[l], true); }
  }
}

DI void phaseF(const Params& p, int l, char* smem) {
  const int tid = tidx(), lane = tid & 63, w = tid >> 6, r = lane & 31, h = lane >> 5;
  float* Sc = (float*)smem;
  float* ls = (float*)(smem + 33024);
  int* li = (int*)(smem + 41472);
  int* jp = (int*)(smem + 49920);
  for (int it = bidx(); it < 264 * 8; it += gridDim.x) {
    const int tile = it >> 3, hd = it & 7;
    const int tok0 = tile * 64;
    for (int pp = 0; pp < 2; ++pp) {
      f32x16 acc[2];
#pragma unroll
      for (int i = 0; i < 2; ++i)
#pragma unroll
        for (int e = 0; e < 16; ++e) acc[i][e] = 0.f;
      const bf16_t* qp = p.qkvo + (size_t)(tok0 + r) * 2048 + (hd * 2 + pp) * 128 + h * 8;
      const bf16_t* kp = p.keysb + ((size_t)((l * 8 + hd) * 2 + pp) * 128 + w * 32 + r) * 128 + h * 8;
#pragma unroll
      for (int ks = 0; ks < 8; ++ks) {
        const bf16x8 bb = ld8(kp + ks * 16);
#pragma unroll
        for (int i = 0; i < 2; ++i) { const bf16x8 a = ld8(qp + (size_t)i * 32 * 2048 + ks * 16); acc[i] = MFMA32(a, bb, acc[i]); }
      }
#pragma unroll
      for (int i = 0; i < 2; ++i)
#pragma unroll
        for (int e = 0; e < 16; ++e) Sc[(i * 32 + crow(e, h)) * 129 + w * 32 + r] = acc[i][e];
      __syncthreads();
      {
        const int row = tid >> 2, part = tid & 3;
        int va[16], vb[16];
#pragma unroll
        for (int j = 0; j < 16; ++j) {
          const int fa = __float_as_int(Sc[row * 129 + j * 4 + part]);
          const int ma = fa ^ ((fa >> 31) & 0x7fffffff);
          va[j] = (ma & ~127) | (127 - (j * 4 + part));
          const int fb = __float_as_int(Sc[row * 129 + (j + 16) * 4 + part]);
          const int mb = fb ^ ((fb >> 31) & 0x7fffffff);
          vb[j] = (mb & ~127) | (127 - ((j + 16) * 4 + part));
        }
        bitonic_sort16(va); bitonic_sort16(vb);
        int vc[16];
#pragma unroll
        for (int i = 0; i < 16; ++i) vc[i] = max(va[i], vb[15 - i]);
        bitonic_merge16(vc);
#pragma unroll
        for (int o = 1; o < 4; o <<= 1) {
          int vp[16];
#pragma unroll
          for (int i = 0; i < 16; ++i) vp[i] = (o == 1) ? dpp_xor1(vc[15 - i]) : dpp_xor2(vc[15 - i]);
#pragma unroll
          for (int i = 0; i < 16; ++i) vc[i] = max(vc[i], vp[i]);
          bitonic_merge16(vc);
        }
        if (part == 0) {
#pragma unroll
          for (int i = 0; i < 16; ++i) {
            const int mono = vc[i] & ~127;
            ls[row * 33 + pp * 16 + i] = __int_as_float(mono ^ ((mono >> 31) & 0x7fffffff));
            li[row * 33 + pp * 16 + i] = 127 - (vc[i] & 127);
          }
        }
      }
      __syncthreads();
    }
    {
      const int row = tid >> 2, part = tid & 3;
      int vc[16];
#pragma unroll
      for (int k = 0; k < 16; ++k) {
        const unsigned cw = kCandWords[k];
        const unsigned ij = (cw >> (8 * part)) & 0xffu;
        const int c = 4 * k + part;
        int key = (int)0x80000000;
        if (ij != 0xffu) {
          const float v = ls[row * 33 + (ij >> 4)] + ls[row * 33 + 16 + (ij & 15)];
          const int fb = __float_as_int(v);
          const int mono = fb ^ ((fb >> 31) & 0x7fffffff);
          key = (mono & ~63) | (63 - c);
        }
        vc[k] = key;
      }
      bitonic_sort16(vc);
#pragma unroll
      for (int o = 1; o < 4; o <<= 1) {
        int vp[16];
#pragma unroll
        for (int i = 0; i < 16; ++i) vp[i] = (o == 1) ? dpp_xor1(vc[15 - i]) : dpp_xor2(vc[15 - i]);
#pragma unroll
        for (int i = 0; i < 16; ++i) vc[i] = max(vc[i], vp[i]);
        bitonic_merge16(vc);
      }
      float sc[16];
      float sum = 0.f;
#pragma unroll
      for (int st = 0; st < 16; ++st) {
        const int mono = vc[st] & ~63;
        sc[st] = __int_as_float(mono ^ ((mono >> 31) & 0x7fffffff));
      }
      const float s0 = sc[0];
#pragma unroll
      for (int st = 0; st < 16; ++st) { sc[st] = __expf(sc[st] - s0); sum += sc[st]; }
      const float inv = 1.f / sum;
      int oid[4]; float og[4];
#pragma unroll
      for (int q = 0; q < 4; ++q) {
        const int kq = part == 0 ? vc[q] : (part == 1 ? vc[4 + q] : (part == 2 ? vc[8 + q] : vc[12 + q]));
        const float gq = part == 0 ? sc[q] : (part == 1 ? sc[4 + q] : (part == 2 ? sc[8 + q] : sc[12 + q]));
        const int c = 63 - (kq & 63);
        const unsigned ij = (kCandWords[c >> 2] >> (8 * (c & 3))) & 0xffu;
        oid[q] = li[row * 33 + (ij >> 4)] * 128 + li[row * 33 + 16 + (ij & 15)];
        og[q] = gq * inv;
      }
      *(int4*)(p.pidx + (size_t)(tok0 + row) * 128 + hd * 16 + part * 4) = make_int4(oid[0], oid[1], oid[2], oid[3]);
      *(float4*)(p.pgate + (size_t)(tok0 + row) * 128 + hd * 16 + part * 4) = make_float4(og[0], og[1], og[2], og[3]);
    }
    __syncthreads();
  }
}

constexpr int GT = 12;
DI void phaseG(const Params& p, int l, char* smem) {
  const int tid = tidx(), lane = tid & 63, w = tid >> 6, g = lane >> 3, sub = lane & 7;
  const int TW = gridDim.x * 4, wg = bidx() * 4 + w;
  const unsigned char* Uq = p.Uq + (size_t)l * 16384 * 1024;
  const unsigned char* Vq = p.Vq + (size_t)l * 16384 * 1024;
  const float* usc = p.uscale + l * 16384; const float* vsc = p.vscale + l * 16384;
  const float* adaL = p.ada + (size_t)l * 136 * 6144;
  const float* g2g = p.ln2_g + l * 1024; const float* g2b = p.ln2_b + l * 1024;
  float* dstbase = (l == 1) ? p.out : p.XZ;
  float* Y = p.F;
  int* spk0 = (int*)smem + w * (4 * GT * 64) + lane;
  int* spk1 = spk0 + GT * 64;
  const int* gpk0 = (const int*)smem + w * (4 * GT * 64) + 8 * g;
  const int* gpk1 = gpk0 + GT * 64;
  int* sa0 = spk0 + 2 * GT * 64;
  int* sa1 = spk0 + 3 * GT * 64;
  const unsigned sub16 = (unsigned)sub << 4;
  const bool b2 = sub & 4, b1 = sub & 2, b0 = sub & 1;
  const bool b5 = g & 4, b4 = g & 2, b3 = g & 1;
  for (int base = wg; base < NT; base += TW * GT) {
    const int nt = min(GT, (NT - base + TW - 1) / TW);
    for (int i = 0; i < nt; ++i) {
      const int tok = base + i * TW;
      spk0[i * 64] = p.pidx[(size_t)tok * 128 + 8 * sub + g];
      spk1[i * 64] = p.pidx[(size_t)tok * 128 + 64 + 8 * sub + g];
      sa0[i * 64] = 0; sa1[i * 64] = 0;
    }
    const int nsteps = 8 * nt;
#define G_NEXT(c_, i_, cn_, in_) { in_ = (i_) + 1; cn_ = (c_); if (in_ == nt) { in_ = 0; cn_ = (c_) + 1; } if (cn_ == 8) { cn_ = (c_); in_ = (i_); } }
#define U_GATHER(BUF, XS, c_, i_)                                                                            \
    { const unsigned char* tb_ = Uq + (size_t)(c_) * 16384 * 128;                                            \
      XS = *(const uint4*)(p.xq + (size_t)(base + (i_) * TW) * 1024 + (c_) * 128 + sub * 16);                \
      const int4 ka_ = *(const int4*)(gpk0 + (i_) * 64), kb_ = *(const int4*)(gpk0 + (i_) * 64 + 4);         \
      const int4 kc_ = *(const int4*)(gpk1 + (i_) * 64), kd_ = *(const int4*)(gpk1 + (i_) * 64 + 4);         \
      const int kk_[16] = {ka_.x, ka_.y, ka_.z, ka_.w, kb_.x, kb_.y, kb_.z, kb_.w, kc_.x, kc_.y, kc_.z, kc_.w, kd_.x, kd_.y, kd_.z, kd_.w}; \
      _Pragma("unroll") for (int ld = 0; ld < 16; ++ld) {                                                    \
        const unsigned e_ = (unsigned)kk_[ld] & 0xffffu;                                                     \
        BUF[ld] = *(const uint4*)(tb_ + ((e_ << 7) | sub16)); } }
#define U_COMPUTE(BUF, XS, i_)                                                                               \
    {                                                                                                        \
      int t[16];                                                                                             \
      _Pragma("unroll") for (int ld = 0; ld < 16; ++ld) {                                                    \
        int v = __builtin_amdgcn_sdot4((int)BUF[ld].x, (int)XS.x, 0, false);                                 \
        v = __builtin_amdgcn_sdot4((int)BUF[ld].y, (int)XS.y, v, false);                                     \
        v = __builtin_amdgcn_sdot4((int)BUF[ld].z, (int)XS.z, v, false);                                     \
        v = __builtin_amdgcn_sdot4((int)BUF[ld].w, (int)XS.w, v, false); t[ld] = v; }                        \
      int wsum2[2];                                                                                          \
      _Pragma("unroll") for (int k = 0; k < 2; ++k) {                                                        \
        int u4[4], v2[2];                                                                                    \
        _Pragma("unroll") for (int j = 0; j < 4; ++j) { const int x = t[8 * k + j], y = t[8 * k + j + 4]; u4[j] = (b2 ? y : x) + dpp_xor4(b2 ? x : y); } \
        _Pragma("unroll") for (int j = 0; j < 2; ++j) { const int x = u4[j], y = u4[j + 2]; v2[j] = (b1 ? y : x) + dpp_xor2(b1 ? x : y); } \
        { const int x = v2[0], y = v2[1]; wsum2[k] = (b0 ? y : x) + dpp_xor1(b0 ? x : y); } }               \
      sa0[(i_) * 64] += wsum2[0]; sa1[(i_) * 64] += wsum2[1];                                                \
    }
    {
      uint4 A[16]; uint4 xa;
      for (int c = 0; c < 8; ++c)
        for (int i = 0; i < nt; ++i) {
          U_GATHER(A, xa, c, i)
          U_COMPUTE(A, xa, i)
        }
    }
    for (int i = 0; i < nt; ++i) {
      const int tok = base + i * TW;
      const float xsc = p.xscale[tok];
      const float gv0 = p.pgate[(size_t)tok * 128 + 8 * sub + g], gv1 = p.pgate[(size_t)tok * 128 + 64 + 8 * sub + g];
      const int e0 = spk0[i * 64], e1 = spk1[i * 64];
      const float a0 = (float)sa0[i * 64] * usc[e0] * xsc, a1 = (float)sa1[i * 64] * usc[e1] * xsc;
      const float c0f = gv0 * 0.5f * a0 * (1.f + erff(a0 * 0.70710678118654752f)) * vsc[e0];
      const float c1f = gv1 * 0.5f * a1 * (1.f + erff(a1 * 0.70710678118654752f)) * vsc[e1];
      spk0[i * 64] = e0 | (int)(f2bf(c0f) << 16); spk1[i * 64] = e1 | (int)(f2bf(c1f) << 16);
    }
    {
      uint4 A[16]; unsigned ca[8];
#define V_GATHER(BUF, CF, c_, i_)                                                                            \
      { const unsigned char* tb_ = Vq + (size_t)(c_) * 16384 * 128;                                          \
        const int4 ka_ = *(const int4*)(gpk0 + (i_) * 64), kb_ = *(const int4*)(gpk0 + (i_) * 64 + 4);       \
        const int4 kc_ = *(const int4*)(gpk1 + (i_) * 64), kd_ = *(const int4*)(gpk1 + (i_) * 64 + 4);       \
        const int kk_[16] = {ka_.x, ka_.y, ka_.z, ka_.w, kb_.x, kb_.y, kb_.z, kb_.w, kc_.x, kc_.y, kc_.z, kc_.w, kd_.x, kd_.y, kd_.z, kd_.w}; \
        _Pragma("unroll") for (int ld = 0; ld < 16; ++ld) {                                                  \
          const unsigned pv_ = (unsigned)kk_[ld];                                                            \
          BUF[ld] = *(const uint4*)(tb_ + (((pv_ & 0xffffu) << 7) | sub16));                                 \
          if (ld & 1) CF[ld >> 1] |= pv_ & 0xffff0000u; else CF[ld >> 1] = pv_ >> 16; } }
#define FP8ACC(w_, o_) { const f32x2 lo = __builtin_amdgcn_cvt_pk_f32_fp8((int)(w_), false); const f32x2 hi = __builtin_amdgcn_cvt_pk_f32_fp8((int)(w_), true); \
        yv[(o_) / 2] = lo * cf2 + yv[(o_) / 2]; yv[(o_) / 2 + 1] = hi * cf2 + yv[(o_) / 2 + 1]; }
#define V_COMPUTE(BUF, CF, c_, i_)                                                                           \
      {                                                                                                      \
        f32x2 yv[8];                                                                                         \
        _Pragma("unroll") for (int j = 0; j < 8; ++j) { yv[j].x = 0.f; yv[j].y = 0.f; }                      \
        _Pragma("unroll") for (int ld = 0; ld < 16; ++ld) {                                                  \
          const float cf = (ld & 1) ? __uint_as_float(CF[ld >> 1] & 0xffff0000u) : __uint_as_float(CF[ld >> 1] << 16); \
          f32x2 cf2; cf2.x = cf; cf2.y = cf;                                                                 \
          unsigned w0_ = BUF[ld].x, w1_ = BUF[ld].y, w2_ = BUF[ld].z, w3_ = BUF[ld].w;                      \
          asm volatile("" : "+v"(w0_), "+v"(w1_), "+v"(w2_), "+v"(w3_));                                   \
          FP8ACC(w0_, 0) FP8ACC(w1_, 4) FP8ACC(w2_, 8) FP8ACC(w3_, 12)                                      \
          asm volatile("" : "+v"(yv[0]), "+v"(yv[1]), "+v"(yv[2]), "+v"(yv[3]), "+v"(yv[4]), "+v"(yv[5]), "+v"(yv[6]), "+v"(yv[7])); } \
        float y16[16];                                                                                       \
        _Pragma("unroll") for (int j = 0; j < 8; ++j) { y16[2 * j] = yv[j].x; y16[2 * j + 1] = yv[j].y; }    \
        float z8[8], z4[4], z2[2];                                                                           \
        _Pragma("unroll") for (int j = 0; j < 8; ++j) { const float x = y16[j], y = y16[j + 8]; z8[j] = (b5 ? y : x) + __shfl_xor(b5 ? x : y, 32); } \
        _Pragma("unroll") for (int j = 0; j < 4; ++j) { const float x = z8[j], y = z8[j + 4]; z4[j] = (b4 ? y : x) + __shfl_xor(b4 ? x : y, 16); } \
        _Pragma("unroll") for (int j = 0; j < 2; ++j) { const float x = z4[j], y = z4[j + 2]; z2[j] = (b3 ? y : x) + dpp_xor8f(b3 ? x : y); } \
        *(float2*)(Y + (size_t)(base + (i_) * TW) * 1024 + (c_) * 128 + sub * 16 + 2 * g) = make_float2(z2[0], z2[1]); \
      }
      for (int c = 0; c < 8; ++c)
        for (int i = 0; i < nt; ++i) {
          V_GATHER(A, ca, c, i)
          V_COMPUTE(A, ca, c, i)
        }
    }
    __threadfence();
    for (int i = 0; i < nt; ++i) {
      const int tok = base + i * TW;
      const int c0i = lane * 8, c1i = 512 + lane * 8;
      const float* ad = adaL + (size_t)cond_row(tok) * 6144;
      const float* xr = p.XZ + (size_t)tok * 1024;
      const float* yr = Y + (size_t)tok * 1024;
      float z[16], gg[16], y[16];
      ld8f(xr + c0i, z); ld8f(xr + c1i, z + 8);
      ld8f(yr + c0i, y); ld8f(yr + c1i, y + 8);
      ld8f(ad + 5120 + c0i, gg); ld8f(ad + 5120 + c1i, gg + 8);
      float sm = 0.f;
#pragma unroll
      for (int j = 0; j < 16; ++j) { z[j] = ALPHA * z[j] + gg[j] * y[j]; sm += z[j]; }
      const float mu = wsum(sm) * (1.f / 1024.f);
      float q = 0.f;
#pragma unroll
      for (int j = 0; j < 16; ++j) { const float d = z[j] - mu; q += d * d; }
      const float rstd = rsqrtf(wsum(q) * (1.f / 1024.f) + LN_EPS);
      float bb[16];
      ld8f(g2g + c0i, gg); ld8f(g2g + c1i, gg + 8); ld8f(g2b + c0i, bb); ld8f(g2b + c1i, bb + 8);
#pragma unroll
      for (int j = 0; j < 16; ++j) z[j] = (z[j] - mu) * rstd * gg[j] + bb[j];
      float* dr = dstbase + (size_t)tok * 1024;
      st8f(dr + c0i, z); st8f(dr + c1i, z + 8);
      if (l == 0) {
        const float* ad1 = p.ada + (size_t)(136 + cond_row(tok)) * 6144;
        mod_store(p.hbf + (size_t)tok * 1024 + c0i, z, ad1 + 1024 + c0i, ad1 + c0i);
        mod_store(p.hbf + (size_t)tok * 1024 + c1i, z + 8, ad1 + 1024 + c1i, ad1 + c1i);
      }
    }
  }
}

#define XB_TMO      128
#define XB_XCNT(j)  (256  + 64 * (j))
#define XB_XSUB(j)  (1280 + 64 * (j))
#define XB_XGEN(j)  (2304 + 64 * (j))
#define XB_TOP      3328
#define XB_TOPGEN   3392
#define XCD_BAR_WORDS 3456
#define XB_SPIN_CAP (1u << 18)
#define LAS __attribute__((address_space(3)))
DI unsigned xb_ld(unsigned* p) { return __hip_atomic_load(p, __ATOMIC_RELAXED, __HIP_MEMORY_SCOPE_AGENT); }
DI unsigned xb_add(unsigned* p, unsigned v) { return __hip_atomic_fetch_add(p, v, __ATOMIC_RELAXED, __HIP_MEMORY_SCOPE_AGENT); }
DI unsigned xb_xcc_id() { return (unsigned)__builtin_amdgcn_s_getreg((3 << 11) | 20) & 0xFu; }
#define XB_SPIN(cond, bar) do { unsigned _sp = 0; while (cond) { __builtin_amdgcn_s_sleep(1); \
    if ((++_sp & 255u) == 0u) { if (xb_ld(&(bar)[XB_TMO])) break; if (_sp > XB_SPIN_CAP) { atomicAdd(&(bar)[XB_TMO], 1u); break; } } } } while (0)
struct XcdBarrier { unsigned* bar; unsigned x; volatile LAS unsigned* st; };
DI XcdBarrier xcd_barrier_post(unsigned* bar, volatile LAS unsigned* st) {
  XcdBarrier b; b.bar = bar; b.x = xb_xcc_id(); b.st = st;
  if (threadIdx.x == 0) (void)xb_add(&bar[XB_XCNT(b.x)], 1u);
  return b;
}
DI void xcd_barrier_complete(unsigned* bar, unsigned x, unsigned& nloc, unsigned& nx) {
  const unsigned G = gridDim.x * gridDim.y * gridDim.z;
  unsigned sum, cnt, mine, sp = 0u;
  for (;;) {
    sum = 0u; cnt = 0u; mine = 0u;
#pragma unroll
    for (unsigned j = 0; j < 16; ++j) { const unsigned c = xb_ld(&bar[XB_XCNT(j)]); sum += c; cnt += (c > 0u) ? 1u : 0u; mine = (j == x) ? c : mine; }
    if (sum == G) break;
    __builtin_amdgcn_s_sleep(1);
    if ((++sp & 255u) == 0u) { if (xb_ld(&bar[XB_TMO])) break; if (sp > XB_SPIN_CAP) { atomicAdd(&bar[XB_TMO], 1u); break; } }
  }
  nloc = mine > 0u ? mine : 1u; nx = cnt > 0u ? cnt : 1u;
}
DI void xcd_barrier(const XcdBarrier& b) {
  asm volatile("s_waitcnt vmcnt(0)" ::: "memory");
  __syncthreads();
  if (threadIdx.x == 0) {
    unsigned* bar = b.bar;
    __builtin_amdgcn_s_waitcnt(0);
    unsigned nloc = b.st[0], nx = b.st[1];
    if (nloc == 0u) { xcd_barrier_complete(bar, b.x, nloc, nx); b.st[0] = nloc; b.st[1] = nx; }
    const unsigned old = xb_add(&bar[XB_XSUB(b.x)], 1u);
    const unsigned gen = old / nloc;
    if (old + 1u == (gen + 1u) * nloc) {
      __builtin_amdgcn_fence(__ATOMIC_RELEASE, "agent");
      asm volatile("s_waitcnt vmcnt(0)" ::: "memory");
      const unsigned og = xb_add(&bar[XB_TOP], 1u);
      const unsigned tg = og / nx;
      if (og + 1u == (tg + 1u) * nx) xb_add(&bar[XB_TOPGEN], 1u);
      else XB_SPIN(xb_ld(&bar[XB_TOPGEN]) == tg, bar);
      __builtin_amdgcn_fence(__ATOMIC_ACQUIRE, "agent");
      xb_add(&bar[XB_XGEN(b.x)], 1u);
      asm volatile("s_waitcnt vmcnt(0)" ::: "memory");
    } else {
      XB_SPIN(xb_ld(&bar[XB_XGEN(b.x)]) == gen, bar);
      __builtin_amdgcn_fence(__ATOMIC_ACQUIRE, "agent");
      asm volatile("s_waitcnt vmcnt(0)" ::: "memory");
    }
  }
  __syncthreads();
}

__global__ void __launch_bounds__(256, 2) fwd_megakernel(Params p, int ph_lo, int ph_hi) {
  __shared__ __attribute__((aligned(16))) char smem[63488];
  __shared__ uint4 xb_words;
  cg::grid_group grid = cg::this_grid();
  if (threadIdx.x == 0) xb_words = make_uint4(0u, 0u, 0u, 0u);
  __syncthreads();
  const XcdBarrier xb = xcd_barrier_post(p.bar, (volatile LAS unsigned*)&xb_words);
  for (int ph = ph_lo; ph < ph_hi; ++ph) {
    if (ph == 0) phase0(p, smem);
    else if (ph == 1) phase1(p);
    else {
      const int l = (ph - 2) / 9, s = (ph - 2) % 9;
      switch (s) {
        case 0: phaseA(p, l, smem); break;
        case 1: phaseB1(p, l, smem); break;
        case 2: phaseB2(p, l); break;
        case 3: phaseB3(p, l, smem); break;
        case 4: phaseC(p, l, smem); break;
        case 5: phaseD(p, l); break;
        case 6: phaseE(p, l, smem); break;
        case 7: phaseF(p, l, smem); break;
        default: phaseG(p, l, smem); break;
      }
    }
    if (ph + 1 < ph_hi) { if (ph_lo < 0) grid.sync(); xcd_barrier(xb); }
  }
}

#ifndef MULTI_LAUNCH
#define MULTI_LAUNCH 0
#endif

extern "C" void kernel_launch(void* const* d_in, const int* in_sizes, int n_in, void* d_out, int out_size, void* d_ws,
                              size_t ws_size, hipStream_t stream) {
  static int grid_blocks = 0;
  if (!grid_blocks) {
    int dev = 0, cus = 0, per_cu = 0;
    hipGetDevice(&dev);
    hipDeviceGetAttribute(&cus, hipDeviceAttributeMultiprocessorCount, dev);
    hipOccupancyMaxActiveBlocksPerMultiprocessor(&per_cu, fwd_megakernel, 256, 0);
    if (per_cu > 2) per_cu = 2;
    if (per_cu < 1) per_cu = 1;
    grid_blocks = cus * per_cu;
  }
  Params p{};
  const float* const* in = (const float* const*)d_in;
  p.x_prompt = in[0]; p.x_sample = in[1]; p.stC = in[2]; p.stN = in[3]; p.stM = in[4]; p.stPool = in[5];
  p.c_prompt = in[6]; p.c_sample = in[7]; p.w_ada = in[8]; p.b_ada = in[9]; p.w_in = in[10]; p.b_gate = in[11];
  p.mh_g = in[12]; p.sgu_g = in[13]; p.sgu_b = in[14]; p.w_s = in[15]; p.b_s = in[16]; p.w_pool = in[17];
  p.pool_scale = in[18]; p.w_o = in[19]; p.ln1_g = in[20]; p.ln1_b = in[21]; p.w_pq = in[22]; p.peer_keys = in[23];
  p.peer_u = in[24]; p.peer_v = in[25]; p.ln2_g = in[26]; p.ln2_b = in[27];
  p.out = (float*)d_out;
  char* ws = (char*)d_ws; size_t off = 0;
  auto take = [&](size_t bytes) { char* r = ws + off; off += (bytes + 255) & ~(size_t)255; return r; };
  p.ada = (float*)take((size_t)2 * 136 * 6144 * 4);
  p.WinT = (bf16_t*)take((size_t)2 * NIN * 1024 * 2);
  p.WoT = (bf16_t*)take((size_t)2 * 1024 * 1024 * 2);
  p.WpqT = (bf16_t*)take((size_t)2 * 2048 * 1024 * 2);
  p.keysb = (bf16_t*)take((size_t)524288 * 2);
  p.Uq = (unsigned char*)take((size_t)2 * 16384 * 1024);
  p.Vq = (unsigned char*)take((size_t)2 * 16384 * 1024);
  p.xq = (unsigned char*)take((size_t)NT * 1024);
  p.uscale = (float*)take((size_t)2 * 16384 * 4);
  p.vscale = (float*)take((size_t)2 * 16384 * 4);
  p.xscale = (float*)take((size_t)NT * 4);
  p.hbf = (bf16_t*)take((size_t)NT * 1024 * 2);
  p.qkvo = (bf16_t*)take((size_t)NT * 2048 * 2);
  p.KT = (bf16_t*)take((size_t)32 * 128 * 2048 * 2);
  p.VT = (bf16_t*)take((size_t)32 * 128 * 2048 * 2);
  p.F = (float*)take((size_t)NT * FS * 4);
  p.CH = (float*)take((size_t)1024 * CHS * 4);
  p.scal = (float*)take((size_t)2048 * 4);
  p.mstart = (float*)take((size_t)1024 * 4);
  p.XZ = (float*)take((size_t)NT * 1024 * 4);
  p.pgate = (float*)take((size_t)NT * 128 * 4);
  p.pidx = (int*)take((size_t)NT * 128 * 4);
  p.bar = (unsigned*)take((size_t)XCD_BAR_WORDS * 4);
  if (off > ws_size) fprintf(stderr, "workspace too small: need %zu have %zu\n", off, ws_size);
  (void)hipMemsetAsync(p.bar, 0, (size_t)XCD_BAR_WORDS * 4, stream);
#if MULTI_LAUNCH
  for (int ph = 0; ph < 20; ++ph) hipLaunchKernelGGL(fwd_megakernel, dim3(grid_blocks), dim3(256), 0, stream, p, ph, ph + 1);
#else
  int lo = 0, hi = 20;
  void* args[] = {&p, &lo, &hi};
  hipError_t e = hipLaunchCooperativeKernel((void*)fwd_megakernel, dim3(grid_blocks), dim3(256), args, 0, stream);
  if (e != hipSuccess) fprintf(stderr, "cooperative launch failed: %s (grid %d)\n", hipGetErrorString(e), grid_blocks);
#endif
}
```

```cpp
#include <hip/hip_runtime.h>
#include <hip/hip_cooperative_groups.h>
#include <cstdio>
#include <cstdint>
namespace cg = cooperative_groups;

typedef unsigned short bf16_t;
typedef __attribute__((ext_vector_type(8))) short bf16x8;
typedef __attribute__((ext_vector_type(16))) float f32x16;
typedef __attribute__((ext_vector_type(2))) __bf16 bf2_t;
typedef __attribute__((ext_vector_type(2))) float f32x2;
#define DI __device__ __forceinline__
#define MFMA32(a, b, c) __builtin_amdgcn_mfma_f32_32x32x16_bf16((a), (b), (c), 0, 0, 0)

constexpr int NP = 16384, NS = 512, NT = 16896;
constexpr int NIN = 2944;
constexpr int FS = 776;
constexpr float ALPHA = 1.4142135623730951f;
constexpr float LN_EPS = 1e-5f;
constexpr int CHS = 129 * 128;

struct Params {
  const float *x_prompt, *x_sample, *stC, *stN, *stM, *stPool, *c_prompt, *c_sample;
  const float *w_ada, *b_ada, *w_in, *b_gate, *mh_g, *sgu_g, *sgu_b, *w_s, *b_s, *w_pool, *pool_scale, *w_o,
      *ln1_g, *ln1_b, *w_pq, *peer_keys, *peer_u, *peer_v, *ln2_g, *ln2_b;
  float* out;
  float* ada;
  bf16_t *WinT, *WoT, *WpqT, *keysb, *hbf, *qkvo, *KT, *VT;
  unsigned char *Uq, *Vq, *xq;
  float *uscale, *vscale, *xscale;
  float *F, *CH, *scal, *mstart, *XZ, *pgate;
  int* pidx;
  unsigned* bar;
};

constexpr size_t O_YP = 0;
constexpr size_t O_YS = 16777216;
constexpr size_t O_CP = O_YS + 524288;
constexpr size_t O_NP = O_CP + 1048576;
constexpr size_t O_MP = O_NP + 8192;
constexpr size_t O_PP = O_MP + 64;
constexpr size_t O_CS = O_PP + 61440;
constexpr size_t O_NS = O_CS + 16777216;
constexpr size_t O_MS = O_NS + 131072;
constexpr size_t O_PS = O_MS + 1024;
constexpr size_t O_SV = O_PS + 983040;

DI int tidx() { int t = threadIdx.x; asm volatile("" : "+v"(t)); return t; }
DI int bidx() { int b = blockIdx.x; asm volatile("" : "+s"(b)); return b; }
DI unsigned f2bf(float x) { unsigned u = __float_as_uint(x); u += 0x7fffu + ((u >> 16) & 1u); return u >> 16; }
DI unsigned pack2(float a, float b) { return f2bf(a) | (f2bf(b) << 16); }
DI float bflo(unsigned u) { return __uint_as_float(u << 16); }
DI float bfhi(unsigned u) { return __uint_as_float(u & 0xffff0000u); }
DI float bf2f(bf16_t h) { return __uint_as_float(((unsigned)h) << 16); }
DI uint4 pack8(const float* v) { return make_uint4(pack2(v[0], v[1]), pack2(v[2], v[3]), pack2(v[4], v[5]), pack2(v[6], v[7])); }
DI void unpack8(uint4 u, float* v) {
  v[0] = bflo(u.x); v[1] = bfhi(u.x); v[2] = bflo(u.y); v[3] = bfhi(u.y);
  v[4] = bflo(u.z); v[5] = bfhi(u.z); v[6] = bflo(u.w); v[7] = bfhi(u.w);
}
DI int crow(int reg, int h) { return (reg & 3) + 8 * (reg >> 2) + 4 * h; }
DI int cond_row(int tok) { return tok < NP ? (tok >> 11) : 8 + ((tok - NP) >> 2); }
DI int dpp_xor1(int x) { return __builtin_amdgcn_update_dpp(0, x, 0xB1, 0xF, 0xF, true); }
DI int dpp_xor2(int x) { return __builtin_amdgcn_update_dpp(0, x, 0x4E, 0xF, 0xF, true); }
DI int dpp_xor4(int x) { return __builtin_amdgcn_update_dpp(0, __builtin_amdgcn_update_dpp(0, x, 0x141, 0xF, 0xF, true), 0x1B, 0xF, 0xF, true); }
DI int dpp_xor8(int x) { return __builtin_amdgcn_update_dpp(0, x, 0x128, 0xF, 0xF, true); }
DI float dpp_xor8f(float x) { return __builtin_bit_cast(float, dpp_xor8(__builtin_bit_cast(int, x))); }
DI float wsum(float v) { for (int o = 32; o > 0; o >>= 1) v += __shfl_xor(v, o); return v; }
DI float wmax(float v) { for (int o = 32; o > 0; o >>= 1) v = fmaxf(v, __shfl_xor(v, o)); return v; }
DI float sigmoidf_(float x) { return 1.f / (1.f + __expf(-x)); }
DI float logsigmoidf_(float x) { return fminf(x, 0.f) - log1pf(__expf(-fabsf(x))); }
DI float dot2bf(unsigned a, unsigned b, float c) {
  return __builtin_amdgcn_fdot2_f32_bf16(__builtin_bit_cast(bf2_t, a), __builtin_bit_cast(bf2_t, b), c, false);
}
DI bf16x8 ld8(const bf16_t* p) { return __builtin_bit_cast(bf16x8, *(const uint4*)p); }
DI void ld8f(const float* p, float* v) {
  float4 a = ((const float4*)p)[0], b = ((const float4*)p)[1];
  v[0] = a.x; v[1] = a.y; v[2] = a.z; v[3] = a.w; v[4] = b.x; v[5] = b.y; v[6] = b.z; v[7] = b.w;
}
DI void st8f(float* p, const float* v) {
  ((float4*)p)[0] = make_float4(v[0], v[1], v[2], v[3]); ((float4*)p)[1] = make_float4(v[4], v[5], v[6], v[7]);
}

template <class Epi>
DI void gemm128(const bf16_t* __restrict__ A, const bf16_t* __restrict__ Bt, int m0, int n0, char* smem, const Epi& epi) {
  const int tid = tidx(), lane = tid & 63, w = tid >> 6, wm = w >> 1, wn = w & 1, r = lane & 31, h = lane >> 5;
  bf16_t* As = (bf16_t*)smem;
  bf16_t* Bs = As + 128 * 72;
  f32x16 acc[2][2];
#pragma unroll
  for (int i = 0; i < 2; ++i)
#pragma unroll
    for (int j = 0; j < 2; ++j)
#pragma unroll
      for (int e = 0; e < 16; ++e) acc[i][j][e] = 0.f;
  typedef __attribute__((ext_vector_type(4))) unsigned u32x4;
  u32x4 ra0, ra1, ra2, ra3, rb0, rb1, rb2, rb3;
  u32x4 sa0, sa1, sa2, sa3, sb0, sb1, sb2, sb3;
  const int prow = tid >> 3, pc = (tid & 7) * 8;
  const bf16_t* ap = A + (size_t)(m0 + prow) * 1024 + pc;
  const bf16_t* bp = Bt + (size_t)(n0 + prow) * 1024 + pc;
#define GLD(P, k0_)                                                                                          \
  P##a0 = *(const u32x4*)(ap + (k0_)); P##a1 = *(const u32x4*)(ap + 32 * 1024 + (k0_));                      \
  P##a2 = *(const u32x4*)(ap + 64 * 1024 + (k0_)); P##a3 = *(const u32x4*)(ap + 96 * 1024 + (k0_));         \
  P##b0 = *(const u32x4*)(bp + (k0_)); P##b1 = *(const u32x4*)(bp + 32 * 1024 + (k0_));                      \
  P##b2 = *(const u32x4*)(bp + 64 * 1024 + (k0_)); P##b3 = *(const u32x4*)(bp + 96 * 1024 + (k0_));
#define LST(P)                                                                                               \
  *(u32x4*)(As + (prow) * 72 + pc) = P##a0; *(u32x4*)(As + (prow + 32) * 72 + pc) = P##a1;                   \
  *(u32x4*)(As + (prow + 64) * 72 + pc) = P##a2; *(u32x4*)(As + (prow + 96) * 72 + pc) = P##a3;              \
  *(u32x4*)(Bs + (prow) * 72 + pc) = P##b0; *(u32x4*)(Bs + (prow + 32) * 72 + pc) = P##b1;                   \
  *(u32x4*)(Bs + (prow + 64) * 72 + pc) = P##b2; *(u32x4*)(Bs + (prow + 96) * 72 + pc) = P##b3;
  GLD(r, 0)
  __builtin_amdgcn_sched_barrier(0);
  GLD(s, 64)
  __builtin_amdgcn_sched_barrier(0);
#define GEMM_COMPUTE()                                                                                       \
  _Pragma("unroll") for (int ks = 0; ks < 4; ++ks) {                                                         \
    bf16x8 a[2], b[2];                                                                                       \
    _Pragma("unroll") for (int i = 0; i < 2; ++i) a[i] = ld8(As + (wm * 64 + i * 32 + r) * 72 + ks * 16 + h * 8); \
    _Pragma("unroll") for (int j = 0; j < 2; ++j) b[j] = ld8(Bs + (wn * 64 + j * 32 + r) * 72 + ks * 16 + h * 8); \
    _Pragma("unroll") for (int i = 0; i < 2; ++i)                                                            \
      _Pragma("unroll") for (int j = 0; j < 2; ++j) acc[i][j] = MFMA32(a[i], b[j], acc[i][j]);               \
  }
#pragma unroll
  for (int kt = 0; kt < 16; kt += 2) {
    __syncthreads();
    LST(r)
    __syncthreads();
    { const int k0 = (kt + 2 < 16 ? kt + 2 : 14) * 64; GLD(r, k0) }
    GEMM_COMPUTE()
    __syncthreads();
    LST(s)
    __syncthreads();
    { const int k0 = (kt + 3 < 16 ? kt + 3 : 15) * 64; GLD(s, k0) }
    GEMM_COMPUTE()
  }
#pragma unroll
  for (int i = 0; i < 2; ++i)
#pragma unroll
    for (int j = 0; j < 2; ++j)
#pragma unroll
      for (int g = 0; g < 4; ++g)
        epi(m0 + wm * 64 + i * 32 + 8 * g + 4 * h, n0 + wn * 64 + j * 32 + r, acc[i][j][4 * g], acc[i][j][4 * g + 1],
            acc[i][j][4 * g + 2], acc[i][j][4 * g + 3]);
}

DI void phase0(const Params& p, char* smem) {
  const int tid = tidx(), G = gridDim.x;
  auto do_ada = [&]() __attribute__((always_inline)) {
    float* S = (float*)smem;
    const int lane = tid & 63, w = tid >> 6;
    for (int it0 = bidx(); it0 < 2 * 24 * 9; it0 += G) {
      int it = it0;
      if ((G & 7) == 0 && G >= 512) {
        const int x = it0 & 7, slot = it0 >> 3;
        if (slot >= 54) continue;
        it = ((slot / 9) * 8 + x) * 9 + slot % 9;
      }
      const int l = it / 216, rem = it % 216, cb = rem / 9, rg = rem % 9;
      float acc[64];
#pragma unroll
      for (int i = 0; i < 64; ++i) acc[i] = 0.f;
      for (int half = 0; half < 2; ++half) {
#pragma unroll
        for (int q = 0; q < 16; ++q) {
          const int row = rg * 16 + q, rowc = row < 136 ? row : 135;
          const float* cp = (rowc < 8 ? p.c_prompt + rowc * 1024 : p.c_sample + (rowc - 8) * 1024) + half * 512;
          const float m = row < 136 ? 1.f : 0.f;
#pragma unroll
          for (int j = 0; j < 2; ++j) { const float c = cp[tid + 256 * j]; S[(tid + 256 * j) * 16 + q] = m * c / (1.f + __expf(-c)); }
        }
        __syncthreads();
        const float* wp = p.w_ada + ((size_t)l * 1024 + half * 512 + w * 128) * 6144 + cb * 256 + lane * 4;
        const float* sp = S + w * 128 * 16;
#pragma unroll 8
        for (int kk = 0; kk < 128; ++kk) {
          const float4 wv = *(const float4*)(wp + (size_t)kk * 6144);
#pragma unroll
          for (int q4 = 0; q4 < 4; ++q4) {
            const float4 s4 = *(const float4*)(sp + kk * 16 + q4 * 4);
            acc[(q4 * 4 + 0) * 4 + 0] += s4.x * wv.x; acc[(q4 * 4 + 0) * 4 + 1] += s4.x * wv.y; acc[(q4 * 4 + 0) * 4 + 2] += s4.x * wv.z; acc[(q4 * 4 + 0) * 4 + 3] += s4.x * wv.w;
            acc[(q4 * 4 + 1) * 4 + 0] += s4.y * wv.x; acc[(q4 * 4 + 1) * 4 + 1] += s4.y * wv.y; acc[(q4 * 4 + 1) * 4 + 2] += s4.y * wv.z; acc[(q4 * 4 + 1) * 4 + 3] += s4.y * wv.w;
            acc[(q4 * 4 + 2) * 4 + 0] += s4.z * wv.x; acc[(q4 * 4 + 2) * 4 + 1] += s4.z * wv.y; acc[(q4 * 4 + 2) * 4 + 2] += s4.z * wv.z; acc[(q4 * 4 + 2) * 4 + 3] += s4.z * wv.w;
            acc[(q4 * 4 + 3) * 4 + 0] += s4.w * wv.x; acc[(q4 * 4 + 3) * 4 + 1] += s4.w * wv.y; acc[(q4 * 4 + 3) * 4 + 2] += s4.w * wv.z; acc[(q4 * 4 + 3) * 4 + 3] += s4.w * wv.w;
          }
        }
        __syncthreads();
      }
      const float4 bb = *(const float4*)(p.b_ada + l * 6144 + cb * 256 + lane * 4);
#pragma unroll
      for (int pass = 0; pass < 2; ++pass) {
#pragma unroll
        for (int j = 0; j < 32; ++j) S[(w * 32 + j) * 64 + lane] = acc[pass * 32 + j];
        __syncthreads();
#pragma unroll
        for (int rr = 0; rr < 2; ++rr) {
          const int r = 2 * w + rr, row = rg * 16 + pass * 8 + r;
          float o[4];
#pragma unroll
          for (int c = 0; c < 4; ++c) o[c] = S[(0 * 32 + r * 4 + c) * 64 + lane] + S[(1 * 32 + r * 4 + c) * 64 + lane] + S[(2 * 32 + r * 4 + c) * 64 + lane] + S[(3 * 32 + r * 4 + c) * 64 + lane];
          if (row < 136) *(float4*)(p.ada + ((size_t)l * 136 + row) * 6144 + cb * 256 + lane * 4) = make_float4(o[0] + bb.x, o[1] + bb.y, o[2] + bb.z, o[3] + bb.w);
        }
        __syncthreads();
      }
    }
  };
  auto do_transposes = [&]() __attribute__((always_inline)) {
    float* T = (float*)smem;
    for (int it = bidx(); it < 3008; it += G) {
      const int l = it / 1504; int j = it % 1504;
      const float* src; bf16_t* dst; int ldsrc, kind;
      if (j < 736) { kind = 0; src = p.w_in + (size_t)l * 1024 * 2824; ldsrc = 2824; dst = p.WinT + (size_t)l * NIN * 1024; }
      else if (j < 992) { j -= 736; kind = 1; src = p.w_o + (size_t)l * 1024 * 1024; ldsrc = 1024; dst = p.WoT + (size_t)l * 1024 * 1024; }
      else { j -= 992; kind = 2; src = p.w_pq + (size_t)l * 1024 * 2048; ldsrc = 2048; dst = p.WpqT + (size_t)l * 2048 * 1024; }
      const int nt = j >> 4, kt = j & 15;
      const int tn = tid & 63, tk0 = tid >> 6;
      const int n = nt * 64 + tn;
      int e = n;
      if (kind == 0) e = n < 2048 ? n : (n < 2816 ? n + 8 : (n < 2824 ? 2048 + (n - 2816) : -1));
#pragma unroll
      for (int i = 0; i < 16; ++i) { const int k = tk0 + 4 * i; T[k * 65 + tn] = e >= 0 ? src[(size_t)(kt * 64 + k) * ldsrc + e] : 0.f; }
      __syncthreads();
      const int nn = tid >> 2, kq = (tid & 3) * 16;
      unsigned pk[8];
#pragma unroll
      for (int q = 0; q < 8; ++q) pk[q] = pack2(T[(kq + 2 * q) * 65 + nn], T[(kq + 2 * q + 1) * 65 + nn]);
      uint4* d4 = (uint4*)(dst + (size_t)(nt * 64 + nn) * 1024 + kt * 64 + kq);
      d4[0] = make_uint4(pk[0], pk[1], pk[2], pk[3]);
      d4[1] = make_uint4(pk[4], pk[5], pk[6], pk[7]);
      __syncthreads();
    }
  };
  auto do_quant = [&]() __attribute__((always_inline)) {
    const size_t nk8 = 524288 / 8;
    for (size_t i = (size_t)bidx() * 256 + tid; i < nk8; i += (size_t)G * 256) {
      const float* s = p.peer_keys + i * 8;
      const float4 a = ((const float4*)s)[0], b = ((const float4*)s)[1];
      *(uint4*)(p.keysb + i * 8) = make_uint4(pack2(a.x, a.y), pack2(a.z, a.w), pack2(b.x, b.y), pack2(b.z, b.w));
    }
    const int lane = tid & 63, w = tid >> 6;
    for (int row0 = (bidx() * 4 + w) * 2; row0 < 65536; row0 += G * 8) {
      float v[2][16];
#pragma unroll
      for (int r = 0; r < 2; ++r) {
        const int row = row0 + r; const int tab = row >> 15, le = row & 32767;
        const float* src = (tab ? p.peer_v : p.peer_u) + (size_t)le * 1024 + lane * 16;
        ld8f(src, v[r]); ld8f(src + 8, v[r] + 8);
      }
#pragma unroll
      for (int r = 0; r < 2; ++r) {
        const int row = row0 + r; const int tab = row >> 15, le = row & 32767, l = le >> 14, e = le & 16383;
        float m = 0.f;
#pragma unroll
        for (int j = 0; j < 16; ++j) m = fmaxf(m, fabsf(v[r][j]));
        m = wmax(m);
        unsigned wd[4];
        if (tab == 0) {
          const float inv = m > 0.f ? 127.f / m : 0.f;
#pragma unroll
          for (int q = 0; q < 4; ++q) {
            const int q0 = (int)rintf(v[r][4 * q] * inv), q1 = (int)rintf(v[r][4 * q + 1] * inv), q2 = (int)rintf(v[r][4 * q + 2] * inv), q3 = (int)rintf(v[r][4 * q + 3] * inv);
            wd[q] = (unsigned)(q0 & 255) | ((unsigned)(q1 & 255) << 8) | ((unsigned)(q2 & 255) << 16) | ((unsigned)(q3 & 255) << 24);
          }
          if (lane == 0) p.uscale[le] = m * (1.f / 127.f);
        } else {
          const float inv = m > 0.f ? 400.f / m : 0.f;
#pragma unroll
          for (int q = 0; q < 4; ++q) {
            int pk = __builtin_amdgcn_cvt_pk_fp8_f32(v[r][4 * q] * inv, v[r][4 * q + 1] * inv, 0, false);
            pk = __builtin_amdgcn_cvt_pk_fp8_f32(v[r][4 * q + 2] * inv, v[r][4 * q + 3] * inv, pk, true);
            wd[q] = (unsigned)pk;
          }
          if (lane == 0) p.vscale[le] = m * (1.f / 400.f);
        }
        unsigned char* dst = (tab ? p.Vq : p.Uq) + (((size_t)(l * 8 + (lane >> 3)) * 16384 + e) << 7) + (lane & 7) * 16;
        *(uint4*)dst = make_uint4(wd[0], wd[1], wd[2], wd[3]);
      }
    }
  };
  if ((bidx() / (gridDim.x >> 1)) & 1) { do_quant(); do_transposes(); do_ada(); }
  else { do_ada(); do_transposes(); do_quant(); }
}

DI void mod_store(bf16_t* dst, const float* x, const float* sc, const float* sh) {
  float s[8], t[8], o[8];
  ld8f(sc, s); ld8f(sh, t);
#pragma unroll
  for (int j = 0; j < 8; ++j) o[j] = x[j] * (1.f + s[j]) + t[j];
  *(uint4*)dst = pack8(o);
}

DI void phase1(const Params& p) {
  const int tid = tidx(), lane = tid & 63, w = tid >> 6;
  for (int tok = bidx() * 4 + w; tok < NT; tok += gridDim.x * 4) {
    const float* xr = tok < NP ? p.x_prompt + (size_t)tok * 1024 : p.x_sample + (size_t)(tok - NP) * 1024;
    const float* ad = p.ada + (size_t)cond_row(tok) * 6144;
#pragma unroll
    for (int hf = 0; hf < 2; ++hf) {
      const int c = hf * 512 + lane * 8;
      float x[8]; ld8f(xr + c, x);
      mod_store(p.hbf + (size_t)tok * 1024 + c, x, ad + 1024 + c, ad + c);
    }
  }
}

DI void tile_decode(int u, int NTL, int MTL, int& mt, int& nt) {
  const int per_mg = 8 * NTL;
  const int mg = u / per_mg; int v = u - mg * per_mg;
  const int rm = min(8, MTL - 8 * mg);
  int ng = 0;
  for (;;) { const int cn = min(8, NTL - 8 * ng); const int sz = rm * cn; if (v < sz) { mt = 8 * mg + v / cn; nt = 8 * ng + v % cn; return; } v -= sz; ++ng; }
}
template <class Epi>
DI void gemm_micro32(const bf16_t* __restrict__ A, const bf16_t* __restrict__ Bt, int m0, int n0, char* smem, const Epi& epi) {
  const int tid = tidx(), lane = tid & 63, w = tid >> 6, r = lane & 31, h = lane >> 5;
  float* red = (float*)smem;
  f32x16 acc;
#pragma unroll
  for (int e = 0; e < 16; ++e) acc[e] = 0.f;
  const bf16_t* ap = A + (size_t)(m0 + r) * 1024 + w * 256 + h * 8;
  const bf16_t* bp = Bt + (size_t)(n0 + r) * 1024 + w * 256 + h * 8;
#pragma unroll
  for (int ks = 0; ks < 16; ++ks) { const bf16x8 a = ld8(ap + ks * 16); const bf16x8 b = ld8(bp + ks * 16); acc = MFMA32(a, b, acc); }
  __syncthreads();
#pragma unroll
  for (int e = 0; e < 16; ++e) red[(w * 16 + e) * 64 + lane] = acc[e];
  __syncthreads();
  if (w == 0) {
#pragma unroll
    for (int e = 0; e < 16; ++e) acc[e] = red[e * 64 + lane] + red[(16 + e) * 64 + lane] + red[(32 + e) * 64 + lane] + red[(48 + e) * 64 + lane];
#pragma unroll
    for (int g = 0; g < 4; ++g) epi(m0 + 8 * g + 4 * h, n0 + r, acc[4 * g], acc[4 * g + 1], acc[4 * g + 2], acc[4 * g + 3]);
  }
}

template <class Epi>
DI void gemm_phase(const bf16_t* A, const bf16_t* Bt, int NTL, char* smem, const Epi& epi, bool micro_sample) {
  const int MTL = micro_sample ? 128 : 132;
  const int T = MTL * NTL, G = gridDim.x, bx = bidx();
  if ((G & 7) == 0) {
    const int x = bx & 7, slot = bx >> 3, per = G >> 3;
    const int lo = (int)(((long long)T * x) >> 3), hi = (int)(((long long)T * (x + 1)) >> 3);
    for (int u = lo + slot; u < hi; u += per) { int mt, nt; tile_decode(u, NTL, MTL, mt, nt); gemm128(A, Bt, mt * 128, nt * 128, smem, epi); }
  } else {
    for (int t = bx; t < T; t += G) { const int mt = t / NTL, nt = t % NTL; gemm128(A, Bt, mt * 128, nt * 128, smem, epi); }
  }
  if (micro_sample) {
    const int NB = NTL * 4;
    for (int t = bx; t < 16 * NB; t += G) { const int mb = t & 15, nb = t >> 4; gemm_micro32(A, Bt, NP + mb * 32, nb * 32, smem, epi); }
  }
}

struct EpiA {
  const Params& p; const float* bg;
  DI void operator()(int row4, int col, float v0, float v1, float v2, float v3) const {
    if (col < 2048) {
      const float s = col < 512 ? 0.08838834764831845f : 1.f;
      bf16_t* q = p.qkvo + (size_t)row4 * 2048 + col;
      if (!(col >= 1024 && col < 1536 && row4 < NP)) {
        q[0] = (bf16_t)f2bf(v0 * s); q[2048] = (bf16_t)f2bf(v1 * s); q[4096] = (bf16_t)f2bf(v2 * s); q[6144] = (bf16_t)f2bf(v3 * s);
      }
      if (col >= 512 && col < 1536 && row4 < NP) {
        int cc = col - 512; bf16_t* T = cc < 512 ? p.KT : p.VT; cc &= 511;
        const int hh = cc >> 7, d = cc & 127, b = row4 >> 11, t = row4 & 2047;
        *(uint2*)(T + ((size_t)((b * 4 + hh) * 128 + d)) * 2048 + t) = make_uint2(pack2(v0, v1), pack2(v2, v3));
      }
    } else if (col < 2816) {
      float* f = p.F + (size_t)row4 * FS + (col - 2048);
      f[0] = v0; f[FS] = v1; f[2 * FS] = v2; f[3 * FS] = v3;
    } else if (col < 2824) {
      const int g = col - 2816; const float bb = bg[g];
      float* f = p.F + (size_t)row4 * FS + 768 + g;
      f[0] = v0 + bb; f[FS] = v1 + bb; f[2 * FS] = v2 + bb; f[3 * FS] = v3 + bb;
    }
  }
};
DI void phaseA(const Params& p, int l, char* smem) {
  const bf16_t* Bt = p.WinT + (size_t)l * NIN * 1024;
  EpiA epi{p, p.b_gate + l * 8};
  gemm_phase(p.hbf, Bt, 23, smem, epi, false);
}

struct EpiC {
  const Params& p; const float* adaL; int l;
  DI void operator()(int row4, int col, float v0, float v1, float v2, float v3) const {
    const float* xr = (l == 0) ? (row4 < NP ? p.x_prompt + (size_t)row4 * 1024 : p.x_sample + (size_t)(row4 - NP) * 1024)
                               : p.XZ + (size_t)row4 * 1024;
    const float g1 = adaL[(size_t)cond_row(row4) * 6144 + 2048 + col];
    const float x0 = xr[col], x1 = xr[1024 + col], x2 = xr[2048 + col], x3 = xr[3072 + col];
    float* z = p.XZ + (size_t)row4 * 1024 + col;
    z[0] = ALPHA * x0 + g1 * v0; z[1024] = ALPHA * x1 + g1 * v1; z[2048] = ALPHA * x2 + g1 * v2; z[3072] = ALPHA * x3 + g1 * v3;
  }
};
DI void phaseC(const Params& p, int l, char* smem) {
  const bf16_t* Bt = p.WoT + (size_t)l * 1024 * 1024;
  EpiC epi{p, p.ada + (size_t)l * 136 * 6144, l};
  gemm_phase(p.hbf, Bt, 8, smem, epi, true);
}

struct EpiE {
  const Params& p;
  DI void operator()(int row4, int col, float v0, float v1, float v2, float v3) const {
    bf16_t* q = p.qkvo + (size_t)row4 * 2048 + col;
    q[0] = (bf16_t)f2bf(v0); q[2048] = (bf16_t)f2bf(v1); q[4096] = (bf16_t)f2bf(v2); q[6144] = (bf16_t)f2bf(v3);
  }
};
DI void phaseE(const Params& p, int l, char* smem) {
  const bf16_t* Bt = p.WpqT + (size_t)l * 2048 * 1024;
  EpiE epi{p};
  gemm_phase(p.hbf, Bt, 16, smem, epi, true);
}

DI void phaseD(const Params& p, int l) {
  const int tid = tidx(), lane = tid & 63, w = tid >> 6;
  const float* adaL = p.ada + (size_t)l * 136 * 6144;
  const float* g = p.ln1_g + l * 1024; const float* bta = p.ln1_b + l * 1024;
  for (int tok = bidx() * 4 + w; tok < NT; tok += gridDim.x * 4) {
    float* zr = p.XZ + (size_t)tok * 1024;
    const int c0 = lane * 8, c1 = 512 + lane * 8;
    float z[16]; ld8f(zr + c0, z); ld8f(zr + c1, z + 8);
    float s = 0.f;
#pragma unroll
    for (int j = 0; j < 16; ++j) s += z[j];
    const float mu = wsum(s) * (1.f / 1024.f);
    float q = 0.f;
#pragma unroll
    for (int j = 0; j < 16; ++j) { const float d = z[j] - mu; q += d * d; }
    const float rstd = rsqrtf(wsum(q) * (1.f / 1024.f) + LN_EPS);
    float gg[16], bb[16];
    ld8f(g + c0, gg); ld8f(g + c1, gg + 8); ld8f(bta + c0, bb); ld8f(bta + c1, bb + 8);
#pragma unroll
    for (int j = 0; j < 16; ++j) z[j] = (z[j] - mu) * rstd * gg[j] + bb[j];
    st8f(zr + c0, z); st8f(zr + c1, z + 8);
    const float* ad = adaL + (size_t)cond_row(tok) * 6144;
    float sc[16], sh[16], hv[16];
    ld8f(ad + 4096 + c0, sc); ld8f(ad + 4096 + c1, sc + 8); ld8f(ad + 3072 + c0, sh); ld8f(ad + 3072 + c1, sh + 8);
    float hm = 0.f;
#pragma unroll
    for (int j = 0; j < 16; ++j) { hv[j] = z[j] * (1.f + sc[j]) + sh[j]; hm = fmaxf(hm, fabsf(hv[j])); }
    *(uint4*)(p.hbf + (size_t)tok * 1024 + c0) = pack8(hv);
    *(uint4*)(p.hbf + (size_t)tok * 1024 + c1) = pack8(hv + 8);
    hm = wmax(hm);
    const float hinv = hm > 0.f ? 127.f / hm : 0.f;
    unsigned qw[4];
#pragma unroll
    for (int q = 0; q < 4; ++q) {
      const int q0 = (int)rintf(hv[4 * q] * hinv), q1 = (int)rintf(hv[4 * q + 1] * hinv), q2 = (int)rintf(hv[4 * q + 2] * hinv), q3 = (int)rintf(hv[4 * q + 3] * hinv);
      qw[q] = (unsigned)(q0 & 255) | ((unsigned)(q1 & 255) << 8) | ((unsigned)(q2 & 255) << 16) | ((unsigned)(q3 & 255) << 24);
    }
    *(uint2*)(p.xq + (size_t)tok * 1024 + c0) = make_uint2(qw[0], qw[1]);
    *(uint2*)(p.xq + (size_t)tok * 1024 + c1) = make_uint2(qw[2], qw[3]);
    if (lane == 0) p.xscale[tok] = hm * (1.f / 127.f);
  }
}

DI void mlstm_i(const Params& p, int l, int item, char* smem) {
  const int tid = tidx(), lane = tid & 63, w = tid >> 6, r = lane & 31, h = lane >> 5;
  const int bh = item >> 5, c = item & 31, b = bh >> 2, hh = bh & 3;
  const int tok0 = b * 2048 + c * 64;
  float* wc = (float*)smem;
  bf16_t* Vs = (bf16_t*)(smem + 256);
  bf16_t* Ks = Vs + 128 * 72;
  {
#pragma unroll
    for (int i = 0; i < 4; ++i) {
      const int pc = tid + 256 * i, row = pc >> 3, cc = (pc & 7) * 8;
      *(uint4*)(Vs + row * 72 + cc) = *(const uint4*)(p.VT + ((size_t)(bh * 128 + row)) * 2048 + c * 64 + cc);
      *(uint4*)(Ks + row * 72 + cc) = *(const uint4*)(p.KT + ((size_t)(bh * 128 + row)) * 2048 + c * 64 + cc);
    }
  }
  if (w == 0) {
    const float* f = p.F + (size_t)(tok0 + lane) * FS + 768;
    const float gi = f[hh], gf = f[4 + hh];
    float x = logsigmoidf_(gf);
#pragma unroll
    for (int o = 1; o < 64; o <<= 1) { const float t = __shfl_up(x, o); if (lane >= o) x += t; }
    const float bend = __shfl(x, 63);
    const float dend = bend - x + gi;
    const float mloc = wmax(dend);
    wc[lane] = __expf(dend - mloc);
    if (lane == 0) { p.scal[(bh * 32 + c) * 2] = bend; p.scal[(bh * 32 + c) * 2 + 1] = mloc; }
  }
  __syncthreads();
  const int vi = w >> 1, ki = w & 1;
  f32x16 acc[2][2];
#pragma unroll
  for (int i = 0; i < 2; ++i)
#pragma unroll
    for (int j = 0; j < 2; ++j)
#pragma unroll
      for (int e = 0; e < 16; ++e) acc[i][j][e] = 0.f;
  const bf16_t* vt = Vs + (vi * 64 + r) * 72 + h * 8;
  const bf16_t* kt = Ks + (ki * 64 + r) * 72 + h * 8;
#pragma unroll
  for (int ks = 0; ks < 4; ++ks) {
    float wv[8];
#pragma unroll
    for (int j = 0; j < 8; ++j) wv[j] = wc[ks * 16 + h * 8 + j];
    bf16x8 a[2], bb[2];
#pragma unroll
    for (int i = 0; i < 2; ++i) {
      const uint4 u = *(const uint4*)(vt + i * 32 * 72 + ks * 16);
      float x[8]; unpack8(u, x);
#pragma unroll
      for (int j = 0; j < 8; ++j) x[j] *= wv[j];
      a[i] = __builtin_bit_cast(bf16x8, pack8(x));
    }
#pragma unroll
    for (int j = 0; j < 2; ++j) bb[j] = ld8(kt + j * 32 * 72 + ks * 16);
#pragma unroll
    for (int i = 0; i < 2; ++i)
#pragma unroll
      for (int j = 0; j < 2; ++j) acc[i][j] = MFMA32(a[i], bb[j], acc[i][j]);
  }
  float* ch = p.CH + (size_t)(bh * 32 + c) * CHS;
#pragma unroll
  for (int i = 0; i < 2; ++i)
#pragma unroll
    for (int j = 0; j < 2; ++j)
#pragma unroll
      for (int e = 0; e < 16; ++e) ch[(vi * 64 + i * 32 + crow(e, h)) * 128 + ki * 64 + j * 32 + r] = acc[i][j][e];
  if (tid < 128) {
    float s = 0.f;
#pragma unroll
    for (int q = 0; q < 8; ++q) {
      float x[8]; unpack8(*(const uint4*)(Ks + tid * 72 + q * 8), x);
#pragma unroll
      for (int j = 0; j < 8; ++j) s += wc[q * 8 + j] * x[j];
    }
    ch[128 * 128 + tid] = s;
  }
  __syncthreads();
}

DI void phaseB2(const Params& p, int l) {
  const int tid = tidx();
  for (int it = bidx(); it < 32 * 17; it += gridDim.x) {
    const int bh = it / 17, sl = it % 17;
    const int e4 = sl * 256 + tid;
    if (e4 >= 4128) continue;
    float m = 0.f;
    float4 C = make_float4(0.f, 0.f, 0.f, 0.f);
    float4* base = (float4*)(p.CH + (size_t)bh * 32 * CHS) + e4;
#pragma unroll 4
    for (int c = 0; c < 32; ++c) {
      const float bend = p.scal[(bh * 32 + c) * 2], mloc = p.scal[(bh * 32 + c) * 2 + 1];
      float4* q = base + (size_t)c * (CHS / 4);
      const float4 d = *q;
      *q = C;
      if (e4 == 0) p.mstart[bh * 32 + c] = m;
      const float mn = fmaxf(bend + m, mloc);
      const float dec = __expf(bend + m - mn), sc = __expf(mloc - mn);
      C.x = dec * C.x + sc * d.x; C.y = dec * C.y + sc * d.y; C.z = dec * C.z + sc * d.z; C.w = dec * C.w + sc * d.w;
      m = mn;
    }
    if (e4 < 4096) *((float4*)(p.out + O_CP + (size_t)(l * 32 + bh) * 16384) + e4) = C;
    else *((float4*)(p.out + O_NP + (size_t)(l * 32 + bh) * 128) + (e4 - 4096)) = C;
    if (e4 == 0) p.out[O_MP + l * 32 + bh] = m;
  }
}

DI void mlstm_iii(const Params& p, int l, int item, char* smem) {
  const int tid = tidx(), lane = tid & 63, w = tid >> 6, r = lane & 31, h = lane >> 5;
  const int bh = item >> 5, c = item & 31, b = bh >> 2, hh = bh & 3;
  const int tok0 = b * 2048 + c * 64;
  bf16_t* Qs = (bf16_t*)smem;
  bf16_t* As = (bf16_t*)(smem + 17408);
  float* Hs = (float*)(smem + 26624);
  float* sv = (float*)(smem + 60416);
  float *rowoff = sv, *gsrc = sv + 64, *winter = sv + 128, *enm = sv + 192, *scl = sv + 256, *nvec = sv + 320, *mus = sv + 448, *rss = sv + 512;
  const float* ch = p.CH + (size_t)(bh * 32 + c) * CHS;
#pragma unroll
  for (int i = 0; i < 4; ++i) {
    const int pc = tid + 256 * i, row = pc >> 4, cc = (pc & 15) * 8;
    *(uint4*)(Qs + row * 136 + cc) = *(const uint4*)(p.qkvo + (size_t)(tok0 + row) * 2048 + hh * 128 + cc);
  }
  if (tid < 128) nvec[tid] = ch[128 * 128 + tid];
  if (w == 0) {
    const float* f = p.F + (size_t)(tok0 + lane) * FS + 768;
    const float gi = f[hh], gf = f[4 + hh];
    float x = logsigmoidf_(gf);
#pragma unroll
    for (int o = 1; o < 64; o <<= 1) { const float t = __shfl_up(x, o); if (lane >= o) x += t; }
    const float u = gi - x;
    float pm = u;
#pragma unroll
    for (int o = 1; o < 64; o <<= 1) { const float t = __shfl_up(pm, o); if (lane >= o) pm = fmaxf(pm, t); }
    const float mc = p.mstart[bh * 32 + c];
    const float inter = x + mc;
    const float mt = fmaxf(inter, x + pm);
    rowoff[lane] = x - mt; gsrc[lane] = u; winter[lane] = __expf(inter - mt); enm[lane] = __expf(-mt);
  }
  __syncthreads();
  {
    const int ti = w >> 1, si = w & 1;
    f32x16 acc;
#pragma unroll
    for (int e = 0; e < 16; ++e) acc[e] = 0.f;
    if (si <= ti) {
      const bf16_t* kp = p.qkvo + (size_t)(tok0 + si * 32 + r) * 2048 + 512 + hh * 128 + h * 8;
#pragma unroll
      for (int ks = 0; ks < 8; ++ks) {
        const bf16x8 a = ld8(Qs + (ti * 32 + r) * 136 + ks * 16 + h * 8);
        const bf16x8 bb = ld8(kp + ks * 16);
        acc = MFMA32(a, bb, acc);
      }
    }
    const int s = si * 32 + r;
    const float gs = gsrc[s];
#pragma unroll
    for (int e = 0; e < 16; ++e) {
      const int t = ti * 32 + crow(e, h);
      const float v = (s <= t) ? __expf(rowoff[t] + gs) * acc[e] : 0.f;
      As[t * 72 + s] = (bf16_t)f2bf(v);
    }
  }
  __syncthreads();
  f32x16 acc1[2], acc2[2];
#pragma unroll
  for (int i = 0; i < 2; ++i)
#pragma unroll
    for (int e = 0; e < 16; ++e) { acc1[i][e] = 0.f; acc2[i][e] = 0.f; }
  {
    const bf16_t* vt = p.VT + ((size_t)(bh * 128 + w * 32 + r)) * 2048 + c * 64 + h * 8;
#pragma unroll 2
    for (int ks = 0; ks < 4; ++ks) {
      const bf16x8 bb = ld8(vt + ks * 16);
#pragma unroll
      for (int i = 0; i < 2; ++i) { const bf16x8 a = ld8(As + (i * 32 + r) * 72 + ks * 16 + h * 8); acc1[i] = MFMA32(a, bb, acc1[i]); }
    }
    const float* cp = ch + (size_t)(w * 32 + r) * 128 + h * 8;
#pragma unroll 4
    for (int ks = 0; ks < 8; ++ks) {
      float x[8]; ld8f(cp + ks * 16, x);
      const bf16x8 bb = __builtin_bit_cast(bf16x8, pack8(x));
#pragma unroll
      for (int i = 0; i < 2; ++i) { const bf16x8 a = ld8(Qs + (i * 32 + r) * 136 + ks * 16 + h * 8); acc2[i] = MFMA32(a, bb, acc2[i]); }
    }
  }
  if (tid < 64) {
    const int t = tid;
    float di = 0.f;
#pragma unroll
    for (int q = 0; q < 8; ++q) { float x[8]; unpack8(*(const uint4*)(As + t * 72 + q * 8), x);
#pragma unroll
      for (int j = 0; j < 8; ++j) di += x[j]; }
    float nq = 0.f;
#pragma unroll 2
    for (int q = 0; q < 16; ++q) { float x[8]; unpack8(*(const uint4*)(Qs + t * 136 + q * 8), x);
#pragma unroll
      for (int j = 0; j < 8; ++j) nq += x[j] * nvec[q * 8 + j]; }
    const float den = di + winter[t] * nq;
    scl[t] = 1.f / fmaxf(fabsf(den), enm[t]);
  }
  __syncthreads();
#pragma unroll
  for (int i = 0; i < 2; ++i)
#pragma unroll
    for (int e = 0; e < 16; ++e) {
      const int t = i * 32 + crow(e, h);
      Hs[t * 132 + w * 32 + r] = (acc1[i][e] + winter[t] * acc2[i][e]) * scl[t];
    }
  __syncthreads();
  {
    const int t = tid >> 2, part = tid & 3;
    float s = 0.f;
#pragma unroll
    for (int j = 0; j < 32; ++j) s += Hs[t * 132 + j * 4 + part];
    s += __shfl_xor(s, 1); s += __shfl_xor(s, 2);
    const float mu = s * (1.f / 128.f);
    float q = 0.f;
#pragma unroll
    for (int j = 0; j < 32; ++j) { const float d = Hs[t * 132 + j * 4 + part] - mu; q += d * d; }
    q += __shfl_xor(q, 1); q += __shfl_xor(q, 2);
    if (part == 0) { mus[t] = mu; rss[t] = rsqrtf(q * (1.f / 128.f) + LN_EPS); }
  }
  __syncthreads();
  const float* mg = p.mh_g + l * 512 + hh * 128;
#pragma unroll
  for (int i = 0; i < 4; ++i) {
    const int pc = tid + 256 * i, t = pc >> 4, v0 = (pc & 15) * 8;
    float o[8]; unpack8(*(const uint4*)(p.qkvo + (size_t)(tok0 + t) * 2048 + 1536 + hh * 128 + v0), o);
    float gg[8]; ld8f(mg + v0, gg);
    const float mu = mus[t], rs = rss[t];
    float y[8];
#pragma unroll
    for (int j = 0; j < 8; ++j) y[j] = sigmoidf_(o[j]) * ((Hs[t * 132 + v0 + j] - mu) * rs * gg[j]);
    *(uint4*)(p.hbf + (size_t)(tok0 + t) * 1024 + hh * 128 + v0) = pack8(y);
  }
  __syncthreads();
}

DI void mlstm_sample(const Params& p, int l, int item, char* smem) {
  const int tid = tidx(), lane = tid & 63, w = tid >> 6;
  const int b = item >> 2, hh = item & 3;
  const int tok0 = NP + b * 4;
  float* qs = (float*)smem;
  float* ks = qs + 512;
  float* vs = ks + 512;
  float* hs = vs + 512;
  float* ns = hs + 512;
  float* qk = ns + 128;
  float* nq = qk + 16;
  const size_t sidx = (size_t)(l * 128 + b) * 4 + hh;
  for (int i = tid; i < 1536; i += 256) {
    const int m = i >> 9, t = (i >> 7) & 3, d = i & 127;
    qs[i] = bf2f(p.qkvo[(size_t)(tok0 + t) * 2048 + m * 512 + hh * 128 + d]);
  }
  if (tid < 128) ns[tid] = p.stN[sidx * 128 + tid];
  __syncthreads();
  {
    const int dp = tid >> 3, part = tid & 7;
    if (dp < 20) {
      const float* x = qs + (dp < 16 ? (dp >> 2) : (dp - 16)) * 128 + part * 16;
      const float* y = (dp < 16 ? ks + (dp & 3) * 128 : ns) + part * 16;
      float a = 0.f;
#pragma unroll
      for (int d = 0; d < 16; ++d) a += x[d] * y[d];
      a += __shfl_xor(a, 1); a += __shfl_xor(a, 2); a += __shfl_xor(a, 4);
      if (part == 0) { if (dp < 16) qk[dp] = a; else nq[dp - 16] = a; }
    }
  }
  float ig[4], bc[4];
  {
    float run = 0.f;
#pragma unroll
    for (int t = 0; t < 4; ++t) { const float* f = p.F + (size_t)(tok0 + t) * FS + 768; ig[t] = f[hh]; run += logsigmoidf_(f[4 + hh]); bc[t] = run; }
  }
  const float mprev = p.stM[sidx];
  float mt[4], wint[4];
#pragma unroll
  for (int t = 0; t < 4; ++t) {
    float mm = bc[t] + mprev;
#pragma unroll
    for (int s = 0; s < 4; ++s) if (s <= t) mm = fmaxf(mm, bc[t] - bc[s] + ig[s]);
    mt[t] = mm; wint[t] = __expf(bc[t] + mprev - mm);
  }
  const float bend = bc[3];
  float mnew = bend + mprev;
#pragma unroll
  for (int s = 0; s < 4; ++s) mnew = fmaxf(mnew, bend - bc[s] + ig[s]);
  float wcs[4];
#pragma unroll
  for (int s = 0; s < 4; ++s) wcs[s] = __expf(bend - bc[s] + ig[s] - mnew);
  const float dec = __expf(bend + mprev - mnew);
  __syncthreads();
  float a[4][4], den[4];
#pragma unroll
  for (int t = 0; t < 4; ++t) {
    float ds = 0.f;
#pragma unroll
    for (int s = 0; s < 4; ++s) { a[t][s] = (s <= t) ? __expf(bc[t] - bc[s] + ig[s] - mt[t]) * qk[t * 4 + s] : 0.f; ds += a[t][s]; }
    den[t] = ds + wint[t] * nq[t];
  }
  {
    const int k4i = tid & 31, rgrp = tid >> 5, l5 = lane & 31;
    const bool bb4 = l5 & 16, bb3 = l5 & 8;
    float4 q4[4], k4[4];
#pragma unroll
    for (int t = 0; t < 4; ++t) { q4[t] = *(const float4*)(qs + t * 128 + k4i * 4); k4[t] = *(const float4*)(ks + t * 128 + k4i * 4); }
    const float wint_t = bb4 ? (bb3 ? wint[3] : wint[2]) : (bb3 ? wint[1] : wint[0]);
    const float den_t = bb4 ? (bb3 ? den[3] : den[2]) : (bb3 ? den[1] : den[0]);
    const float mt_t = bb4 ? (bb3 ? mt[3] : mt[2]) : (bb3 ? mt[1] : mt[0]);
    const float invd_t = 1.f / fmaxf(fabsf(den_t), __expf(-mt_t));
    float a_t[4];
#pragma unroll
    for (int s = 0; s < 4; ++s) a_t[s] = bb4 ? (bb3 ? a[3][s] : a[2][s]) : (bb3 ? a[1][s] : a[0][s]);
    const int tsel = (bb4 ? 2 : 0) + (bb3 ? 1 : 0);
    const float* cbase = p.stC + sidx * 16384 + k4i * 4;
    float* obase = p.out + O_CS + sidx * 16384 + k4i * 4;
#pragma unroll 4
    for (int j = 0; j < 16; ++j) {
      const int vrow = rgrp + 8 * j;
      const float4 cv = *(const float4*)(cbase + vrow * 128);
      const float v0 = vs[vrow], v1 = vs[128 + vrow], v2 = vs[256 + vrow], v3 = vs[384 + vrow];
      float pt[4];
#pragma unroll
      for (int t = 0; t < 4; ++t) pt[t] = cv.x * q4[t].x + cv.y * q4[t].y + cv.z * q4[t].z + cv.w * q4[t].w;
      const float w0 = wcs[0] * v0, w1 = wcs[1] * v1, w2 = wcs[2] * v2, w3 = wcs[3] * v3;
      float4 cn;
      cn.x = dec * cv.x + w0 * k4[0].x + w1 * k4[1].x + w2 * k4[2].x + w3 * k4[3].x;
      cn.y = dec * cv.y + w0 * k4[0].y + w1 * k4[1].y + w2 * k4[2].y + w3 * k4[3].y;
      cn.z = dec * cv.z + w0 * k4[0].z + w1 * k4[1].z + w2 * k4[2].z + w3 * k4[3].z;
      cn.w = dec * cv.w + w0 * k4[0].w + w1 * k4[1].w + w2 * k4[2].w + w3 * k4[3].w;
      *(float4*)(obase + vrow * 128) = cn;
      float r2[2];
#pragma unroll
      for (int jj = 0; jj < 2; ++jj) { const float x = pt[jj], y = pt[jj + 2]; r2[jj] = (bb4 ? y : x) + __shfl_xor(bb4 ? x : y, 16); }
      float r1 = (bb3 ? r2[1] : r2[0]) + __shfl_xor(bb3 ? r2[0] : r2[1], 8);
      r1 += __shfl_xor(r1, 4); r1 += __shfl_xor(r1, 2); r1 += __shfl_xor(r1, 1);
      if ((l5 & 7) == 0) hs[tsel * 128 + vrow] = (wint_t * r1 + a_t[0] * v0 + a_t[1] * v1 + a_t[2] * v2 + a_t[3] * v3) * invd_t;
    }
  }
  if (tid < 128) {
    float nn = dec * ns[tid];
#pragma unroll
    for (int s = 0; s < 4; ++s) nn += wcs[s] * ks[s * 128 + tid];
    p.out[O_NS + sidx * 128 + tid] = nn;
  }
  if (tid == 0) p.out[O_MS + sidx] = mnew;
  __syncthreads();
  {
    const int t = w;
    const float h0 = hs[t * 128 + lane], h1 = hs[t * 128 + 64 + lane];
    const float mu = wsum(h0 + h1) * (1.f / 128.f);
    const float d0 = h0 - mu, d1 = h1 - mu;
    const float rs = rsqrtf(wsum(d0 * d0 + d1 * d1) * (1.f / 128.f) + LN_EPS);
    const float* mg = p.mh_g + l * 512 + hh * 128;
    const bf16_t* op = p.qkvo + (size_t)(tok0 + t) * 2048 + 1536 + hh * 128;
    bf16_t* yp = p.hbf + (size_t)(tok0 + t) * 1024 + hh * 128;
    yp[lane] = (bf16_t)f2bf(sigmoidf_(bf2f(op[lane])) * d0 * rs * mg[lane]);
    yp[64 + lane] = (bf16_t)f2bf(sigmoidf_(bf2f(op[64 + lane])) * d1 * rs * mg[64 + lane]);
  }
  __syncthreads();
}

DI void sgu_prompt(const Params& p, int l, int item, char* smem) {
  const int tid = tidx(), lane = tid & 63, w = tid >> 6, r = lane & 31, h = lane >> 5;
  const int g = item & 3, bc = item >> 2;
  const int tok0 = bc * 128;
  bf16_t* Ws = (bf16_t*)smem;
  bf16_t* Vt = (bf16_t*)(smem + 34816);
  {
    const int s = tid >> 1, hf = tid & 1;
    const float* vp = p.F + (size_t)(tok0 + s) * FS + 256 + g * 64 + hf * 32;
    float x[32];
#pragma unroll
    for (int q = 0; q < 4; ++q) ld8f(vp + q * 8, x + q * 8);
    float sm = 0.f;
#pragma unroll
    for (int j = 0; j < 32; ++j) sm += x[j];
    sm += __shfl_xor(sm, 1);
    const float mu = sm * (1.f / 64.f);
    float q2 = 0.f;
#pragma unroll
    for (int j = 0; j < 32; ++j) { const float d = x[j] - mu; q2 += d * d; }
    q2 += __shfl_xor(q2, 1);
    const float rs = rsqrtf(q2 * (1.f / 64.f) + LN_EPS);
    const float* gp = p.sgu_g + l * 256 + g * 64 + hf * 32;
    const float* bp = p.sgu_b + l * 256 + g * 64 + hf * 32;
#pragma unroll
    for (int j = 0; j < 32; ++j) Vt[(hf * 32 + j) * 136 + s] = (bf16_t)f2bf((x[j] - mu) * rs * gp[j] + bp[j]);
  }
  {
    const float* wsp = p.w_s + (size_t)(l * 4 + g) * 16384;
#pragma unroll
    for (int i = 0; i < 16; ++i) {
      const int e4 = tid + 256 * i, t = e4 >> 5, s0 = (e4 & 31) * 4;
      const float4 v = *(const float4*)(wsp + t * 128 + s0);
      const float a0 = s0 <= t ? v.x : 0.f, a1 = s0 + 1 <= t ? v.y : 0.f, a2 = s0 + 2 <= t ? v.z : 0.f, a3 = s0 + 3 <= t ? v.w : 0.f;
      *(uint2*)(Ws + t * 136 + s0) = make_uint2(pack2(a0, a1), pack2(a2, a3));
    }
  }
  __syncthreads();
  f32x16 acc[2];
#pragma unroll
  for (int j = 0; j < 2; ++j)
#pragma unroll
    for (int e = 0; e < 16; ++e) acc[j][e] = 0.f;
#pragma unroll
  for (int ks = 0; ks < 8; ++ks) {
    const bf16x8 a = ld8(Ws + (w * 32 + r) * 136 + ks * 16 + h * 8);
#pragma unroll
    for (int j = 0; j < 2; ++j) { const bf16x8 bb = ld8(Vt + (j * 32 + r) * 136 + ks * 16 + h * 8); acc[j] = MFMA32(a, bb, acc[j]); }
  }
  const float* bsp = p.b_s + (l * 4 + g) * 128;
#pragma unroll
  for (int j = 0; j < 2; ++j)
#pragma unroll
    for (int e = 0; e < 16; ++e) {
      const int t = w * 32 + crow(e, h), d = j * 32 + r;
      const float u = p.F[(size_t)(tok0 + t) * FS + g * 64 + d];
      p.hbf[(size_t)(tok0 + t) * 1024 + 512 + g * 64 + d] = (bf16_t)f2bf(u * (acc[j][e] + bsp[t]));
    }
  __syncthreads();
}

DI void sgu_sample(const Params& p, int l, int b) {
  const int tid = tidx(), g = tid >> 6;
  const int tok0 = NP + b * 4;
  float vn[4];
  const float gg = p.sgu_g[l * 256 + tid], bb = p.sgu_b[l * 256 + tid];
#pragma unroll
  for (int t = 0; t < 4; ++t) {
    const float x = p.F[(size_t)(tok0 + t) * FS + 256 + tid];
    const float mu = wsum(x) * (1.f / 64.f);
    const float d = x - mu;
    const float rs = rsqrtf(wsum(d * d) * (1.f / 64.f) + LN_EPS);
    vn[t] = d * rs * gg + bb;
    p.out[O_SV + ((size_t)(l * 128 + b) * 4 + t) * 256 + tid] = vn[t];
  }
  const float* wsp = p.w_s + (size_t)(l * 4 + g) * 16384;
  const float* bsp = p.b_s + (l * 4 + g) * 128;
#pragma unroll
  for (int t = 0; t < 4; ++t) {
    float mix = bsp[t];
#pragma unroll
    for (int s = 0; s < 4; ++s) if (s <= t) mix += wsp[t * 128 + s] * vn[s];
    const float u = p.F[(size_t)(tok0 + t) * FS + tid];
    p.hbf[(size_t)(tok0 + t) * 1024 + 512 + tid] = (bf16_t)f2bf(u * mix);
  }
}

DI void pool_tail(const Params& p, int l, int tokbase, const float* P, int tid) {
  const int g = tid >> 6, e = tid & 63;
  float acc[16];
#pragma unroll
  for (int i = 0; i < 16; ++i) acc[i] = 0.f;
  const float* wp = p.w_pool + (size_t)(l * 4 + g) * 4096 + e;
#pragma unroll 4
  for (int d4 = 0; d4 < 16; ++d4) {
    const float w0 = wp[(d4 * 4) * 64], w1 = wp[(d4 * 4 + 1) * 64], w2 = wp[(d4 * 4 + 2) * 64], w3 = wp[(d4 * 4 + 3) * 64];
#pragma unroll
    for (int tt = 0; tt < 16; ++tt) {
      const float4 p4 = *(const float4*)(P + tt * 256 + g * 64 + d4 * 4);
      acc[tt] += p4.x * w0 + p4.y * w1 + p4.z * w2 + p4.w * w3;
    }
  }
  const float ps = p.pool_scale[l * 256 + tid];
#pragma unroll
  for (int tt = 0; tt < 16; ++tt) p.hbf[(size_t)(tokbase + tt) * 1024 + 768 + tid] = (bf16_t)f2bf(acc[tt] * ps);
}

DI void pool_prompt(const Params& p, int l, int item, char* smem) {
  const int tid = tidx();
  const int b = item >> 7, t0 = (item & 127) * 16;
  float* X = (float*)smem;
  float* P = X + 31 * 256;
#pragma unroll
  for (int i = 0; i < 31; ++i) { const int t = t0 - 15 + i; const int tc = t >= 0 ? t : 0; const float v = p.F[(size_t)(b * 2048 + tc) * FS + 512 + tid]; X[i * 256 + tid] = t >= 0 ? v : 0.f; }
  __syncthreads();
  const int g = tid >> 6, wsz = 2 << g;
#pragma unroll 4
  for (int tt = 0; tt < 16; ++tt) {
    float s = 0.f;
#pragma unroll
    for (int j = 0; j < 16; ++j) { const float xv = X[(15 + tt - j) * 256 + tid]; s += j < wsz ? xv : 0.f; }
    const int pos = t0 + tt;
    const float cnt = (float)(pos + 1 < wsz ? pos + 1 : wsz);
    P[tt * 256 + tid] = s / cnt - X[(15 + tt) * 256 + tid];
  }
  if (t0 == 2032)
    for (int tt = 1; tt < 16; ++tt) p.out[O_PP + ((size_t)(l * 8 + b) * 15 + (tt - 1)) * 256 + tid] = X[(15 + tt) * 256 + tid];
  __syncthreads();
  pool_tail(p, l, b * 2048 + t0, P, tid);
  __syncthreads();
}

DI void pool_sample(const Params& p, int l, int item, char* smem) {
  const int tid = tidx();
  const int b0 = item * 4;
  float* X = (float*)smem;
  float* P = X + 31 * 256;
  const int g = tid >> 6, wsz = 2 << g;
  for (int bi = 0; bi < 4; ++bi) {
    const int b = b0 + bi;
#pragma unroll
    for (int i = 0; i < 19; ++i)
      X[i * 256 + tid] = i < 15 ? p.stPool[((size_t)(l * 128 + b) * 15 + i) * 256 + tid] : p.F[(size_t)(NP + b * 4 + (i - 15)) * FS + 512 + tid];
    __syncthreads();
#pragma unroll
    for (int t = 0; t < 4; ++t) {
      float s = 0.f;
#pragma unroll
      for (int j = 0; j < 16; ++j) { const float xv = X[(15 + t - j) * 256 + tid]; s += j < wsz ? xv : 0.f; }
      P[(bi * 4 + t) * 256 + tid] = s / (float)wsz - X[(15 + t) * 256 + tid];
    }
#pragma unroll
    for (int i = 0; i < 15; ++i) p.out[O_PS + ((size_t)(l * 128 + b) * 15 + i) * 256 + tid] = X[(4 + i) * 256 + tid];
    __syncthreads();
  }
  pool_tail(p, l, NP + b0 * 4, P, tid);
  __syncthreads();
}

DI void phaseB1(const Params& p, int l, char* smem) {
  const int G = gridDim.x, bx = bidx();
  for (int it = bx; it < 512; it += G) mlstm_sample(p, l, it, smem);
  for (int it = (bx + 256) % G; it < 1024; it += G) mlstm_i(p, l, it, smem);
  for (int it = bx; it < 512; it += G) sgu_prompt(p, l, it, smem);
  for (int it = (bx + 128) % G; it < 128; it += G) sgu_sample(p, l, it);
  for (int it = bx; it < 1024; it += G) pool_prompt(p, l, it, smem);
  for (int it = (bx + 64) % G; it < 32; it += G) pool_sample(p, l, it, smem);
}

DI void phaseB3(const Params& p, int l, char* smem) {
  for (int it = bidx(); it < 1024; it += gridDim.x) mlstm_iii(p, l, it, smem);
}

__device__ const unsigned kCandWords[16] = {0x03020100u, 0x07060504u, 0x0b0a0908u, 0x0f0e0d0cu, 0x13121110u, 0x17161514u, 0x23222120u, 0x32313024u,
                                            0x42414033u, 0x61605150u, 0x90807170u, 0xd0c0b0a0u, 0xfffff0e0u, 0xffffffffu, 0xffffffffu, 0xffffffffu};

DI void ce_(int& a, int& b, bool desc) { const int hi = max(a, b), lo = min(a, b); a = desc ? hi : lo; b = desc ? lo : hi; }
DI void bitonic_sort16(int* v) {
#pragma unroll
  for (int k = 2; k <= 16; k <<= 1) {
#pragma unroll
    for (int j = k >> 1; j >= 1; j >>= 1) {
#pragma unroll
      for (int i = 0; i < 16; ++i) { const int l = i ^ j; if (l > i) ce_(v[i], v[l], (i & k) == 0); }
    }
  }
}
DI void bitonic_merge16(int* v) {
#pragma unroll
  for (int j = 8; j >= 1; j >>= 1) {
#pragma unroll
    for (int i = 0; i < 16; ++i) { const int l = i ^ j; if (l > i) ce_(v[i], v[l], true); }
  }
}

DI void phaseF(const Params& p, int l, char* smem) {
  const int tid = tidx(), lane = tid & 63, w = tid >> 6, r = lane & 31, h = lane >> 5;
  float* Sc = (float*)smem;
  float* ls = (float*)(smem + 33024);
  int* li = (int*)(smem + 41472);
  int* jp = (int*)(smem + 49920);
  for (int it = bidx(); it < 264 * 8; it += gridDim.x) {
    const int tile = it >> 3, hd = it & 7;
    const int tok0 = tile * 64;
    for (int pp = 0; pp < 2; ++pp) {
      f32x16 acc[2];
#pragma unroll
      for (int i = 0; i < 2; ++i)
#pragma unroll
        for (int e = 0; e < 16; ++e) acc[i][e] = 0.f;
      const bf16_t* qp = p.qkvo + (size_t)(tok0 + r) * 2048 + (hd * 2 + pp) * 128 + h * 8;
      const bf16_t* kp = p.keysb + ((size_t)((l * 8 + hd) * 2 + pp) * 128 + w * 32 + r) * 128 + h * 8;
#pragma unroll
      for (int ks = 0; ks < 8; ++ks) {
        const bf16x8 bb = ld8(kp + ks * 16);
#pragma unroll
        for (int i = 0; i < 2; ++i) { const bf16x8 a = ld8(qp + (size_t)i * 32 * 2048 + ks * 16); acc[i] = MFMA32(a, bb, acc[i]); }
      }
#pragma unroll
      for (int i = 0; i < 2; ++i)
#pragma unroll
        for (int e = 0; e < 16; ++e) Sc[(i * 32 + crow(e, h)) * 129 + w * 32 + r] = acc[i][e];
      __syncthreads();
      {
        const int row = tid >> 2, part = tid & 3;
        int va[16], vb[16];
#pragma unroll
        for (int j = 0; j < 16; ++j) {
          const int fa = __float_as_int(Sc[row * 129 + j * 4 + part]);
          const int ma = fa ^ ((fa >> 31) & 0x7fffffff);
          va[j] = (ma & ~127) | (127 - (j * 4 + part));
          const int fb = __float_as_int(Sc[row * 129 + (j + 16) * 4 + part]);
          const int mb = fb ^ ((fb >> 31) & 0x7fffffff);
          vb[j] = (mb & ~127) | (127 - ((j + 16) * 4 + part));
        }
        bitonic_sort16(va); bitonic_sort16(vb);
        int vc[16];
#pragma unroll
        for (int i = 0; i < 16; ++i) vc[i] = max(va[i], vb[15 - i]);
        bitonic_merge16(vc);
#pragma unroll
        for (int o = 1; o < 4; o <<= 1) {
          int vp[16];
#pragma unroll
          for (int i = 0; i < 16; ++i) vp[i] = (o == 1) ? dpp_xor1(vc[15 - i]) : dpp_xor2(vc[15 - i]);
#pragma unroll
          for (int i = 0; i < 16; ++i) vc[i] = max(vc[i], vp[i]);
          bitonic_merge16(vc);
        }
        if (part == 0) {
#pragma unroll
          for (int i = 0; i < 16; ++i) {
            const int mono = vc[i] & ~127;
            ls[row * 33 + pp * 16 + i] = __int_as_float(mono ^ ((mono >> 31) & 0x7fffffff));
            li[row * 33 + pp * 16 + i] = 127 - (vc[i] & 127);
          }
        }
      }
      __syncthreads();
    }
    {
      const int row = tid >> 2, part = tid & 3;
      int vc[16];
#pragma unroll
      for (int k = 0; k < 16; ++k) {
        const unsigned cw = kCandWords[k];
        const unsigned ij = (cw >> (8 * part)) & 0xffu;
        const int c = 4 * k + part;
        int key = (int)0x80000000;
        if (ij != 0xffu) {
          const float v = ls[row * 33 + (ij >> 4)] + ls[row * 33 + 16 + (ij & 15)];
          const int fb = __float_as_int(v);
          const int mono = fb ^ ((fb >> 31) & 0x7fffffff);
          key = (mono & ~63) | (63 - c);
        }
        vc[k] = key;
      }
      bitonic_sort16(vc);
#pragma unroll
      for (int o = 1; o < 4; o <<= 1) {
        int vp[16];
#pragma unroll
        for (int i = 0; i < 16; ++i) vp[i] = (o == 1) ? dpp_xor1(vc[15 - i]) : dpp_xor2(vc[15 - i]);
#pragma unroll
        for (int i = 0; i < 16; ++i) vc[i] = max(vc[i], vp[i]);
        bitonic_merge16(vc);
      }
      float sc[16];
      float sum = 0.f;
#pragma unroll
      for (int st = 0; st < 16; ++st) {
        const int mono = vc[st] & ~63;
        sc[st] = __int_as_float(mono ^ ((mono >> 31) & 0x7fffffff));
      }
      const float s0 = sc[0];
#pragma unroll
      for (int st = 0; st < 16; ++st) { sc[st] = __expf(sc[st] - s0); sum += sc[st]; }
      const float inv = 1.f / sum;
      int oid[4]; float og[4];
#pragma unroll
      for (int q = 0; q < 4; ++q) {
        const int kq = part == 0 ? vc[q] : (part == 1 ? vc[4 + q] : (part == 2 ? vc[8 + q] : vc[12 + q]));
        const float gq = part == 0 ? sc[q] : (part == 1 ? sc[4 + q] : (part == 2 ? sc[8 + q] : sc[12 + q]));
        const int c = 63 - (kq & 63);
        const unsigned ij = (kCandWords[c >> 2] >> (8 * (c & 3))) & 0xffu;
        oid[q] = li[row * 33 + (ij >> 4)] * 128 + li[row * 33 + 16 + (ij & 15)];
        og[q] = gq * inv;
      }
      *(int4*)(p.pidx + (size_t)(tok0 + row) * 128 + hd * 16 + part * 4) = make_int4(oid[0], oid[1], oid[2], oid[3]);
      *(float4*)(p.pgate + (size_t)(tok0 + row) * 128 + hd * 16 + part * 4) = make_float4(og[0], og[1], og[2], og[3]);
    }
    __syncthreads();
  }
}

constexpr int GT = 12;
DI void phaseG(const Params& p, int l, char* smem) {
  const int tid = tidx(), lane = tid & 63, w = tid >> 6, g = lane >> 3, sub = lane & 7;
  const int TW = gridDim.x * 4, wg = bidx() * 4 + w;
  const unsigned char* Uq = p.Uq + (size_t)l * 16384 * 1024;
  const unsigned char* Vq = p.Vq + (size_t)l * 16384 * 1024;
  const float* usc = p.uscale + l * 16384; const float* vsc = p.vscale + l * 16384;
  const float* adaL = p.ada + (size_t)l * 136 * 6144;
  const float* g2g = p.ln2_g + l * 1024; const float* g2b = p.ln2_b + l * 1024;
  float* dstbase = (l == 1) ? p.out : p.XZ;
  float* Y = p.F;
  int* spk0 = (int*)smem + w * (4 * GT * 64) + lane;
  int* spk1 = spk0 + GT * 64;
  const int* gpk0 = (const int*)smem + w * (4 * GT * 64) + 8 * g;
  const int* gpk1 = gpk0 + GT * 64;
  int* sa0 = spk0 + 2 * GT * 64;
  int* sa1 = spk0 + 3 * GT * 64;
  const unsigned sub16 = (unsigned)sub << 4;
  const bool b2 = sub & 4, b1 = sub & 2, b0 = sub & 1;
  const bool b5 = g & 4, b4 = g & 2, b3 = g & 1;
  for (int base = wg; base < NT; base += TW * GT) {
    const int nt = min(GT, (NT - base + TW - 1) / TW);
    for (int i = 0; i < nt; ++i) {
      const int tok = base + i * TW;
      spk0[i * 64] = p.pidx[(size_t)tok * 128 + 8 * sub + g];
      spk1[i * 64] = p.pidx[(size_t)tok * 128 + 64 + 8 * sub + g];
      sa0[i * 64] = 0; sa1[i * 64] = 0;
    }
    const int nsteps = 8 * nt;
#define G_NEXT(c_, i_, cn_, in_) { in_ = (i_) + 1; cn_ = (c_); if (in_ == nt) { in_ = 0; cn_ = (c_) + 1; } if (cn_ == 8) { cn_ = (c_); in_ = (i_); } }
#define U_GATHER(BUF, XS, c_, i_)                                                                            \
    { const unsigned char* tb_ = Uq + (size_t)(c_) * 16384 * 128;                                            \
      XS = *(const uint4*)(p.xq + (size_t)(base + (i_) * TW) * 1024 + (c_) * 128 + sub * 16);                \
      const int4 ka_ = *(const int4*)(gpk0 + (i_) * 64), kb_ = *(const int4*)(gpk0 + (i_) * 64 + 4);         \
      const int4 kc_ = *(const int4*)(gpk1 + (i_) * 64), kd_ = *(const int4*)(gpk1 + (i_) * 64 + 4);         \
      const int kk_[16] = {ka_.x, ka_.y, ka_.z, ka_.w, kb_.x, kb_.y, kb_.z, kb_.w, kc_.x, kc_.y, kc_.z, kc_.w, kd_.x, kd_.y, kd_.z, kd_.w}; \
      _Pragma("unroll") for (int ld = 0; ld < 16; ++ld) {                                                    \
        const unsigned e_ = (unsigned)kk_[ld] & 0xffffu;                                                     \
        BUF[ld] = *(const uint4*)(tb_ + ((e_ << 7) | sub16)); } }
#define U_COMPUTE(BUF, XS, i_)                                                                               \
    {                                                                                                        \
      int t[16];                                                                                             \
      _Pragma("unroll") for (int ld = 0; ld < 16; ++ld) {                                                    \
        int v = __builtin_amdgcn_sdot4((int)BUF[ld].x, (int)XS.x, 0, false);                                 \
        v = __builtin_amdgcn_sdot4((int)BUF[ld].y, (int)XS.y, v, false);                                     \
        v = __builtin_amdgcn_sdot4((int)BUF[ld].z, (int)XS.z, v, false);                                     \
        v = __builtin_amdgcn_sdot4((int)BUF[ld].w, (int)XS.w, v, false); t[ld] = v; }                        \
      int wsum2[2];                                                                                          \
      _Pragma("unroll") for (int k = 0; k < 2; ++k) {                                                        \
        int u4[4], v2[2];                                                                                    \
        _Pragma("unroll") for (int j = 0; j < 4; ++j) { const int x = t[8 * k + j], y = t[8 * k + j + 4]; u4[j] = (b2 ? y : x) + dpp_xor4(b2 ? x : y); } \
        _Pragma("unroll") for (int j = 0; j < 2; ++j) { const int x = u4[j], y = u4[j + 2]; v2[j] = (b1 ? y : x) + dpp_xor2(b1 ? x : y); } \
        { const int x = v2[0], y = v2[1]; wsum2[k] = (b0 ? y : x) + dpp_xor1(b0 ? x : y); } }               \
      sa0[(i_) * 64] += wsum2[0]; sa1[(i_) * 64] += wsum2[1];                                                \
    }
    {
      uint4 A[16]; uint4 xa;
      for (int c = 0; c < 8; ++c)
        for (int i = 0; i < nt; ++i) {
          U_GATHER(A, xa, c, i)
          U_COMPUTE(A, xa, i)
        }
    }
    for (int i = 0; i < nt; ++i) {
      const int tok = base + i * TW;
      const float xsc = p.xscale[tok];
      const float gv0 = p.pgate[(size_t)tok * 128 + 8 * sub + g], gv1 = p.pgate[(size_t)tok * 128 + 64 + 8 * sub + g];
      const int e0 = spk0[i * 64], e1 = spk1[i * 64];
      const float a0 = (float)sa0[i * 64] * usc[e0] * xsc, a1 = (float)sa1[i * 64] * usc[e1] * xsc;
      const float c0f = gv0 * 0.5f * a0 * (1.f + erff(a0 * 0.70710678118654752f)) * vsc[e0];
      const float c1f = gv1 * 0.5f * a1 * (1.f + erff(a1 * 0.70710678118654752f)) * vsc[e1];
      spk0[i * 64] = e0 | (int)(f2bf(c0f) << 16); spk1[i * 64] = e1 | (int)(f2bf(c1f) << 16);
    }
    {
      uint4 A[16]; unsigned ca[8];
#define V_GATHER(BUF, CF, c_, i_)                                                                            \
      { const unsigned char* tb_ = Vq + (size_t)(c_) * 16384 * 128;                                          \
        const int4 ka_ = *(const int4*)(gpk0 + (i_) * 64), kb_ = *(const int4*)(gpk0 + (i_) * 64 + 4);       \
        const int4 kc_ = *(const int4*)(gpk1 + (i_) * 64), kd_ = *(const int4*)(gpk1 + (i_) * 64 + 4);       \
        const int kk_[16] = {ka_.x, ka_.y, ka_.z, ka_.w, kb_.x, kb_.y, kb_.z, kb_.w, kc_.x, kc_.y, kc_.z, kc_.w, kd_.x, kd_.y, kd_.z, kd_.w}; \
        _Pragma("unroll") for (int ld = 0; ld < 16; ++ld) {                                                  \
          const unsigned pv_ = (unsigned)kk_[ld];                                                            \
          BUF[ld] = *(const uint4*)(tb_ + (((pv_ & 0xffffu) << 7) | sub16));                                 \
          if (ld & 1) CF[ld >> 1] |= pv_ & 0xffff0000u; else CF[ld >> 1] = pv_ >> 16; } }
#define FP8ACC(w_, o_) { const f32x2 lo = __builtin_amdgcn_cvt_pk_f32_fp8((int)(w_), false); const f32x2 hi = __builtin_amdgcn_cvt_pk_f32_fp8((int)(w_), true); \
        yv[(o_) / 2] = lo * cf2 + yv[(o_) / 2]; yv[(o_) / 2 + 1] = hi * cf2 + yv[(o_) / 2 + 1]; }
#define V_COMPUTE(BUF, CF, c_, i_)                                                                           \
      {                                                                                                      \
        f32x2 yv[8];                                                                                         \
        _Pragma("unroll") for (int j = 0; j < 8; ++j) { yv[j].x = 0.f; yv[j].y = 0.f; }                      \
        _Pragma("unroll") for (int ld = 0; ld < 16; ++ld) {                                                  \
          const float cf = (ld & 1) ? __uint_as_float(CF[ld >> 1] & 0xffff0000u) : __uint_as_float(CF[ld >> 1] << 16); \
          f32x2 cf2; cf2.x = cf; cf2.y = cf;                                                                 \
          unsigned w0_ = BUF[ld].x, w1_ = BUF[ld].y, w2_ = BUF[ld].z, w3_ = BUF[ld].w;                      \
          asm volatile("" : "+v"(w0_), "+v"(w1_), "+v"(w2_), "+v"(w3_));                                   \
          FP8ACC(w0_, 0) FP8ACC(w1_, 4) FP8ACC(w2_, 8) FP8ACC(w3_, 12)                                      \
          asm volatile("" : "+v"(yv[0]), "+v"(yv[1]), "+v"(yv[2]), "+v"(yv[3]), "+v"(yv[4]), "+v"(yv[5]), "+v"(yv[6]), "+v"(yv[7])); } \
        float y16[16];                                                                                       \
        _Pragma("unroll") for (int j = 0; j < 8; ++j) { y16[2 * j] = yv[j].x; y16[2 * j + 1] = yv[j].y; }    \
        float z8[8], z4[4], z2[2];                                                                           \
        _Pragma("unroll") for (int j = 0; j < 8; ++j) { const float x = y16[j], y = y16[j + 8]; z8[j] = (b5 ? y : x) + __shfl_xor(b5 ? x : y, 32); } \
        _Pragma("unroll") for (int j = 0; j < 4; ++j) { const float x = z8[j], y = z8[j + 4]; z4[j] = (b4 ? y : x) + __shfl_xor(b4 ? x : y, 16); } \
        _Pragma("unroll") for (int j = 0; j < 2; ++j) { const float x = z4[j], y = z4[j + 2]; z2[j] = (b3 ? y : x) + dpp_xor8f(b3 ? x : y); } \
        *(float2*)(Y + (size_t)(base + (i_) * TW) * 1024 + (c_) * 128 + sub * 16 + 2 * g) = make_float2(z2[0], z2[1]); \
      }
      for (int c = 0; c < 8; ++c)
        for (int i = 0; i < nt; ++i) {
          V_GATHER(A, ca, c, i)
          V_COMPUTE(A, ca, c, i)
        }
    }
    __threadfence();
    for (int i = 0; i < nt; ++i) {
      const int tok = base + i * TW;
      const int c0i = lane * 8, c1i = 512 + lane * 8;
      const float* ad = adaL + (size_t)cond_row(tok) * 6144;
      const float* xr = p.XZ + (size_t)tok * 1024;
      const float* yr = Y + (size_t)tok * 1024;
      float z[16], gg[16], y[16];
      ld8f(xr + c0i, z); ld8f(xr + c1i, z + 8);
      ld8f(yr + c0i, y); ld8f(yr + c1i, y + 8);
      ld8f(ad + 5120 + c0i, gg); ld8f(ad + 5120 + c1i, gg + 8);
      float sm = 0.f;
#pragma unroll
      for (int j = 0; j < 16; ++j) { z[j] = ALPHA * z[j] + gg[j] * y[j]; sm += z[j]; }
      const float mu = wsum(sm) * (1.f / 1024.f);
      float q = 0.f;
#pragma unroll
      for (int j = 0; j < 16; ++j) { const float d = z[j] - mu; q += d * d; }
      const float rstd = rsqrtf(wsum(q) * (1.f / 1024.f) + LN_EPS);
      float bb[16];
      ld8f(g2g + c0i, gg); ld8f(g2g + c1i, gg + 8); ld8f(g2b + c0i, bb); ld8f(g2b + c1i, bb + 8);
#pragma unroll
      for (int j = 0; j < 16; ++j) z[j] = (z[j] - mu) * rstd * gg[j] + bb[j];
      float* dr = dstbase + (size_t)tok * 1024;
      st8f(dr + c0i, z); st8f(dr + c1i, z + 8);
      if (l == 0) {
        const float* ad1 = p.ada + (size_t)(136 + cond_row(tok)) * 6144;
        mod_store(p.hbf + (size_t)tok * 1024 + c0i, z, ad1 + 1024 + c0i, ad1 + c0i);
        mod_store(p.hbf + (size_t)tok * 1024 + c1i, z + 8, ad1 + 1024 + c1i, ad1 + c1i);
      }
    }
  }
}

#define XB_TMO      128
#define XB_XCNT(j)  (256  + 64 * (j))
#define XB_XSUB(j)  (1280 + 64 * (j))
#define XB_XGEN(j)  (2304 + 64 * (j))
#define XB_TOP      3328
#define XB_TOPGEN   3392
#define XCD_BAR_WORDS 3456
#define XB_SPIN_CAP (1u << 18)
#define LAS __attribute__((address_space(3)))
DI unsigned xb_ld(unsigned* p) { return __hip_atomic_load(p, __ATOMIC_RELAXED, __HIP_MEMORY_SCOPE_AGENT); }
DI unsigned xb_add(unsigned* p, unsigned v) { return __hip_atomic_fetch_add(p, v, __ATOMIC_RELAXED, __HIP_MEMORY_SCOPE_AGENT); }
DI unsigned xb_xcc_id() { return (unsigned)__builtin_amdgcn_s_getreg((3 << 11) | 20) & 0xFu; }
#define XB_SPIN(cond, bar) do { unsigned _sp = 0; while (cond) { __builtin_amdgcn_s_sleep(1); \
    if ((++_sp & 255u) == 0u) { if (xb_ld(&(bar)[XB_TMO])) break; if (_sp > XB_SPIN_CAP) { atomicAdd(&(bar)[XB_TMO], 1u); break; } } } } while (0)
struct XcdBarrier { unsigned* bar; unsigned x; volatile LAS unsigned* st; };
DI XcdBarrier xcd_barrier_post(unsigned* bar, volatile LAS unsigned* st) {
  XcdBarrier b; b.bar = bar; b.x = xb_xcc_id(); b.st = st;
  if (threadIdx.x == 0) (void)xb_add(&bar[XB_XCNT(b.x)], 1u);
  return b;
}
DI void xcd_barrier_complete(unsigned* bar, unsigned x, unsigned& nloc, unsigned& nx) {
  const unsigned G = gridDim.x * gridDim.y * gridDim.z;
  unsigned sum, cnt, mine, sp = 0u;
  for (;;) {
    sum = 0u; cnt = 0u; mine = 0u;
#pragma unroll
    for (unsigned j = 0; j < 16; ++j) { const unsigned c = xb_ld(&bar[XB_XCNT(j)]); sum += c; cnt += (c > 0u) ? 1u : 0u; mine = (j == x) ? c : mine; }
    if (sum == G) break;
    __builtin_amdgcn_s_sleep(1);
    if ((++sp & 255u) == 0u) { if (xb_ld(&bar[XB_TMO])) break; if (sp > XB_SPIN_CAP) { atomicAdd(&bar[XB_TMO], 1u); break; } }
  }
  nloc = mine > 0u ? mine : 1u; nx = cnt > 0u ? cnt : 1u;
}
DI void xcd_barrier(const XcdBarrier& b) {
  asm volatile("s_waitcnt vmcnt(0)" ::: "memory");
  __syncthreads();
  if (threadIdx.x == 0) {
    unsigned* bar = b.bar;
    __builtin_amdgcn_s_waitcnt(0);
    unsigned nloc = b.st[0], nx = b.st[1];
    if (nloc == 0u) { xcd_barrier_complete(bar, b.x, nloc, nx); b.st[0] = nloc; b.st[1] = nx; }
    const unsigned old = xb_add(&bar[XB_XSUB(b.x)], 1u);
    const unsigned gen = old / nloc;
    if (old + 1u == (gen + 1u) * nloc) {
      __builtin_amdgcn_fence(__ATOMIC_RELEASE, "agent");
      asm volatile("s_waitcnt vmcnt(0)" ::: "memory");
      const unsigned og = xb_add(&bar[XB_TOP], 1u);
      const unsigned tg = og / nx;
      if (og + 1u == (tg + 1u) * nx) xb_add(&bar[XB_TOPGEN], 1u);
      else XB_SPIN(xb_ld(&bar[XB_TOPGEN]) == tg, bar);
      __builtin_amdgcn_fence(__ATOMIC_ACQUIRE, "agent");
      xb_add(&bar[XB_XGEN(b.x)], 1u);
      asm volatile("s_waitcnt vmcnt(0)" ::: "memory");
    } else {
      XB_SPIN(xb_ld(&bar[XB_XGEN(b.x)]) == gen, bar);
      __builtin_amdgcn_fence(__ATOMIC_ACQUIRE, "agent");
      asm volatile("s_waitcnt vmcnt(0)" ::: "memory");
    }
  }
  __syncthreads();
}

__global__ void __launch_bounds__(256, 2) fwd_megakernel(Params p, int ph_lo, int ph_hi) {
  __shared__ __attribute__((aligned(16))) char smem[63488];
  __shared__ uint4 xb_words;
  cg::grid_group grid = cg::this_grid();
  if (threadIdx.x == 0) xb_words = make_uint4(0u, 0u, 0u, 0u);
  __syncthreads();
  const XcdBarrier xb = xcd_barrier_post(p.bar, (volatile LAS unsigned*)&xb_words);
  for (int ph = ph_lo; ph < ph_hi; ++ph) {
    if (ph == 0) phase0(p, smem);
    else if (ph == 1) phase1(p);
    else {
      const int l = (ph - 2) / 9, s = (ph - 2) % 9;
      switch (s) {
        case 0: phaseA(p, l, smem); break;
        case 1: phaseB1(p, l, smem); break;
        case 2: phaseB2(p, l); break;
        case 3: phaseB3(p, l, smem); break;
        case 4: phaseC(p, l, smem); break;
        case 5: phaseD(p, l); break;
        case 6: phaseE(p, l, smem); break;
        case 7: phaseF(p, l, smem); break;
        default: phaseG(p, l, smem); break;
      }
    }
    if (ph + 1 < ph_hi) { if (ph_lo < 0) grid.sync(); xcd_barrier(xb); }
  }
}

#ifndef MULTI_LAUNCH
#define MULTI_LAUNCH 0
#endif

extern "C" void kernel_launch(void* const* d_in, const int* in_sizes, int n_in, void* d_out, int out_size, void* d_ws,
                              size_t ws_size, hipStream_t stream) {
  static int grid_blocks = 0;
  if (!grid_blocks) {
    int dev = 0, cus = 0, per_cu = 0;
    hipGetDevice(&dev);
    hipDeviceGetAttribute(&cus, hipDeviceAttributeMultiprocessorCount, dev);
    hipOccupancyMaxActiveBlocksPerMultiprocessor(&per_cu, fwd_megakernel, 256, 0);
    if (per_cu > 2) per_cu = 2;
    if (per_cu < 1) per_cu = 1;
    grid_blocks = cus * per_cu;
  }
  Params p{};
  const float* const* in = (const float* const*)d_in;
  p.x_prompt = in[0]; p.x_sample = in[1]; p.stC = in[2]; p.stN = in[3]; p.stM = in[4]; p.stPool = in[5];
  p.c_prompt = in[6]; p.c_sample = in[7]; p.w_ada = in[8]; p.b_ada = in[9]; p.w_in = in[10]; p.b_gate = in[11];
  p.mh_g = in[12]; p.sgu_g = in[13]; p.sgu_b = in[14]; p.w_s = in[15]; p.b_s = in[16]; p.w_pool = in[17];
  p.pool_scale = in[18]; p.w_o = in[19]; p.ln1_g = in[20]; p.ln1_b = in[21]; p.w_pq = in[22]; p.peer_keys = in[23];
  p.peer_u = in[24]; p.peer_v = in[25]; p.ln2_g = in[26]; p.ln2_b = in[27];
  p.out = (float*)d_out;
  char* ws = (char*)d_ws; size_t off = 0;
  auto take = [&](size_t bytes) { char* r = ws + off; off += (bytes + 255) & ~(size_t)255; return r; };
  p.ada = (float*)take((size_t)2 * 136 * 6144 * 4);
  p.WinT = (bf16_t*)take((size_t)2 * NIN * 1024 * 2);
  p.WoT = (bf16_t*)take((size_t)2 * 1024 * 1024 * 2);
  p.WpqT = (bf16_t*)take((size_t)2 * 2048 * 1024 * 2);
  p.keysb = (bf16_t*)take((size_t)524288 * 2);
  p.Uq = (unsigned char*)take((size_t)2 * 16384 * 1024);
  p.Vq = (unsigned char*)take((size_t)2 * 16384 * 1024);
  p.xq = (unsigned char*)take((size_t)NT * 1024);
  p.uscale = (float*)take((size_t)2 * 16384 * 4);
  p.vscale = (float*)take((size_t)2 * 16384 * 4);
  p.xscale = (float*)take((size_t)NT * 4);
  p.hbf = (bf16_t*)take((size_t)NT * 1024 * 2);
  p.qkvo = (bf16_t*)take((size_t)NT * 2048 * 2);
  p.KT = (bf16_t*)take((size_t)32 * 128 * 2048 * 2);
  p.VT = (bf16_t*)take((size_t)32 * 128 * 2048 * 2);
  p.F = (float*)take((size_t)NT * FS * 4);
  p.CH = (float*)take((size_t)1024 * CHS * 4);
  p.scal = (float*)take((size_t)2048 * 4);
  p.mstart = (float*)take((size_t)1024 * 4);
  p.XZ = (float*)take((size_t)NT * 1024 * 4);
  p.pgate = (float*)take((size_t)NT * 128 * 4);
  p.pidx = (int*)take((size_t)NT * 128 * 4);
  p.bar = (unsigned*)take((size_t)XCD_BAR_WORDS * 4);
  if (off > ws_size) fprintf(stderr, "workspace too small: need %zu have %zu\n", off, ws_size);
  (void)hipMemsetAsync(p.bar, 0, (size_t)XCD_BAR_WORDS * 4, stream);
#if MULTI_LAUNCH
  for (int ph = 0; ph < 20; ++ph) hipLaunchKernelGGL(fwd_megakernel, dim3(grid_blocks), dim3(256), 0, stream, p, ph, ph + 1);
#else
  int lo = 0, hi = 20;
  void* args[] = {&p, &lo, &hi};
  hipError_t e = hipLaunchCooperativeKernel((void*)fwd_megakernel, dim3(grid_blocks), dim3(256), args, 0, stream);
  if (e != hipSuccess) fprintf(stderr, "cooperative launch failed: %s (grid %d)\n", hipGetErrorString(e), grid_blocks);
#endif
}
```
